# Optimizing an MI355X kernel written in HIP

```python
import math
import jax, jax.numpy as jnp
from jax import lax
import numpy as np

D_MODEL = 1024
BATCH = 16
SEQ = 4096
DEPTH = 1

HEAD_DIM = 64
N_Q_HEADS = 8
N_KV_HEADS = 2
Q_GROUP = N_Q_HEADS // N_KV_HEADS
ATTN_WIDTH = N_Q_HEADS * HEAD_DIM
KV_WIDTH = N_KV_HEADS * HEAD_DIM
WINDOW = 128
ATTN_BLOCK = 128
ROPE_DIM = HEAD_DIM // 4
ROPE_THETA = 500000.0
N_G_HEADS = 8
G_HEAD_DIM = 64
GMLP_WIDTH = N_G_HEADS * G_HEAD_DIM
CHUNK = 128
MIX_WIDTH = ATTN_WIDTH + GMLP_WIDTH
IN_WIDTH = ATTN_WIDTH + 2 * KV_WIDTH + 2 * GMLP_WIDTH
SPLITS = (ATTN_WIDTH, ATTN_WIDTH + KV_WIDTH, ATTN_WIDTH + 2 * KV_WIDTH,
          ATTN_WIDTH + 2 * KV_WIDTH + GMLP_WIDTH)
N_EXPERTS = 32
TOP_K = 4
D_EXPERT = D_MODEL
SWIGLU_LIMIT = 7.0
SWIGLU_ALPHA = 1.702
EXPERT_BLOCK = 256
LN_EPS = 1e-5
DEEPNORM_ALPHA = (2.0 * DEPTH) ** 0.25
DEEPNORM_BETA = (8.0 * DEPTH) ** -0.25

kernel_name = "hybrid_swa_sink_gmlp_moe_deepnorm"


def layer_norm(x, g, b):
    xf = x.astype(jnp.float32)
    mu = jnp.mean(xf, axis=-1, keepdims=True)
    var = jnp.mean(jnp.square(xf - mu), axis=-1, keepdims=True)
    y = (xf - mu) * lax.rsqrt(var + LN_EPS)
    return (y * g.astype(jnp.float32) + b.astype(jnp.float32)).astype(x.dtype)


def rotary_tables(positions):
    inv_freq = ROPE_THETA ** (-jnp.arange(0, ROPE_DIM, 2, dtype=jnp.float32) / ROPE_DIM)
    ang = positions.astype(jnp.float32)[..., None] * inv_freq
    return jnp.cos(ang)[:, :, None, :], jnp.sin(ang)[:, :, None, :]


def apply_partial_rope(t, cos, sin):
    half = ROPE_DIM // 2
    cos = cos.astype(t.dtype)
    sin = sin.astype(t.dtype)
    r1, r2, rest = t[..., :half], t[..., half:ROPE_DIM], t[..., ROPE_DIM:]
    return jnp.concatenate([r1 * cos - r2 * sin, r2 * cos + r1 * sin, rest], axis=-1)


def sliding_window_attention(q, k, v, sinks):
    B, S = q.shape[0], q.shape[1]
    nb = S // ATTN_BLOCK
    qb = q.reshape(B, nb, ATTN_BLOCK, N_KV_HEADS, Q_GROUP, HEAD_DIM)
    kb = k.reshape(B, nb, ATTN_BLOCK, N_KV_HEADS, HEAD_DIM)
    vb = v.reshape(B, nb, ATTN_BLOCK, N_KV_HEADS, HEAD_DIM)
    pad = ((0, 0), (1, 0), (0, 0), (0, 0), (0, 0))
    kw = jnp.concatenate([jnp.pad(kb[:, :-1], pad), kb], axis=2)
    vw = jnp.concatenate([jnp.pad(vb[:, :-1], pad), vb], axis=2)
    s = jnp.einsum('bnqhgd,bnkhd->bnhgqk', qb, kw).astype(jnp.float32) * (HEAD_DIM ** -0.5)
    qi = jnp.arange(ATTN_BLOCK)[:, None] + ATTN_BLOCK
    kj = jnp.arange(2 * ATTN_BLOCK)[None, :]
    diff = qi - kj
    band = (diff >= 0) & (diff < WINDOW)
    has_prev = (jnp.arange(nb)[:, None, None] > 0) | (kj[None] >= ATTN_BLOCK)
    mask = band[None] & has_prev
    s = jnp.where(mask[None, :, None, None], s, -jnp.inf)
    sink = sinks.astype(jnp.float32).reshape(N_KV_HEADS, Q_GROUP)[None, None, :, :, None, None]
    m = jnp.maximum(jnp.max(s, axis=-1, keepdims=True), sink)
    p = jnp.exp(s - m)
    p = p / (jnp.sum(p, axis=-1, keepdims=True) + jnp.exp(sink - m))
    o = jnp.einsum('bnhgqk,bnkhd->bnqhgd', p.astype(v.dtype), vw)
    return o.reshape(B, S, ATTN_WIDTH)


def chunked_spatial_gating(u, v, gn_g, gn_b, w_s, b_s):
    B, S = u.shape[0], u.shape[1]
    nc = S // CHUNK
    v = layer_norm(v, gn_g, gn_b)
    vc = v.reshape(B, nc, CHUNK, N_G_HEADS, G_HEAD_DIM)
    tril = jnp.tril(jnp.ones((CHUNK, CHUNK), dtype=bool))
    w = jnp.where(tril[None], w_s, jnp.zeros((), w_s.dtype))
    mixed = jnp.einsum('hts,bcshd->bcthd', w, vc) + b_s.T[None, None, :, :, None]
    return (u.reshape(B, nc, CHUNK, N_G_HEADS, G_HEAD_DIM) * mixed).reshape(B, S, GMLP_WIDTH)


def hybrid_mixer(x, cos, sin, w_in, b_in, sinks, gn_g, gn_b, w_s, b_s, w_out, b_out):
    B, S, _ = x.shape
    proj = jnp.einsum('bsd,de->bse', x, w_in) + b_in
    q, k, v, gu, gv = jnp.split(proj, SPLITS, axis=-1)
    q = apply_partial_rope(q.reshape(B, S, N_Q_HEADS, HEAD_DIM), cos, sin)
    k = apply_partial_rope(k.reshape(B, S, N_KV_HEADS, HEAD_DIM), cos, sin)
    v = v.reshape(B, S, N_KV_HEADS, HEAD_DIM)
    attn = sliding_window_attention(q, k, v, sinks)
    gu = jax.nn.gelu(gu, approximate=False).reshape(B, S, N_G_HEADS, G_HEAD_DIM)
    gv = jax.nn.gelu(gv, approximate=False).reshape(B, S, N_G_HEADS, G_HEAD_DIM)
    gmix = chunked_spatial_gating(gu, gv, gn_g, gn_b, w_s, b_s)
    o = jnp.concatenate([attn, gmix], axis=-1)
    return jnp.einsum('bse,ed->bsd', o, w_out) + b_out


def clamped_swiglu(gu):
    gate, up = gu[..., :D_EXPERT], gu[..., D_EXPERT:]
    gate = jnp.minimum(gate, SWIGLU_LIMIT)
    up = jnp.clip(up, -SWIGLU_LIMIT, SWIGLU_LIMIT)
    return (up + 1.0) * (gate * jax.nn.sigmoid(gate * SWIGLU_ALPHA))


def routed_experts(x, w_router, b_router, w_gate_up, b_gate_up, w_down, b_down):
    B, S, D = x.shape
    T = B * S
    x2 = x.reshape(T, D)
    logits = (x2 @ w_router + b_router).astype(jnp.float32)
    top_val, top_idx = lax.top_k(logits, TOP_K)
    gates = jax.nn.softmax(top_val, axis=-1).astype(x.dtype)
    N = T * TOP_K
    flat_e = top_idx.reshape(N)
    flat_tok = jnp.arange(N, dtype=jnp.int32) // TOP_K
    flat_g = gates.reshape(N)
    order = jnp.argsort(flat_e)
    sorted_e = flat_e[order]
    counts = jnp.bincount(flat_e, length=N_EXPERTS)
    starts = jnp.cumsum(counts) - counts
    padded = ((counts + EXPERT_BLOCK - 1) // EXPERT_BLOCK) * EXPERT_BLOCK
    pends = jnp.cumsum(padded)
    pstarts = pends - padded
    dest = pstarts[sorted_e] + (jnp.arange(N) - starts[sorted_e])
    NP = N + N_EXPERTS * EXPERT_BLOCK
    nblk = NP // EXPERT_BLOCK
    buf_tok = jnp.zeros((NP,), jnp.int32).at[dest].set(flat_tok[order])
    buf_g = jnp.zeros((NP,), x.dtype).at[dest].set(flat_g[order])
    blk_start = jnp.arange(nblk) * EXPERT_BLOCK
    blk_e = jnp.minimum(jnp.searchsorted(pends, blk_start, side='right'), N_EXPERTS - 1)

    def body(acc, blk):
        tok, g, e = blk
        xb = x2[tok]
        h = clamped_swiglu(xb @ w_gate_up[e] + b_gate_up[e])
        y = (h @ w_down[e] + b_down[e]) * g[:, None]
        return acc.at[tok].add(y.astype(acc.dtype)), None

    acc0 = jnp.zeros((T, D), x.dtype)
    out, _ = lax.scan(body, acc0, (buf_tok.reshape(nblk, EXPERT_BLOCK),
                                   buf_g.reshape(nblk, EXPERT_BLOCK), blk_e))
    return out.reshape(B, S, D)


def setup_inputs(seed: int = 0) -> dict:
    key = jax.random.key(seed)
    ks = jax.random.split(key, 24)
    f32 = jnp.float32
    L = DEPTH
    nrm = lambda k, shape, scale: jax.random.normal(k, shape, f32) * scale
    x = jax.random.normal(ks[0], (BATCH, SEQ, D_MODEL), f32)
    offsets = jax.random.randint(ks[1], (BATCH, 1), 0, 4096, dtype=jnp.int32)
    positions = offsets + jnp.arange(SEQ, dtype=jnp.int32)[None, :]
    col_scale = jnp.concatenate([jnp.ones((ATTN_WIDTH + KV_WIDTH,), f32),
                                 jnp.full((KV_WIDTH + 2 * GMLP_WIDTH,), DEEPNORM_BETA, f32)])
    return {
        "x": x,
        "positions": positions,
        "ln_in_g": 1.0 + nrm(ks[2], (D_MODEL,), 0.02),
        "ln_in_b": nrm(ks[3], (D_MODEL,), 0.02),
        "w_in": nrm(ks[4], (L, D_MODEL, IN_WIDTH), D_MODEL ** -0.5) * col_scale,
        "b_in": nrm(ks[5], (L, IN_WIDTH), 0.02),
        "sinks": nrm(ks[6], (L, N_Q_HEADS), 0.5),
        "gn_g": 1.0 + nrm(ks[7], (L, G_HEAD_DIM), 0.02),
        "gn_b": nrm(ks[8], (L, G_HEAD_DIM), 0.02),
        "w_s": nrm(ks[9], (L, N_G_HEADS, CHUNK, CHUNK), CHUNK ** -0.5),
        "b_s": 1.0 + nrm(ks[10], (L, N_G_HEADS, CHUNK), 0.02),
        "w_out": nrm(ks[11], (L, MIX_WIDTH, D_MODEL), MIX_WIDTH ** -0.5 * DEEPNORM_BETA),
        "b_out": nrm(ks[12], (L, D_MODEL), 0.02),
        "ln1_g": 1.0 + nrm(ks[13], (L, D_MODEL), 0.02),
        "ln1_b": nrm(ks[14], (L, D_MODEL), 0.02),
        "w_router": nrm(ks[15], (L, D_MODEL, N_EXPERTS), D_MODEL ** -0.5),
        "b_router": nrm(ks[16], (L, N_EXPERTS), 0.01),
        "w_gate_up": nrm(ks[17], (L, N_EXPERTS, D_MODEL, 2 * D_EXPERT), D_MODEL ** -0.5 * DEEPNORM_BETA),
        "b_gate_up": nrm(ks[18], (L, N_EXPERTS, 2 * D_EXPERT), 0.02),
        "w_down": nrm(ks[19], (L, N_EXPERTS, D_EXPERT, D_MODEL), D_EXPERT ** -0.5 * DEEPNORM_BETA),
        "b_down": nrm(ks[20], (L, N_EXPERTS, D_MODEL), 0.02),
        "ln2_g": 1.0 + nrm(ks[21], (L, D_MODEL), 0.02),
        "ln2_b": nrm(ks[22], (L, D_MODEL), 0.02),
    }


def reference(x, positions, ln_in_g, ln_in_b, w_in, b_in, sinks, gn_g, gn_b, w_s, b_s,
              w_out, b_out, ln1_g, ln1_b, w_router, b_router, w_gate_up, b_gate_up,
              w_down, b_down, ln2_g, ln2_b):
    cos, sin = rotary_tables(positions)
    h = layer_norm(x, ln_in_g, ln_in_b)
    for l in range(DEPTH):
        mix = hybrid_mixer(h, cos, sin, w_in[l], b_in[l], sinks[l], gn_g[l], gn_b[l],
                           w_s[l], b_s[l], w_out[l], b_out[l])
        h = layer_norm(DEEPNORM_ALPHA * h + mix, ln1_g[l], ln1_b[l])
        ffn = routed_experts(h, w_router[l], b_router[l], w_gate_up[l], b_gate_up[l],
                             w_down[l], b_down[l])
        h = layer_norm(DEEPNORM_ALPHA * h + ffn, ln2_g[l], ln2_b[l])
    return h
```

```cpp
#include <hip/hip_runtime.h>
#include <stdint.h>
#include <math.h>

constexpr int D = 1024, BATCH = 16, SEQ = 4096, T = BATCH * SEQ;
constexpr int NQH = 8, NKVH = 2, HD = 64, ATTW = 512, KVW = 128, GW = 512, INW = 1792;
constexpr int NE = 32, TOPK = 4, DE = 1024, EBLK = 256;
constexpr int OFF_Q = 0, OFF_K = 512, OFF_V = 640, OFF_GU = 768, OFF_GV = 1280;
constexpr float LN_EPS = 1e-5f;
constexpr float ALPHA = 1.189207115002721f;
constexpr int NPMAX = T + NE * EBLK;

__device__ __forceinline__ float wave_sum(float v) {
#pragma unroll
    for (int o = 1; o < 64; o <<= 1) v += __shfl_xor(v, o);
    return v;
}
__device__ __forceinline__ float gelu_exact(float v) { return 0.5f * v * (1.0f + erff(v * 0.70710678118654752f)); }

__global__ void __launch_bounds__(256) ln_rows(const float* __restrict__ a, const float* __restrict__ b, float alpha,
                                                const float* __restrict__ g, const float* __restrict__ beta, float* __restrict__ out, int rows) {
    const int lane = threadIdx.x & 63, wave = threadIdx.x >> 6;
    const int row = blockIdx.x * 4 + wave;
    if (row >= rows) return;
    const float4* ar = (const float4*)(a + (size_t)row * D) + lane;
    const float4* br = b ? (const float4*)(b + (size_t)row * D) + lane : nullptr;
    float4 v[4]; float s = 0.f;
#pragma unroll
    for (int j = 0; j < 4; ++j) {
        float4 x = ar[64 * j];
        x.x *= alpha; x.y *= alpha; x.z *= alpha; x.w *= alpha;
        if (br) { float4 y = br[64 * j]; x.x += y.x; x.y += y.y; x.z += y.z; x.w += y.w; }
        v[j] = x; s += (x.x + x.y) + (x.z + x.w);
    }
    const float mean = wave_sum(s) * (1.f / D);
    float s2 = 0.f;
#pragma unroll
    for (int j = 0; j < 4; ++j) {
        v[j].x -= mean; v[j].y -= mean; v[j].z -= mean; v[j].w -= mean;
        s2 += (v[j].x * v[j].x + v[j].y * v[j].y) + (v[j].z * v[j].z + v[j].w * v[j].w);
    }
    const float rstd = 1.0f / sqrtf(wave_sum(s2) * (1.f / D) + LN_EPS);
    float4* o = (float4*)(out + (size_t)row * D) + lane;
#pragma unroll
    for (int j = 0; j < 4; ++j) {
        const float4 gg = ((const float4*)g)[lane + 64 * j], bb = ((const float4*)beta)[lane + 64 * j];
        float4 r;
        r.x = v[j].x * rstd * gg.x + bb.x; r.y = v[j].y * rstd * gg.y + bb.y;
        r.z = v[j].z * rstd * gg.z + bb.z; r.w = v[j].w * rstd * gg.w + bb.w;
        o[64 * j] = r;
    }
}

template <int MODE>
__global__ void __launch_bounds__(256) sgemm128(const float* __restrict__ A, int lda, const float* __restrict__ B, int ldb, const float* __restrict__ bias,
                                                 float* __restrict__ C, int ldc, int K,
                                                 const int* __restrict__ slot_tok, const float* __restrict__ slot_gate, const int* __restrict__ grp_e,
                                                 size_t strideB, int strideBias, int accumulate) {
    __shared__ float As[16][132];
    __shared__ float Bs[16][132];
    const int t = threadIdx.x, tx = t & 15, ty = t >> 4;
    const int row0 = blockIdx.y * 128, col0 = blockIdx.x * 128;
    if (MODE == 1) {
        const int e = grp_e[row0 / EBLK];
        if (e < 0) return;
        B += (size_t)e * strideB; bias += (size_t)e * strideBias;
    }
    float acc[8][8];
#pragma unroll
    for (int i = 0; i < 8; ++i)
#pragma unroll
        for (int j = 0; j < 8; ++j) acc[i][j] = 0.f;
    const int ar = t >> 1, akq = (t & 1) * 8;
    const int bk = t >> 4, bn = (t & 15) * 8;
    const float* ap = A + (size_t)(row0 + ar) * lda + akq;
    const float* bp = B + (size_t)bk * ldb + col0 + bn;
    for (int k0 = 0; k0 < K; k0 += 16) {
        const float4 a0 = *(const float4*)(ap + k0), a1 = *(const float4*)(ap + k0 + 4);
        const float4 b0 = *(const float4*)(bp + (size_t)k0 * ldb), b1 = *(const float4*)(bp + (size_t)k0 * ldb + 4);
        __syncthreads();
        As[akq + 0][ar] = a0.x; As[akq + 1][ar] = a0.y; As[akq + 2][ar] = a0.z; As[akq + 3][ar] = a0.w;
        As[akq + 4][ar] = a1.x; As[akq + 5][ar] = a1.y; As[akq + 6][ar] = a1.z; As[akq + 7][ar] = a1.w;
        *(float4*)&Bs[bk][bn] = b0; *(float4*)&Bs[bk][bn + 4] = b1;
        __syncthreads();
#pragma unroll
        for (int k = 0; k < 16; ++k) {
            float a[8], b[8];
            *(float4*)&a[0] = *(const float4*)&As[k][ty * 8]; *(float4*)&a[4] = *(const float4*)&As[k][ty * 8 + 4];
            *(float4*)&b[0] = *(const float4*)&Bs[k][tx * 8]; *(float4*)&b[4] = *(const float4*)&Bs[k][tx * 8 + 4];
#pragma unroll
            for (int i = 0; i < 8; ++i)
#pragma unroll
                for (int j = 0; j < 8; ++j) acc[i][j] = fmaf(a[i], b[j], acc[i][j]);
        }
    }
#pragma unroll
    for (int i = 0; i < 8; ++i) {
        const int r = row0 + ty * 8 + i;
        float g = 1.f; size_t orow = (size_t)r;
        if (MODE == 1) { const int tok = slot_tok[r]; if (tok < 0) continue; g = slot_gate[r]; orow = (size_t)tok; }
        float* cp = C + orow * ldc + col0 + tx * 8;
#pragma unroll
        for (int j = 0; j < 8; j += 4) {
            const float4 bb = *(const float4*)(bias + col0 + tx * 8 + j);
            float4 v;
            v.x = (acc[i][j] + bb.x) * g; v.y = (acc[i][j + 1] + bb.y) * g; v.z = (acc[i][j + 2] + bb.z) * g; v.w = (acc[i][j + 3] + bb.w) * g;
            if (MODE == 1 && accumulate) { const float4 o = *(const float4*)(cp + j); v.x += o.x; v.y += o.y; v.z += o.z; v.w += o.w; }
            *(float4*)(cp + j) = v;
        }
    }
}

__global__ void __launch_bounds__(256) sgemm_gateup(const float* __restrict__ X, const float* __restrict__ Wgu, const float* __restrict__ bgu,
                                                     float* __restrict__ H, const int* __restrict__ slot_tok, const int* __restrict__ grp_e) {
    __shared__ float As[16][132];
    __shared__ float Bg[16][68];
    __shared__ float Bu[16][68];
    const int t = threadIdx.x, tx = t & 15, ty = t >> 4;
    const int row0 = blockIdx.y * 128, col0 = blockIdx.x * 64;
    const int e = grp_e[row0 / EBLK];
    if (e < 0) return;
    const float* B = Wgu + (size_t)e * D * 2 * DE;
    const float* bias = bgu + (size_t)e * 2 * DE;
    float ag[8][4], au[8][4];
#pragma unroll
    for (int i = 0; i < 8; ++i)
#pragma unroll
        for (int j = 0; j < 4; ++j) { ag[i][j] = 0.f; au[i][j] = 0.f; }
    const int ar = t >> 1, akq = (t & 1) * 8;
    int tok = slot_tok[row0 + ar]; if (tok < 0) tok = 0;
    const float* ap = X + (size_t)tok * D + akq;
    const int bk = t >> 4, bn = (t & 15) * 4;
    const float* bpg = B + (size_t)bk * (2 * DE) + col0 + bn;
    const float* bpu = bpg + DE;
    for (int k0 = 0; k0 < D; k0 += 16) {
        const float4 a0 = *(const float4*)(ap + k0), a1 = *(const float4*)(ap + k0 + 4);
        const float4 g0 = *(const float4*)(bpg + (size_t)k0 * (2 * DE)), u0 = *(const float4*)(bpu + (size_t)k0 * (2 * DE));
        __syncthreads();
        As[akq + 0][ar] = a0.x; As[akq + 1][ar] = a0.y; As[akq + 2][ar] = a0.z; As[akq + 3][ar] = a0.w;
        As[akq + 4][ar] = a1.x; As[akq + 5][ar] = a1.y; As[akq + 6][ar] = a1.z; As[akq + 7][ar] = a1.w;
        *(float4*)&Bg[bk][bn] = g0; *(float4*)&Bu[bk][bn] = u0;
        __syncthreads();
#pragma unroll
        for (int k = 0; k < 16; ++k) {
            float a[8], g[4], u[4];
            *(float4*)&a[0] = *(const float4*)&As[k][ty * 8]; *(float4*)&a[4] = *(const float4*)&As[k][ty * 8 + 4];
            *(float4*)&g[0] = *(const float4*)&Bg[k][tx * 4]; *(float4*)&u[0] = *(const float4*)&Bu[k][tx * 4];
#pragma unroll
            for (int i = 0; i < 8; ++i)
#pragma unroll
                for (int j = 0; j < 4; ++j) { ag[i][j] = fmaf(a[i], g[j], ag[i][j]); au[i][j] = fmaf(a[i], u[j], au[i][j]); }
        }
    }
    const float4 bg = *(const float4*)(bias + col0 + tx * 4), bu = *(const float4*)(bias + DE + col0 + tx * 4);
    const float bgv[4] = {bg.x, bg.y, bg.z, bg.w}, buv[4] = {bu.x, bu.y, bu.z, bu.w};
#pragma unroll
    for (int i = 0; i < 8; ++i) {
        const int r = row0 + ty * 8 + i;
        float o[4];
#pragma unroll
        for (int j = 0; j < 4; ++j) {
            float gate = ag[i][j] + bgv[j], up = au[i][j] + buv[j];
            gate = fminf(gate, 7.0f); up = fminf(fmaxf(up, -7.0f), 7.0f);
            const float sg = 1.0f / (1.0f + expf(-1.702f * gate));
            o[j] = (up + 1.0f) * (gate * sg);
        }
        *(float4*)(H + (size_t)r * DE + col0 + tx * 4) = make_float4(o[0], o[1], o[2], o[3]);
    }
}

__global__ void __launch_bounds__(256) proj_post(float* __restrict__ proj, const int* __restrict__ positions, const float* __restrict__ gn_g, const float* __restrict__ gn_b) {
    const int lane = threadIdx.x & 63, wave = threadIdx.x >> 6;
    const int tok = blockIdx.x * 4 + wave;
    float* p = proj + (size_t)tok * INW;
    const float pos = (float)positions[tok];
    for (int i = lane; i < 80; i += 64) {
        const int h = i >> 3, j = i & 7;
        const float inv = powf(500000.0f, -(float)(2 * j) / 16.0f);
        const float ang = pos * inv;
        const float c = cosf(ang), s = sinf(ang);
        float* q = p + h * 64;
        const float r1 = q[j], r2 = q[j + 8];
        q[j] = r1 * c - r2 * s; q[j + 8] = r2 * c + r1 * s;
    }
    for (int i = lane; i < GW; i += 64) p[OFF_GU + i] = gelu_exact(p[OFF_GU + i]);
    for (int h = 0; h < 8; ++h) {
        float v = gelu_exact(p[OFF_GV + h * 64 + lane]);
        const float mean = wave_sum(v) * (1.f / 64.f);
        const float d = v - mean;
        const float var = wave_sum(d * d) * (1.f / 64.f);
        p[OFF_GV + h * 64 + lane] = d * (1.0f / sqrtf(var + LN_EPS)) * gn_g[lane] + gn_b[lane];
    }
}

__global__ void __launch_bounds__(64) attn_naive(const float* __restrict__ proj, const float* __restrict__ sinks, float* __restrict__ o) {
    const int idx = blockIdx.x * 64 + threadIdx.x;
    const int h = blockIdx.y;
    const int tok = idx, s = tok % SEQ;
    const int kvh = h >> 2;
    float q[64], acc[64];
    const float* qp = proj + (size_t)tok * INW + OFF_Q + h * 64;
#pragma unroll
    for (int d = 0; d < 64; ++d) { q[d] = qp[d] * 0.125f; acc[d] = 0.f; }
    float m = sinks[h], l = 1.0f;
    const int j0 = (s - 127 > 0) ? s - 127 : 0;
    for (int j = j0; j <= s; ++j) {
        const float* kp = proj + (size_t)(tok - s + j) * INW + OFF_K + kvh * 64;
        const float* vp = proj + (size_t)(tok - s + j) * INW + OFF_V + kvh * 64;
        float sc = 0.f;
#pragma unroll
        for (int d = 0; d < 64; d += 4) { const float4 kk = *(const float4*)(kp + d); sc += q[d] * kk.x + q[d + 1] * kk.y + q[d + 2] * kk.z + q[d + 3] * kk.w; }
        const float mn = fmaxf(m, sc);
        const float f = expf(m - mn), pj = expf(sc - mn);
        l = l * f + pj; m = mn;
#pragma unroll
        for (int d = 0; d < 64; d += 4) { const float4 vv = *(const float4*)(vp + d);
            acc[d] = acc[d] * f + pj * vv.x; acc[d + 1] = acc[d + 1] * f + pj * vv.y; acc[d + 2] = acc[d + 2] * f + pj * vv.z; acc[d + 3] = acc[d + 3] * f + pj * vv.w; }
    }
    const float il = 1.0f / l;
    float* op = o + (size_t)tok * D + h * 64;
#pragma unroll
    for (int d = 0; d < 64; ++d) op[d] = acc[d] * il;
}

__global__ void __launch_bounds__(256) gmlp_naive(const float* __restrict__ proj, const float* __restrict__ w_s, const float* __restrict__ b_s, float* __restrict__ o) {
    __shared__ float vs[128][64];
    const int chunk = blockIdx.x, h = blockIdx.y;
    const int tid = threadIdx.x;
    const size_t tok0 = (size_t)chunk * 128;
    for (int i = tid; i < 128 * 64; i += 256) { const int s = i >> 6, d = i & 63; vs[s][d] = proj[(tok0 + s) * INW + OFF_GV + h * 64 + d]; }
    __syncthreads();
    const int t = tid >> 1, d0 = (tid & 1) * 32;
    float acc[32];
#pragma unroll
    for (int d = 0; d < 32; ++d) acc[d] = 0.f;
    const float* wr = w_s + ((size_t)h * 128 + t) * 128;
    for (int s = 0; s <= t; ++s) {
        const float w = wr[s];
#pragma unroll
        for (int d = 0; d < 32; ++d) acc[d] = fmaf(w, vs[s][d0 + d], acc[d]);
    }
    const float bias = b_s[h * 128 + t];
    const float* up = proj + (tok0 + t) * INW + OFF_GU + h * 64 + d0;
    float* op = o + (tok0 + t) * D + ATTW + h * 64 + d0;
#pragma unroll
    for (int d = 0; d < 32; ++d) op[d] = up[d] * (acc[d] + bias);
}

__global__ void __launch_bounds__(256) router_topk(const float* __restrict__ h1, const float* __restrict__ w_router, const float* __restrict__ b_router,
                                                    int* __restrict__ top_e, float* __restrict__ top_g, int* __restrict__ top_pos, int* __restrict__ counts  ) {
    __shared__ float rows[4][D];
    const int lane = threadIdx.x & 63, wave = threadIdx.x >> 6;
    const int tok = blockIdx.x * 4 + wave;
    for (int i = lane; i < D; i += 64) rows[wave][i] = h1[(size_t)tok * D + i];
    __syncthreads();
    const int e = lane & 31, kh = lane >> 5;
    float acc = 0.f;
    for (int k = kh * 512; k < kh * 512 + 512; ++k) acc = fmaf(rows[wave][k], w_router[(size_t)k * NE + e], acc);
    acc += __shfl_xor(acc, 32);
    float logit = acc + b_router[e];
    float vals[4]; int idxs[4];
    float cur = logit;
#pragma unroll
    for (int r = 0; r < 4; ++r) {
        float bv = cur; int bi = e;
#pragma unroll
        for (int o = 1; o < 32; o <<= 1) {
            const float ov = __shfl_xor(bv, o); const int oi = __shfl_xor(bi, o);
            if (ov > bv || (ov == bv && oi < bi)) { bv = ov; bi = oi; }
        }
        vals[r] = bv; idxs[r] = bi;
        if (e == bi) cur = -INFINITY;
    }
    const float m = vals[0];
    const float e0 = 1.0f, e1 = expf(vals[1] - m), e2 = expf(vals[2] - m), e3 = expf(vals[3] - m);
    const float inv = 1.0f / (e0 + e1 + e2 + e3);
    if (lane < 4) {
        const float ee = lane == 0 ? e0 : lane == 1 ? e1 : lane == 2 ? e2 : e3;
        const int ex = lane == 0 ? idxs[0] : lane == 1 ? idxs[1] : lane == 2 ? idxs[2] : idxs[3];
        top_e[tok * 4 + lane] = ex; top_g[tok * 4 + lane] = ee * inv;
        top_pos[tok * 4 + lane] = atomicAdd(&counts[lane * NE + ex], 1);
    }
}

__global__ void __launch_bounds__(64) route_scan(const int* __restrict__ counts, int* __restrict__ pstart  , int* __restrict__ grp_e  ) {
    const int p = blockIdx.x;
    if (threadIdx.x == 0) {
        int off = 0;
        for (int e = 0; e < NE; ++e) {
            pstart[p * NE + e] = off;
            const int c = counts[p * NE + e], ng = (c + EBLK - 1) / EBLK;
            for (int g = 0; g < ng; ++g) grp_e[p * (NPMAX / EBLK) + off / EBLK + g] = e;
            off += ng * EBLK;
        }
        for (int g = off / EBLK; g < NPMAX / EBLK; ++g) grp_e[p * (NPMAX / EBLK) + g] = -1;
    }
}
__global__ void __launch_bounds__(256) route_fill(const int* __restrict__ top_e, const float* __restrict__ top_g, const int* __restrict__ top_pos, const int* __restrict__ pstart,
                                                   int* __restrict__ slot_tok  , float* __restrict__ slot_gate) {
    const int i = blockIdx.x * 256 + threadIdx.x;
    const int tok = i >> 2, p = i & 3;
    const int slot = pstart[p * NE + top_e[i]] + top_pos[i];
    slot_tok[(size_t)p * NPMAX + slot] = tok; slot_gate[(size_t)p * NPMAX + slot] = top_g[i];
}

extern "C" void kernel_launch(void* const* d_in, const int* in_sizes, int n_in, void* d_out, int out_size, void* d_ws, size_t ws_size, hipStream_t stream) {
    const float* x = (const float*)d_in[0]; const int* positions = (const int*)d_in[1];
    const float* ln_in_g = (const float*)d_in[2]; const float* ln_in_b = (const float*)d_in[3];
    const float* w_in = (const float*)d_in[4]; const float* b_in = (const float*)d_in[5];
    const float* sinks = (const float*)d_in[6]; const float* gn_g = (const float*)d_in[7]; const float* gn_b = (const float*)d_in[8];
    const float* w_s = (const float*)d_in[9]; const float* b_s = (const float*)d_in[10];
    const float* w_out = (const float*)d_in[11]; const float* b_out = (const float*)d_in[12];
    const float* ln1_g = (const float*)d_in[13]; const float* ln1_b = (const float*)d_in[14];
    const float* w_router = (const float*)d_in[15]; const float* b_router = (const float*)d_in[16];
    const float* w_gate_up = (const float*)d_in[17]; const float* b_gate_up = (const float*)d_in[18];
    const float* w_down = (const float*)d_in[19]; const float* b_down = (const float*)d_in[20];
    const float* ln2_g = (const float*)d_in[21]; const float* ln2_b = (const float*)d_in[22];
    float* out = (float*)d_out;
    char* ws = (char*)d_ws;
    const size_t MiB = 1u << 20;
    float* h0 = (float*)(ws + 0);
    float* proj = (float*)(ws + 256 * MiB);
    float* o = (float*)(ws + 704 * MiB);
    char* ctl = ws + 960 * MiB;
    int* counts = (int*)ctl;
    int* pstart = counts + 128;
    int* grp_e = pstart + 128;
    int* top_e = grp_e + 4 * (NPMAX / EBLK) + 64;
    float* top_g = (float*)(top_e + T * 4);
    int* top_pos = (int*)(top_g + T * 4);
    int* slot_tok = top_pos + T * 4;
    float* slot_gate = (float*)(slot_tok + 4 * NPMAX);
    float* h1 = h0; float* hmid = proj; float* mix = o;

    ln_rows<<<T / 4, 256, 0, stream>>>(x, nullptr, 1.0f, ln_in_g, ln_in_b, h0, T);
    sgemm128<0><<<dim3(INW / 128, T / 128), 256, 0, stream>>>(h0, D, w_in, INW, b_in, proj, INW, D, nullptr, nullptr, nullptr, 0, 0, 0);
    proj_post<<<T / 4, 256, 0, stream>>>(proj, positions, gn_g, gn_b);
    attn_naive<<<dim3(T / 64, NQH), 64, 0, stream>>>(proj, sinks, o);
    gmlp_naive<<<dim3(T / 128, 8), 256, 0, stream>>>(proj, w_s, b_s, o);
    float* mixbuf = proj;
    sgemm128<0><<<dim3(D / 128, T / 128), 256, 0, stream>>>(o, D, w_out, D, b_out, mixbuf, D, D, nullptr, nullptr, nullptr, 0, 0, 0);
    float* h1buf = o;
    ln_rows<<<T / 4, 256, 0, stream>>>(h0, mixbuf, ALPHA, ln1_g, ln1_b, h1buf, T);
    (void)h1; (void)mix;
    hipMemsetAsync(counts, 0, 128 * sizeof(int), stream);
    hipMemsetAsync(slot_tok, 0xFF, (size_t)4 * NPMAX * sizeof(int), stream);
    router_topk<<<T / 4, 256, 0, stream>>>(h1buf, w_router, b_router, top_e, top_g, top_pos, counts);
    route_scan<<<4, 64, 0, stream>>>(counts, pstart, grp_e);
    route_fill<<<T * 4 / 256, 256, 0, stream>>>(top_e, top_g, top_pos, pstart, slot_tok, slot_gate);
    float* ffn = h0;
    hmid = proj;
    for (int p = 0; p < 4; ++p) {
        const int* st = slot_tok + (size_t)p * NPMAX; const float* sg = slot_gate + (size_t)p * NPMAX; const int* ge = grp_e + p * (NPMAX / EBLK);
        sgemm_gateup<<<dim3(DE / 64, NPMAX / 128), 256, 0, stream>>>(h1buf, w_gate_up, b_gate_up, hmid, st, ge);
        sgemm128<1><<<dim3(D / 128, NPMAX / 128), 256, 0, stream>>>(hmid, DE, w_down, D, b_down, ffn, D, DE, st, sg, ge, (size_t)DE * D, D, p > 0 ? 1 : 0);
    }
    ln_rows<<<T / 4, 256, 0, stream>>>(h1buf, ffn, ALPHA, ln2_g, ln2_b, out, T);
}
```

```cpp
#include <hip/hip_runtime.h>
#include <cstdio>
#include <cstdint>

#define DI __device__ __forceinline__
#define LAS __attribute__((address_space(3)))
#define GAS __attribute__((address_space(1)))
typedef unsigned short bf16_t;
typedef short bf16x8 __attribute__((ext_vector_type(8)));
typedef short s16x4 __attribute__((ext_vector_type(4)));
typedef float f32x2 __attribute__((ext_vector_type(2)));
typedef float f32x4 __attribute__((ext_vector_type(4)));
typedef float f32x16 __attribute__((ext_vector_type(16)));
typedef unsigned u32x2 __attribute__((ext_vector_type(2)));
typedef unsigned u32x4 __attribute__((ext_vector_type(4)));
typedef __bf16 bf16x2_t __attribute__((ext_vector_type(2)));
typedef GAS unsigned gu32;

constexpr int D = 1024, SEQ = 4096, NBATCH = 16, T = NBATCH * SEQ;
constexpr int INW = 1792, NE = 32;
constexpr int NSLOT = T * 4 + NE * 256;
constexpr int NGRP_MAX = NSLOT / 256;
constexpr int CHUNK0_GROUPS = 512;
constexpr int HMID_GROUPS = 592;
constexpr float LN_EPS = 1e-5f;
constexpr float ALPHA = 1.189207115002721f;
constexpr float LOG2E = 1.4426950408889634f;
constexpr float QSCALE = 0.125f * LOG2E;
constexpr int NWAVES = 8, NTHREADS = 512;

constexpr size_t MiB = 1u << 20;
constexpr size_t WS_CTL = 0, CTL_ZERO_BYTES = 65536;
constexpr size_t WS_WGCOUNT = 1 * MiB;
constexpr size_t WS_GRPE = 1 * MiB + 65536;
constexpr size_t WS_OUTC = 1 * MiB + 131072;
constexpr size_t WS_WIN = 2 * MiB;
constexpr size_t WS_WOUT = 6 * MiB;
constexpr size_t WS_WSP = 8 * MiB;
constexpr size_t WS_STATS0 = 9 * MiB;
constexpr size_t WS_ROPE = 10 * MiB;
constexpr size_t WS_WGU = 16 * MiB;
constexpr size_t WS_WD = 144 * MiB;
constexpr size_t WS_TOKE = 208 * MiB;
constexpr size_t WS_TOKG = 209 * MiB;
constexpr size_t WS_TOKL = 210 * MiB;
constexpr size_t WS_SLOTTOK = 211 * MiB;
constexpr size_t WS_SLOTGATE = 212 * MiB + 512 * 1024;
constexpr size_t WS_SLOTDEST = 214 * MiB;
constexpr size_t WS_H0B = 216 * MiB;
constexpr size_t WS_QB = 344 * MiB;
constexpr size_t WS_KB = 408 * MiB;
constexpr size_t WS_VB = 424 * MiB;
constexpr size_t WS_GUB = 440 * MiB;
constexpr size_t WS_GVB = 504 * MiB;
constexpr size_t WS_YSLOT = 216 * MiB;
constexpr size_t WS_HMID = 728 * MiB;
constexpr size_t WS_END = 1024 * MiB;
static_assert(WS_HMID + (size_t)HMID_GROUPS * 256 * 1024 * 2 <= WS_END, "ws map");
static_assert(WS_YSLOT + (size_t)T * 4 * 1024 * 2 <= WS_HMID, "ws map");
constexpr int CW_BAR = 4096;

constexpr int RING_BYTES = 131072;
constexpr int MISC_OFF = RING_BYTES;
constexpr int TOKBUF_OFF = MISC_OFF + 1024;
constexpr int LDS_BYTES = 147456;

DI unsigned cvtpk(float lo, float hi) { f32x2 v = {lo, hi}; bf16x2_t b = __builtin_convertvector(v, bf16x2_t); return __builtin_bit_cast(unsigned, b); }
DI float bf2f(unsigned short h) { return __uint_as_float((unsigned)h << 16); }
DI float bflo(unsigned w) { return __uint_as_float(w << 16); }
DI float bfhi(unsigned w) { return __uint_as_float(w & 0xffff0000u); }
DI float wave_sum(float v) {
#pragma unroll
    for (int o = 1; o < 64; o <<= 1) v += __shfl_xor(v, o);
    return v;
}
#define LDS_WAIT() asm volatile("s_waitcnt lgkmcnt(0)" ::: "memory")
#define VM_WAIT() asm volatile("s_waitcnt vmcnt(0)" ::: "memory")

DI f32x2 gelu_pk(f32x2 v) {
    const f32x2 av = __builtin_elementwise_abs(v), d = av * 0.2316418882f + 1.0f;
    f32x2 t; t.x = __builtin_amdgcn_rcpf(d.x); t.y = __builtin_amdgcn_rcpf(d.y);
    f32x2 q = t * 0.5307027145f + (-0.7265760135f); q = q * t + 0.7107068705f; q = q * t + (-0.142248368f); q = q * t + 0.127414796f; q = q * t;
    const f32x2 s = (v * v) * (-0.72134752044f);
    f32x2 e; e.x = __builtin_amdgcn_exp2f(s.x); e.y = __builtin_amdgcn_exp2f(s.y);
    const f32x2 m = v * (q * e), r = v - m;
    f32x2 o; o.x = v.x < 0.f ? m.x : r.x; o.y = v.y < 0.f ? m.y : r.y; return o;
}
DI f32x4 gelu4(f32x4 v) { f32x2 a = gelu_pk((f32x2){v[0], v[1]}), b = gelu_pk((f32x2){v[2], v[3]}); return (f32x4){a.x, a.y, b.x, b.y}; }


struct Frame { int tid, lane, wave, bid; };
DI Frame opaque(const Frame& f) { Frame r; r.tid = threadIdx.x; asm volatile("" : "+v"(r.tid)); r.lane = r.tid & 63; r.wave = __builtin_amdgcn_readfirstlane(r.tid >> 6); r.bid = f.bid; return r; }
constexpr int G = 256;
template <int K> DI const float* inp() { const float* p; asm volatile("s_load_dwordx2 %0, %1, %2\n\ts_waitcnt lgkmcnt(0)" : "=s"(p) : "s"(__builtin_amdgcn_kernarg_segment_ptr()), "i"(K * 8)); return p; }
DI float* outp() { float* p; asm volatile("s_load_dwordx2 %0, %1, %2\n\ts_waitcnt lgkmcnt(0)" : "=s"(p) : "s"(__builtin_amdgcn_kernarg_segment_ptr()), "i"(23 * 8)); return p; }
DI unsigned char* wsp() { unsigned char* p; asm volatile("s_load_dwordx2 %0, %1, %2\n\ts_waitcnt lgkmcnt(0)" : "=s"(p) : "s"(__builtin_amdgcn_kernarg_segment_ptr()), "i"(24 * 8)); return p; }
enum { I_X = 0, I_POS = 1, I_LNING = 2, I_LNINB = 3, I_WIN = 4, I_BIN = 5, I_SINKS = 6, I_GNG = 7, I_GNB = 8, I_WS = 9, I_BS = 10, I_WOUT = 11, I_BOUT = 12, I_LN1G = 13, I_LN1B = 14,
       I_WR = 15, I_BR = 16, I_WGU = 17, I_BGU = 18, I_WD = 19, I_BD = 20, I_LN2G = 21, I_LN2B = 22 };

#define XB_TMO      128
#define XB_XCNT(j)  (256  + 64 * (j))
#define XB_XSUB(j)  (1280 + 64 * (j))
#define XB_XGEN(j)  (2304 + 64 * (j))
#define XB_TOP      3328
#define XB_TOPGEN   3392
#define XCD_BAR_WORDS 3456
#define XB_SPIN_CAP (1u << 18)
DI unsigned xb_ld(unsigned* p)              { return __hip_atomic_load(p, __ATOMIC_RELAXED, __HIP_MEMORY_SCOPE_AGENT); }
DI unsigned xb_add(unsigned* p, unsigned v) { return __hip_atomic_fetch_add(p, v, __ATOMIC_RELAXED, __HIP_MEMORY_SCOPE_AGENT); }
DI unsigned xb_xcc_id() { return (unsigned)__builtin_amdgcn_s_getreg((3 << 11) | 20) & 0xFu; }
#define XB_SPIN(cond, bar) do { unsigned _sp = 0; while (cond) { __builtin_amdgcn_s_sleep(1); \
    if ((++_sp & 255u) == 0u) { if (xb_ld(&(bar)[XB_TMO])) break; if (_sp > XB_SPIN_CAP) { atomicAdd(&(bar)[XB_TMO], 1u); break; } } } } while (0)
DI void xcd_barrier_post(unsigned* bar) { if (threadIdx.x == 0) (void)xb_add(&bar[XB_XCNT(xb_xcc_id())], 1u); }
DI void xcd_barrier_complete(unsigned* bar, unsigned x, unsigned& nloc, unsigned& nx) {
    unsigned sum, cnt, mine, sp = 0u;
    for (;;) {
        sum = 0u; cnt = 0u; mine = 0u;
#pragma unroll
        for (unsigned j = 0; j < 16; ++j) { const unsigned c = xb_ld(&bar[XB_XCNT(j)]); sum += c; cnt += (c > 0u) ? 1u : 0u; mine = (j == x) ? c : mine; }
        if (sum == (unsigned)G) break;
        __builtin_amdgcn_s_sleep(1);
        if ((++sp & 255u) == 0u) { if (xb_ld(&bar[XB_TMO])) break; if (sp > XB_SPIN_CAP) { atomicAdd(&bar[XB_TMO], 1u); break; } }
    }
    nloc = mine > 0u ? mine : 1u; nx = cnt > 0u ? cnt : 1u;
}
DI void xcd_barrier(volatile LAS unsigned* st) {
    asm volatile("s_waitcnt vmcnt(0)" ::: "memory");
    __syncthreads();
    if (threadIdx.x == 0) {
        unsigned* bar = (unsigned*)(wsp() + WS_CTL) + CW_BAR; const unsigned x = xb_xcc_id();
        __builtin_amdgcn_s_waitcnt(0);
        unsigned nloc = st[0], nx = st[1];
        if (nloc == 0u) { xcd_barrier_complete(bar, x, nloc, nx); st[0] = nloc; st[1] = nx; }
        const unsigned old = xb_add(&bar[XB_XSUB(x)], 1u);
        const unsigned gen = old / nloc;
        if (old + 1u == (gen + 1u) * nloc) {
            __builtin_amdgcn_fence(__ATOMIC_RELEASE, "agent");
            asm volatile("s_waitcnt vmcnt(0)" ::: "memory");
            const unsigned og = xb_add(&bar[XB_TOP], 1u);
            const unsigned tg = og / nx;
            if (og + 1u == (tg + 1u) * nx) xb_add(&bar[XB_TOPGEN], 1u);
            else XB_SPIN(xb_ld(&bar[XB_TOPGEN]) == tg, bar);
            __builtin_amdgcn_fence(__ATOMIC_ACQUIRE, "agent");
            xb_add(&bar[XB_XGEN(x)], 1u);
            asm volatile("s_waitcnt vmcnt(0)" ::: "memory");
        } else {
            XB_SPIN(xb_ld(&bar[XB_XGEN(x)]) == gen, bar);
            __builtin_amdgcn_fence(__ATOMIC_ACQUIRE, "agent");
            asm volatile("s_waitcnt vmcnt(0)" ::: "memory");
        }
    }
    __syncthreads();
}

namespace pg8 {
constexpr int BM = 256, BK = 64, HALF = 128, HTB = HALF * BK * 2, NXCD = 8, WGM = 8, GK = 1024, NT = GK / BK;
constexpr size_t KSTEP = BK * 2, HSTEP = (size_t)HALF * GK * 2, TSTEP = 2 * HSTEP;
DI int lds_byte(int r, int c) { const int st = (r >> 4) * 2 + (c >> 5), rr = r & 15, cc = c & 31, ob = rr * 64 + cc * 2; return st * 1024 + (ob ^ (((ob >> 9) & 1) << 5)); }
DI void stage_rc(int b, int& R, int& C) { const int st = b / 1024, sb = b % 1024, swz = sb ^ (((sb >> 9) & 1) << 5); R = (st >> 1) * 16 + swz / 64; C = (st & 1) * 32 + (swz % 64) / 2; }
DI int perm32(int rho) { const int n = rho >> 4, i = rho & 15; return 8 * (i >> 2) + 4 * n + (i & 3); }

struct Unit { int pm, pn, e; };

template <int M, int N> struct StaticOrder {
    int c;
    DI bool next(int i, Unit& u) const {
        constexpr int nM = M / BM, nN = N / BM, nwg = nM * nN;
        const int L = i * G + c; if (L >= nwg) return false;
        int wgid = L; { constexpr int q = nwg / NXCD, r = nwg % NXCD; const int xcd = wgid % NXCD, off = wgid / NXCD; wgid = (xcd < r ? xcd * (q + 1) : r * (q + 1) + (xcd - r) * q) + off; }
        constexpr int nig = WGM * nN; const int gid = wgid / nig, fm = gid * WGM, gsz = (nM - fm) < WGM ? (nM - fm) : WGM;
        u.pm = fm + ((wgid % nig) % gsz); u.pn = (wgid % nig) / gsz; u.e = 0; return true;
    }
};
template <int NPN> struct GroupOrder {
    int g0, g1, c;
    DI bool next(int i, Unit& u) const {
        constexpr int GPX = 32 / NPN;
        const int x = c & 7, j = c >> 3;
        const int g = g0 + i * (8 * GPX) + x * GPX + j / NPN;
        if (g >= g1) return false;
        u.pm = g; u.pn = j % NPN;
        u.e = __builtin_amdgcn_readfirstlane((int)__hip_atomic_load((unsigned*)(wsp() + WS_GRPE) + g, __ATOMIC_RELAXED, __HIP_MEMORY_SCOPE_AGENT));
        return true;
    }
};
DI void piece_rc(int i, int& R, int& C) { int t = threadIdx.x; asm volatile("" : "+v"(t)); stage_rc(t * 16 + i * 8192, R, C); }
DI unsigned tok_off(const LAS int* tb, int h, int i, unsigned pitch) { int R, C; piece_rc(i, R, C); int tok = tb[h * HALF + R]; tok = tok < 0 ? 0 : tok; return (unsigned)tok * pitch + (unsigned)C * 2u; }

template <class Cfg, class Epi, class Sched>
DI void gemm_phase(LAS unsigned char* lds, LAS unsigned char* tokbuf, const int pm_bias, const Sched& S, const Epi& E) {
    constexpr bool GATHER = Cfg::GATHER;
    int tid = threadIdx.x; asm volatile("" : "+v"(tid));
    const int wid = __builtin_amdgcn_readfirstlane(tid >> 6), lane = tid & 63, wr = wid >> 2, wc = wid & 3, fr = lane & 15, fq = lane >> 4;
    unsigned voffB[2], vaC[2][2];
#pragma unroll
    for (int i = 0; i < 2; ++i) { int R, C; stage_rc(tid * 16 + i * 8192, R, C); const int Rb = Epi::PERM ? ((R & ~31) + perm32(R & 31)) : R;
        voffB[i] = (unsigned)(Rb * GK + C) * 2u; vaC[0][i] = (unsigned)(R * GK + C) * 2u; vaC[1][i] = vaC[0][i]; }
    constexpr size_t AHSTEP = GATHER ? (size_t)0 : HSTEP;
    const unsigned ldsw = (unsigned)wid * 1024u;
    const int aoff = lds_byte(wr * 64 + fr, fq * 8), boff = lds_byte(wc * 32 + fr, fq * 8);
#define PG8_SA(b, h) (((b) * 2 + (h)) * HTB)
#define PG8_SB(b, h) ((4 + (b) * 2 + (h)) * HTB)
#define PG8_STAGEB(bufoff, gbase) do { _Pragma("unroll") for (int _i = 0; _i < 2; ++_i) \
        __builtin_amdgcn_global_load_lds((const unsigned*)((const char*)(gbase) + voffB[_i]), (LAS unsigned*)(lds + (bufoff) + ldsw + _i * 8192), 16, 0, 0); } while (0)
#define PG8_STAGEA(bufoff, gbase, o0, o1) do { \
        __builtin_amdgcn_global_load_lds((const unsigned*)((const char*)(gbase) + (o0)), (LAS unsigned*)(lds + (bufoff) + ldsw), 16, 0, 0); \
        __builtin_amdgcn_global_load_lds((const unsigned*)((const char*)(gbase) + (o1)), (LAS unsigned*)(lds + (bufoff) + ldsw + 8192), 16, 0, 0); } while (0)
#define PG8_LDA(dst, b, h) do { _Pragma("unroll") for (int m = 0; m < 4; ++m) _Pragma("unroll") for (int k = 0; k < 2; ++k) dst[m][k] = *(const LAS bf16x8*)(lds + PG8_SA(b, h) + aoff + m * 2048 + k * 1024); } while (0)
#define PG8_LDB(dst, b, h) do { _Pragma("unroll") for (int n = 0; n < 2; ++n) _Pragma("unroll") for (int k = 0; k < 2; ++k) dst[n][k] = *(const LAS bf16x8*)(lds + PG8_SB(b, h) + boff + n * 2048 + k * 1024); } while (0)
#define PG8_MMA(ai, bj, At, Bt) do { __builtin_amdgcn_s_setprio(1); _Pragma("unroll") for (int m = 0; m < 4; ++m) _Pragma("unroll") for (int n = 0; n < 2; ++n) _Pragma("unroll") for (int k = 0; k < 2; ++k) \
        acc[ai][bj][m][n] = __builtin_amdgcn_mfma_f32_16x16x32_bf16(Bt[n][k], At[m][k], acc[ai][bj][m][n], 0, 0, 0); __builtin_amdgcn_s_setprio(0); } while (0)
#define PG8_WAIT_V(n) asm volatile("s_waitcnt vmcnt(" #n ")" ::: "memory")
#define PG8_WAIT_L(n) asm volatile("s_waitcnt lgkmcnt(" #n ")" ::: "memory")
#define PG8_BAR __builtin_amdgcn_s_barrier()
#define PG8_SCHED __builtin_amdgcn_sched_barrier(0)
#define PG8_ABASE(u) (GATHER ? (const char*)outp() : (const char*)wsp() + Cfg::A_OFF + (size_t)((u).pm - pm_bias) * TSTEP)
#define PG8_BBASE(u) ((const char*)wsp() + Cfg::B_OFF + (size_t)(u).e * Cfg::B_E_BYTES + (size_t)(u).pn * TSTEP)
#define PG8_TOKSRC(u) ((const unsigned*)((const int*)(wsp() + WS_SLOTTOK) + (size_t)(u).pm * 256 + lane * 4))
    Unit cur, nxt; int ui = 0;
    if (!S.next(0, cur)) return;
    if constexpr (GATHER) {
        if (wid == 0) __builtin_amdgcn_global_load_lds(PG8_TOKSRC(cur), (LAS unsigned*)(tokbuf), 16, 0, 0);
        PG8_WAIT_V(0); PG8_BAR;
#pragma unroll
        for (int h = 0; h < 2; ++h)
#pragma unroll
            for (int i = 0; i < 2; ++i) vaC[h][i] = tok_off((const LAS int*)tokbuf, h, i, 4096u);
        PG8_WAIT_L(0); PG8_BAR;
    }
    f32x4 acc[2][2][4][2];
#pragma unroll
    for (int a = 0; a < 2; ++a)
#pragma unroll
        for (int b = 0; b < 2; ++b)
#pragma unroll
            for (int m = 0; m < 4; ++m)
#pragma unroll
                for (int n = 0; n < 2; ++n) acc[a][b][m][n] = (f32x4){0.f, 0.f, 0.f, 0.f};
    bf16x8 At[4][2], B0[2][2], B1[2][2];
    const char* cA = PG8_ABASE(cur);
    const char* cB = PG8_BBASE(cur);
    PG8_STAGEB(PG8_SB(0, 0), cB); PG8_STAGEB(PG8_SB(0, 1), cB + HSTEP); PG8_STAGEA(PG8_SA(0, 0), cA, vaC[0][0], vaC[0][1]); PG8_STAGEA(PG8_SA(0, 1), cA + AHSTEP, vaC[1][0], vaC[1][1]);
    if (wr == 1) PG8_BAR;
    PG8_WAIT_V(2); PG8_BAR;
    PG8_STAGEB(PG8_SB(1, 0), cB + KSTEP); PG8_STAGEA(PG8_SA(1, 0), cA + KSTEP, vaC[0][0], vaC[0][1]); PG8_STAGEB(PG8_SB(1, 1), cB + HSTEP + KSTEP);
    PG8_WAIT_V(6); PG8_BAR;
    for (;;) {
        const bool has_next = S.next(ui + 1, nxt);
        const LAS int* tbn = (const LAS int*)(tokbuf + ((ui + 1) & 1) * 1024);
        if constexpr (GATHER) {
            if (has_next && wid == 0) __builtin_amdgcn_global_load_lds(PG8_TOKSRC(nxt), (LAS unsigned*)(tokbuf + ((ui + 1) & 1) * 1024), 16, 0, 0);
        }
#pragma unroll 1
        for (int t = 0; t < NT; t += 2) {
            const bool last = (t == NT - 2);
            const char* a1 = cA + (size_t)(t + 1) * KSTEP;
            const char* a2 = cA + (size_t)(t + 2) * KSTEP; const char* b2 = cB + (size_t)(t + 2) * KSTEP;
            unsigned o00 = vaC[0][0], o01 = vaC[0][1], o10 = vaC[1][0], o11 = vaC[1][1];
            if (last) {
                if (has_next) { a2 = PG8_ABASE(nxt); b2 = PG8_BBASE(nxt);
                    if constexpr (GATHER) { o00 = tok_off(tbn, 0, 0, 4096u); o01 = tok_off(tbn, 0, 1, 4096u); o10 = tok_off(tbn, 1, 0, 4096u); o11 = tok_off(tbn, 1, 1, 4096u); } }
                else { a2 = cA; b2 = cB; }
            }
            const char* a3 = a2 + KSTEP; const char* b3 = b2 + KSTEP;
            PG8_LDB(B0, 0, 0); PG8_LDB(B1, 0, 1); PG8_SCHED; PG8_LDA(At, 0, 0); PG8_STAGEA(PG8_SA(1, 1), a1 + AHSTEP, vaC[1][0], vaC[1][1]);
            PG8_WAIT_V(8); PG8_WAIT_L(0); PG8_BAR; PG8_MMA(0, 0, At, B0); PG8_MMA(0, 1, At, B1); PG8_BAR; PG8_SCHED;
            PG8_LDA(At, 0, 1); PG8_STAGEB(PG8_SB(0, 0), b2); PG8_STAGEB(PG8_SB(0, 1), b2 + HSTEP); PG8_STAGEA(PG8_SA(0, 0), a2, o00, o01);
            PG8_WAIT_V(8); PG8_WAIT_L(0); PG8_BAR; PG8_MMA(1, 0, At, B0); PG8_MMA(1, 1, At, B1); PG8_BAR; PG8_SCHED;
            PG8_LDB(B0, 1, 0); PG8_LDB(B1, 1, 1); PG8_SCHED; PG8_LDA(At, 1, 0); PG8_STAGEA(PG8_SA(0, 1), a2 + AHSTEP, o10, o11);
            PG8_WAIT_V(8); PG8_WAIT_L(0); PG8_BAR; PG8_MMA(0, 0, At, B0); PG8_MMA(0, 1, At, B1); PG8_BAR; PG8_SCHED;
            PG8_LDA(At, 1, 1); PG8_STAGEB(PG8_SB(1, 0), b3); PG8_STAGEB(PG8_SB(1, 1), b3 + HSTEP); PG8_STAGEA(PG8_SA(1, 0), a3, o00, o01);
            PG8_WAIT_V(8); PG8_WAIT_L(0); PG8_BAR; PG8_MMA(1, 0, At, B0); PG8_MMA(1, 1, At, B1); PG8_BAR; PG8_SCHED;
        }
        if (wr == 0) PG8_BAR;
        E(acc, cur, wr, wc, fr, fq);
        if (!has_next) break;
#pragma unroll
        for (int a = 0; a < 2; ++a)
#pragma unroll
            for (int b = 0; b < 2; ++b)
#pragma unroll
                for (int m = 0; m < 4; ++m)
#pragma unroll
                    for (int n = 0; n < 2; ++n) acc[a][b][m][n] = (f32x4){0.f, 0.f, 0.f, 0.f};
        if constexpr (GATHER) {
#pragma unroll
            for (int h = 0; h < 2; ++h)
#pragma unroll
                for (int i = 0; i < 2; ++i) vaC[h][i] = tok_off(tbn, h, i, 4096u);
            PG8_WAIT_L(0);
        }
        cur = nxt; cA = PG8_ABASE(cur); cB = PG8_BBASE(cur); ++ui;
        if (wr == 1) PG8_BAR;
    }
    PG8_WAIT_V(0);
    PG8_BAR;
#undef PG8_SA
#undef PG8_SB
#undef PG8_STAGEA
#undef PG8_STAGEB
#undef PG8_LDA
#undef PG8_LDB
#undef PG8_MMA
#undef PG8_WAIT_V
#undef PG8_WAIT_L
#undef PG8_BAR
#undef PG8_SCHED
#undef PG8_ABASE
#undef PG8_BBASE
#undef PG8_TOKSRC
}
}

struct EpiInProj {
    static constexpr bool PERM = true;
    DI void operator()(f32x4 (&acc)[2][2][4][2], const pg8::Unit& u, int wr, int wc, int fr, int fq) const {
        const int pn = u.pn;
        int kind, head, ldc; size_t boff;
        if (pn < 2) { kind = 0; head = 4 * pn + wc; boff = WS_QB; ldc = 512; }
        else if (pn == 2) { if (wc < 2) { kind = 1; head = wc; boff = WS_KB; } else { kind = 2; head = wc - 2; boff = WS_VB; } ldc = 128; }
        else if (pn < 5) { kind = 3; head = 4 * (pn - 3) + wc; boff = WS_GUB; ldc = 512; }
        else { kind = 4; head = 4 * (pn - 5) + wc; boff = WS_GVB; ldc = 512; }
        unsigned char* ws = wsp();
        bf16_t* base = (bf16_t*)(ws + boff);
        const float* b_in = inp<I_BIN>();
        const int src0 = 256 * pn + 64 * wc + 8 * fq;
#pragma unroll
        for (int bj = 0; bj < 2; ++bj)
#pragma unroll
            for (int n = 0; n < 2; ++n) { const f32x4 bv = *(const f32x4*)(b_in + src0 + 32 * bj + 4 * n);
#pragma unroll
                for (int ai = 0; ai < 2; ++ai)
#pragma unroll
                    for (int m = 0; m < 4; ++m) acc[ai][bj][m][n] += bv; }
        const float* rope = (const float*)(ws + WS_ROPE);
        const float* gn_g = inp<I_GNG>(); const float* gn_b = inp<I_GNB>();
        const int row0 = u.pm * 256 + wr * 64 + fr;
#pragma unroll
        for (int ai = 0; ai < 2; ++ai)
#pragma unroll
            for (int m = 0; m < 4; ++m) {
                const int row = row0 + ai * 128 + m * 16;
                f32x4 v[2][2];
#pragma unroll
                for (int bj = 0; bj < 2; ++bj)
#pragma unroll
                    for (int n = 0; n < 2; ++n) v[bj][n] = acc[ai][bj][m][n];
                if (kind <= 1) {
                    const float* cs = rope + (size_t)row * 16;
#pragma unroll
                    for (int n = 0; n < 2; ++n) {
                        const f32x4 c4 = *(const f32x4*)(cs + 4 * n), s4 = *(const f32x4*)(cs + 8 + 4 * n);
                        f32x4 p4; p4[0] = __shfl_xor(v[0][n][0], 16); p4[1] = __shfl_xor(v[0][n][1], 16); p4[2] = __shfl_xor(v[0][n][2], 16); p4[3] = __shfl_xor(v[0][n][3], 16);
                        const f32x4 sg = (fq & 1) ? s4 : -s4;
                        const f32x4 rot = v[0][n] * c4 + p4 * sg;
                        if (fq < 2) v[0][n] = rot;
                    }
                    if (kind == 0) {
#pragma unroll
                        for (int bj = 0; bj < 2; ++bj)
#pragma unroll
                            for (int n = 0; n < 2; ++n) v[bj][n] = v[bj][n] * QSCALE;
                    }
                } else if (kind >= 3) {
#pragma unroll
                    for (int bj = 0; bj < 2; ++bj)
#pragma unroll
                        for (int n = 0; n < 2; ++n) v[bj][n] = gelu4(v[bj][n]);
                    if (kind == 4) {
                        float s = 0.f;
#pragma unroll
                        for (int bj = 0; bj < 2; ++bj)
#pragma unroll
                            for (int n = 0; n < 2; ++n) s += (v[bj][n][0] + v[bj][n][1]) + (v[bj][n][2] + v[bj][n][3]);
                        s += __shfl_xor(s, 16); s += __shfl_xor(s, 32);
                        const float mean = s * (1.0f / 64.0f); float q = 0.f;
#pragma unroll
                        for (int bj = 0; bj < 2; ++bj)
#pragma unroll
                            for (int n = 0; n < 2; ++n) { v[bj][n] = v[bj][n] - mean; const f32x4 d = v[bj][n]; q += (d[0] * d[0] + d[1] * d[1]) + (d[2] * d[2] + d[3] * d[3]); }
                        q += __shfl_xor(q, 16); q += __shfl_xor(q, 32);
                        const float rstd = 1.0f / sqrtf(q * (1.0f / 64.0f) + LN_EPS);
#pragma unroll
                        for (int bj = 0; bj < 2; ++bj)
#pragma unroll
                            for (int n = 0; n < 2; ++n) v[bj][n] = v[bj][n] * rstd * *(const f32x4*)(gn_g + 32 * bj + 8 * fq + 4 * n) + *(const f32x4*)(gn_b + 32 * bj + 8 * fq + 4 * n);
                    }
                }
                bf16_t* rowp = base + (size_t)row * ldc + head * 64 + 8 * fq;
#pragma unroll
                for (int bj = 0; bj < 2; ++bj) { u32x4 w; w.x = cvtpk(v[bj][0][0], v[bj][0][1]); w.y = cvtpk(v[bj][0][2], v[bj][0][3]); w.z = cvtpk(v[bj][1][0], v[bj][1][1]); w.w = cvtpk(v[bj][1][2], v[bj][1][3]);
                    *(u32x4*)(rowp + 32 * bj) = w; }
            }
    }
};
struct EpiOut {
    static constexpr bool PERM = false;
    DI void operator()(f32x4 (&acc)[2][2][4][2], const pg8::Unit& u, int wr, int wc, int fr, int fq) const {
        const int col0 = u.pn * 256 + wc * 32 + 4 * fq;
        unsigned char* ws = wsp(); float* y1 = outp();
        const float* outc = (const float*)(ws + WS_OUTC); const float* stats0 = (const float*)(ws + WS_STATS0);
        const float* x = inp<I_X>();
        f32x4 ca[2][2];
#pragma unroll
        for (int bj = 0; bj < 2; ++bj)
#pragma unroll
            for (int n = 0; n < 2; ++n) { ca[bj][n] = *(const f32x4*)(outc + col0 + bj * 128 + n * 16); const f32x4 cb = *(const f32x4*)(outc + 1024 + col0 + bj * 128 + n * 16);
#pragma unroll
                for (int ai = 0; ai < 2; ++ai)
#pragma unroll
                    for (int m = 0; m < 4; ++m) acc[ai][bj][m][n] += cb; }
        const int row0 = u.pm * 256 + wr * 64 + fr;
#pragma unroll
        for (int ai = 0; ai < 2; ++ai)
#pragma unroll
            for (int m = 0; m < 4; ++m) {
                const int row = row0 + ai * 128 + m * 16;
                const f32x2 st = *(const f32x2*)(stats0 + (size_t)row * 2);
                const size_t off = (size_t)row * D + col0;
#pragma unroll
                for (int bj = 0; bj < 2; ++bj)
#pragma unroll
                    for (int n = 0; n < 2; ++n) { const f32x4 xv = *(const f32x4*)(x + off + bj * 128 + n * 16);
                        const f32x4 o = acc[ai][bj][m][n] + (xv - st.x) * st.y * ca[bj][n];
                        *(f32x4*)(y1 + off + bj * 128 + n * 16) = o; }
                if (m & 1) asm volatile("" ::: "memory");
            }
    }
};
struct EpiGateUp {
    static constexpr bool PERM = true;
    int g0;
    DI void operator()(f32x4 (&acc)[2][2][4][2], const pg8::Unit& u, int wr, int wc, int fr, int fq) const {
        const int hcol0 = 128 * u.pn + 32 * wc + 8 * fq;
        const float* bias = inp<I_BGU>() + (size_t)u.e * 2048;
        bf16_t* hmid = (bf16_t*)(wsp() + WS_HMID);
        f32x4 bg[2], bu[2];
#pragma unroll
        for (int n = 0; n < 2; ++n) { bg[n] = *(const f32x4*)(bias + hcol0 + 4 * n); bu[n] = *(const f32x4*)(bias + 1024 + hcol0 + 4 * n); }
        const size_t row0 = (size_t)(u.pm - g0) * 256 + wr * 64 + fr;
#pragma unroll
        for (int ai = 0; ai < 2; ++ai)
#pragma unroll
            for (int m = 0; m < 4; ++m) {
                float h[2][4];
#pragma unroll
                for (int n = 0; n < 2; ++n) {
                    const f32x4 gt = acc[ai][0][m][n] + bg[n], up = acc[ai][1][m][n] + bu[n];
#pragma unroll
                    for (int j = 0; j < 4; ++j) {
                        const float gc = fminf(gt[j], 7.0f), uc = fminf(fmaxf(up[j], -7.0f), 7.0f);
                        const float sg = __builtin_amdgcn_rcpf(1.0f + __builtin_amdgcn_exp2f(gc * (-1.702f * LOG2E)));
                        h[n][j] = (uc + 1.0f) * (gc * sg);
                    }
                }
                u32x4 w; w.x = cvtpk(h[0][0], h[0][1]); w.y = cvtpk(h[0][2], h[0][3]); w.z = cvtpk(h[1][0], h[1][1]); w.w = cvtpk(h[1][2], h[1][3]);
                *(u32x4*)(hmid + (row0 + ai * 128 + m * 16) * 1024 + hcol0) = w;
            }
    }
};
struct EpiDown {
    static constexpr bool PERM = true;
    DI void operator()(f32x4 (&acc)[2][2][4][2], const pg8::Unit& u, int wr, int wc, int fr, int fq) const {
        const int col0 = 256 * u.pn + 32 * wc + 8 * fq;
        const float* bias = inp<I_BD>() + (size_t)u.e * 1024;
        unsigned char* ws = wsp();
        bf16_t* yslot = (bf16_t*)(ws + WS_YSLOT); const int* slot_dest = (const int*)(ws + WS_SLOTDEST); const float* slot_gate = (const float*)(ws + WS_SLOTGATE);
        f32x4 bd[2][2];
#pragma unroll
        for (int bj = 0; bj < 2; ++bj)
#pragma unroll
            for (int n = 0; n < 2; ++n) bd[bj][n] = *(const f32x4*)(bias + col0 + 128 * bj + 4 * n);
        const int slot0 = u.pm * 256 + wr * 64 + fr;
#pragma unroll
        for (int ai = 0; ai < 2; ++ai)
#pragma unroll
            for (int m = 0; m < 4; ++m) {
                const int slot = slot0 + ai * 128 + m * 16;
                const int dest = slot_dest[slot];
                const float gt = slot_gate[slot];
                if (dest >= 0) {
                    bf16_t* rowp = yslot + (size_t)dest * 1024 + col0;
#pragma unroll
                    for (int bj = 0; bj < 2; ++bj) { const f32x4 v0 = (acc[ai][bj][m][0] + bd[bj][0]) * gt, v1 = (acc[ai][bj][m][1] + bd[bj][1]) * gt;
                        u32x4 w; w.x = cvtpk(v0[0], v0[1]); w.y = cvtpk(v0[2], v0[3]); w.z = cvtpk(v1[0], v1[1]); w.w = cvtpk(v1[2], v1[3]);
                        *(u32x4*)(rowp + 128 * bj) = w; }
                }
            }
    }
};

DI int rowmap(int kind, int n) {
    if (kind == 0) { const int pn = n >> 8, ch = n & 255, wc = ch >> 6, bj = (ch >> 5) & 1, w = ch & 31; return (pn << 8) + (bj << 7) + (wc << 5) + w; }
    if (kind == 2) { return n < 1024 ? ((n >> 7) << 8) + (n & 127) : (((n - 1024) >> 7) << 8) + 128 + ((n - 1024) & 127); }
    return n;
}
DI void p0_transpose_item(const float* W, int K, int N, bf16_t* WT, int kind, LAS float* scr, int item, int lane) {
    const int nblk = N / 32, kb = item / nblk, nb = item % nblk, k0 = 64 * kb, n0 = 32 * nb;
#pragma unroll 8
    for (int i = 0; i < 32; ++i) { const int kk = 2 * i + (lane >> 5); scr[kk * 33 + (lane & 31)] = W[(size_t)(k0 + kk) * N + n0 + (lane & 31)]; }
    LDS_WAIT(); asm volatile("" ::: "memory");
    const int c = lane & 7;
#pragma unroll
    for (int j = 0; j < 4; ++j) { const int n = (lane >> 3) + 8 * j; const LAS float* s = scr + (8 * c) * 33 + n;
        u32x4 o; o.x = cvtpk(s[0 * 33], s[1 * 33]); o.y = cvtpk(s[2 * 33], s[3 * 33]); o.z = cvtpk(s[4 * 33], s[5 * 33]); o.w = cvtpk(s[6 * 33], s[7 * 33]);
        *(GAS u32x4*)(WT + (size_t)rowmap(kind, n0 + n) * K + k0 + 8 * c) = o; }
    LDS_WAIT(); asm volatile("" ::: "memory");
}
DI void p0_prologue(const Frame& F0, LAS unsigned char* lds) {
    const Frame F = opaque(F0);
    unsigned char* ws = wsp();
    LAS float* scr = (LAS float*)(lds + F.wave * 16384);
    const int gw = F.bid * NWAVES + F.wave, NGW = G * NWAVES;
    const int gt = F.bid * NTHREADS + F.tid, NGT = G * NTHREADS;
    constexpr int I_IN = (D / 64) * (INW / 32), I_OUT = (D / 64) * (D / 32), I_GU = (D / 64) * (2048 / 32), I_D = (D / 64) * (D / 32);
    constexpr int NITEMS = I_IN + I_OUT + NE * (I_GU + I_D);
    for (int it = gw; it < NITEMS; it += NGW) {
        int r = it;
        if (r < I_IN) { p0_transpose_item(inp<I_WIN>(), D, INW, (bf16_t*)(ws + WS_WIN), 0, scr, r, F.lane); continue; } r -= I_IN;
        if (r < I_OUT) { p0_transpose_item(inp<I_WOUT>(), D, D, (bf16_t*)(ws + WS_WOUT), 1, scr, r, F.lane); continue; } r -= I_OUT;
        if (r < NE * I_GU) { const int e = r / I_GU; p0_transpose_item(inp<I_WGU>() + (size_t)e * D * 2048, D, 2048, (bf16_t*)(ws + WS_WGU) + (size_t)e * 2048 * D, 2, scr, r % I_GU, F.lane); continue; } r -= NE * I_GU;
        { const int e = r / I_D; p0_transpose_item(inp<I_WD>() + (size_t)e * D * D, D, D, (bf16_t*)(ws + WS_WD) + (size_t)e * D * D, 1, scr, r % I_D, F.lane); }
    }
    bf16_t* h0b = (bf16_t*)(ws + WS_H0B); float* stats0 = (float*)(ws + WS_STATS0);
    const float* xin = inp<I_X>(); const float* lg = inp<I_LNING>(); const float* lb = inp<I_LNINB>();
    for (int m = gw; m < T; m += NGW) {
        const GAS f32x4* xr = (const GAS f32x4*)(xin + (size_t)m * D) + F.lane;
        f32x4 v[4]; float s = 0.f;
#pragma unroll
        for (int j = 0; j < 4; ++j) { v[j] = xr[64 * j]; s += (v[j].x + v[j].y) + (v[j].z + v[j].w); }
        const float mean = wave_sum(s) * (1.f / D); float s2 = 0.f;
#pragma unroll
        for (int j = 0; j < 4; ++j) { v[j] = v[j] - mean; s2 += (v[j].x * v[j].x + v[j].y * v[j].y) + (v[j].z * v[j].z + v[j].w * v[j].w); }
        const float rstd = 1.f / sqrtf(wave_sum(s2) * (1.f / D) + LN_EPS);
        GAS u32x2* o8 = (GAS u32x2*)(h0b + (size_t)m * D) + F.lane;
#pragma unroll
        for (int j = 0; j < 4; ++j) { const f32x4 gg = ((const f32x4*)lg)[F.lane + 64 * j], bb = ((const f32x4*)lb)[F.lane + 64 * j];
            const f32x4 r = v[j] * rstd * gg + bb; u32x2 w; w.x = cvtpk(r.x, r.y); w.y = cvtpk(r.z, r.w); o8[64 * j] = w; }
        if (F.lane == 0) { stats0[2 * m] = mean; stats0[2 * m + 1] = rstd; }
    }
    float* rope = (float*)(ws + WS_ROPE); const int* positions = (const int*)inp<I_POS>();
    for (int i = gt; i < T * 8; i += NGT) {
        const int tok = i >> 3, j = i & 7;
        const float inv = powf(500000.0f, -(float)(2 * j) / 16.0f);
        const float ang = (float)positions[tok] * inv;
        rope[tok * 16 + j] = cosf(ang); rope[tok * 16 + 8 + j] = sinf(ang);
    }
    int* slot_tok = (int*)(ws + WS_SLOTTOK); int* slot_dest = (int*)(ws + WS_SLOTDEST);
    for (int i = gt; i < NSLOT; i += NGT) { slot_tok[i] = -1; slot_dest[i] = -1; }
    float* outc = (float*)(ws + WS_OUTC); const float* bo = inp<I_BOUT>();
    for (int i = gt; i < D; i += NGT) { outc[i] = ALPHA * lg[i]; outc[1024 + i] = bo[i] + ALPHA * lb[i]; }
    bf16_t* wsp = (bf16_t*)(ws + WS_WSP); const float* w_s = inp<I_WS>();
    for (int i = gt; i < 8 * 128 * 128; i += NGT) {
        const int j = i & 7, hi = (i >> 3) & 1, ks = (i >> 4) & 7, t = (i >> 7) & 127, h = i >> 14;
        const int s = 16 * ks + 8 * (j >> 2) + 4 * hi + (j & 3);
        const float w = (s <= t) ? w_s[((size_t)h * 128 + t) * 128 + s] : 0.f;
        wsp[i] = (bf16_t)(cvtpk(w, 0.f) & 0xffffu);
    }
}

#define MFMA32(a, b, c) __builtin_amdgcn_mfma_f32_32x32x16_bf16((a), (b), (c), 0, 0, 0)
DI int crow(int r, int hi) { return (r & 3) + 8 * (r >> 2) + 4 * hi; }
DI bf16x8 cat4(s16x4 lo, s16x4 hi) { return __builtin_shufflevector(lo, hi, 0, 1, 2, 3, 4, 5, 6, 7); }
DI void attn_unit(const Frame& F0, LAS unsigned char* lds, int u) {
    const Frame F = opaque(F0);
    unsigned char* ws = wsp();
    const int b = u >> 6, n = (u >> 1) & 31, kvh = u & 1;
    const int tok0 = b * SEQ + n * 128;
    const bf16_t* Qb = (const bf16_t*)(ws + WS_QB); const bf16_t* Kb = (const bf16_t*)(ws + WS_KB); const bf16_t* Vb = (const bf16_t*)(ws + WS_VB);
    bf16_t* Ob = (bf16_t*)(ws + WS_H0B);
    LAS unsigned char* Kl = lds;
    LAS unsigned char* Vt = lds + 36864;
    LAS float* scr = (LAS float*)(lds + 36864 + 32768) + F.wave * 64;
#pragma unroll
    for (int rep = 0; rep < 4; ++rep) {
        const int c = F.tid + 512 * rep, kw = c >> 3, ch = c & 7;
        int tokk = tok0 - 128 + kw; if (n == 0 && kw < 128) tokk = tok0 + kw;
        const u32x4 kv = *(const u32x4*)(Kb + (size_t)tokk * 128 + kvh * 64 + ch * 8);
        *(LAS u32x4*)(Kl + kw * 144 + ch * 16) = kv;
        const u32x4 vv = *(const u32x4*)(Vb + (size_t)tokk * 128 + kvh * 64 + ch * 8);
        const unsigned wv[4] = {vv.x, vv.y, vv.z, vv.w};
#pragma unroll
        for (int e = 0; e < 8; ++e) { const int d = ch * 8 + e; const unsigned short val = (unsigned short)((e & 1) ? (wv[e >> 1] >> 16) : (wv[e >> 1] & 0xffffu));
            *(LAS unsigned short*)(Vt + d * 512 + ((((kw >> 2) ^ (d & 31))) << 3) + (kw & 3) * 2) = val; }
    }
    __syncthreads();
    const int g = F.wave >> 1, rh = F.wave & 1, hq = kvh * 4 + g;
    const int q = F.lane & 31, hi = F.lane >> 5;
    const float sink2 = inp<I_SINKS>()[hq] * LOG2E;
#pragma unroll 1
    for (int sb = 0; sb < 2; ++sb) {
        const int r0 = rh * 64 + sb * 32, kb0 = r0 >> 5;
        const bf16_t* qp = Qb + (size_t)(tok0 + r0 + q) * 512 + hq * 64 + hi * 8;
        bf16x8 qf[4];
#pragma unroll
        for (int ds = 0; ds < 4; ++ds) qf[ds] = *(const bf16x8*)(qp + ds * 16);
        f32x16 p[5];
#pragma unroll
        for (int kbi = 0; kbi < 5; ++kbi) {
            f32x16 a = {};
#pragma unroll
            for (int ds = 0; ds < 4; ++ds) { const bf16x8 kf = *(const LAS bf16x8*)(Kl + ((kb0 + kbi) * 32 + q) * 144 + (ds * 16 + hi * 8) * 2); a = MFMA32(kf, qf[ds], a); }
            p[kbi] = a;
        }
        const int qi = 128 + r0 + q;
        float mx = sink2;
#pragma unroll
        for (int kbi = 0; kbi < 5; ++kbi)
#pragma unroll
            for (int r = 0; r < 16; ++r) { const int kw = (kb0 + kbi) * 32 + crow(r, hi); const bool ok = (kw <= qi) && (qi - kw < 128) && (n > 0 || kw >= 128);
                const float s = ok ? p[kbi][r] : -1e30f; p[kbi][r] = s; mx = fmaxf(mx, s); }
        mx = fmaxf(mx, __shfl_xor(mx, 32));
        float l = 0.f;
#pragma unroll
        for (int kbi = 0; kbi < 5; ++kbi)
#pragma unroll
            for (int r = 0; r < 16; ++r) { const float e = __builtin_amdgcn_exp2f(p[kbi][r] - mx); p[kbi][r] = e; l += e; }
        l += __shfl_xor(l, 32); l += __builtin_amdgcn_exp2f(sink2 - mx);
        f32x16 o0 = {}, o1 = {};
#pragma unroll
        for (int kbi = 0; kbi < 5; ++kbi)
#pragma unroll
            for (int s2 = 0; s2 < 2; ++s2) {
                u32x4 pw; pw.x = cvtpk(p[kbi][8 * s2 + 0], p[kbi][8 * s2 + 1]); pw.y = cvtpk(p[kbi][8 * s2 + 2], p[kbi][8 * s2 + 3]);
                pw.z = cvtpk(p[kbi][8 * s2 + 4], p[kbi][8 * s2 + 5]); pw.w = cvtpk(p[kbi][8 * s2 + 6], p[kbi][8 * s2 + 7]);
                const bf16x8 pa = __builtin_bit_cast(bf16x8, pw);
                const int kc = ((kb0 + kbi) * 32 + 16 * s2 + 4 * hi) >> 2;
                { const int d = q; const s16x4 lo = *(const LAS s16x4*)(Vt + d * 512 + ((kc ^ (d & 31)) << 3)), hh = *(const LAS s16x4*)(Vt + d * 512 + (((kc + 2) ^ (d & 31)) << 3)); o0 = MFMA32(pa, cat4(lo, hh), o0); }
                { const int d = 32 + q; const s16x4 lo = *(const LAS s16x4*)(Vt + d * 512 + ((kc ^ (d & 31)) << 3)), hh = *(const LAS s16x4*)(Vt + d * 512 + (((kc + 2) ^ (d & 31)) << 3)); o1 = MFMA32(pa, cat4(lo, hh), o1); }
            }
        if (hi == 0) scr[q] = l;
        LDS_WAIT();
        bf16_t* op = Ob + (size_t)(tok0 + r0) * D + hq * 64 + q;
#pragma unroll
        for (int r = 0; r < 16; ++r) { const int qr = crow(r, hi); const float rl = __builtin_amdgcn_rcpf(scr[qr]);
            op[(size_t)qr * D] = (bf16_t)(cvtpk(o0[r] * rl, 0.f) & 0xffffu); op[(size_t)qr * D + 32] = (bf16_t)(cvtpk(o1[r] * rl, 0.f) & 0xffffu); }
        LDS_WAIT();
    }
    __syncthreads();
}
DI void gmlp_unit(const Frame& F0, LAS unsigned char* lds, int chunk) {
    const Frame F = opaque(F0);
    unsigned char* ws = wsp();
    const int h = F.wave, tok0 = chunk * 128;
    const bf16_t* GUb = (const bf16_t*)(ws + WS_GUB); const bf16_t* GVb = (const bf16_t*)(ws + WS_GVB); const bf16_t* wsp = (const bf16_t*)(ws + WS_WSP);
    bf16_t* Ob = (bf16_t*)(ws + WS_H0B);
    LAS unsigned char* Vt = lds + F.wave * 16384;
#pragma unroll 4
    for (int rep = 0; rep < 16; ++rep) {
        const int c = F.lane + 64 * rep, s = c >> 3, ch = c & 7;
        const u32x4 vv = *(const u32x4*)(GVb + (size_t)(tok0 + s) * 512 + h * 64 + ch * 8);
        const unsigned wv[4] = {vv.x, vv.y, vv.z, vv.w};
#pragma unroll
        for (int e = 0; e < 8; ++e) { const int d = ch * 8 + e; const unsigned short val = (unsigned short)((e & 1) ? (wv[e >> 1] >> 16) : (wv[e >> 1] & 0xffffu));
            *(LAS unsigned short*)(Vt + d * 256 + (((s >> 2) ^ (d & 31)) << 3) + (s & 3) * 2) = val; }
    }
    LDS_WAIT();
    const int q = F.lane & 31, hi = F.lane >> 5;
    const float* b_s = inp<I_BS>();
#pragma unroll 1
    for (int tb = 0; tb < 4; ++tb) {
        f32x16 a0 = {}, a1 = {};
        const bf16_t* wp = wsp + ((size_t)(h * 128 + tb * 32 + q) * 8) * 16 + hi * 8;
        for (int ks = 0; ks < 2 * tb + 2; ++ks) {
            const bf16x8 wa = *(const bf16x8*)(wp + ks * 16);
            const int kc = (16 * ks + 4 * hi) >> 2;
            { const int d = q; const s16x4 lo = *(const LAS s16x4*)(Vt + d * 256 + ((kc ^ (d & 31)) << 3)), hh = *(const LAS s16x4*)(Vt + d * 256 + (((kc + 2) ^ (d & 31)) << 3)); a0 = MFMA32(wa, cat4(lo, hh), a0); }
            { const int d = 32 + q; const s16x4 lo = *(const LAS s16x4*)(Vt + d * 256 + ((kc ^ (d & 31)) << 3)), hh = *(const LAS s16x4*)(Vt + d * 256 + (((kc + 2) ^ (d & 31)) << 3)); a1 = MFMA32(wa, cat4(lo, hh), a1); }
        }
#pragma unroll
        for (int r = 0; r < 16; ++r) { const int t = tb * 32 + crow(r, hi); const float bias = b_s[h * 128 + t];
            const bf16_t* gp = GUb + (size_t)(tok0 + t) * 512 + h * 64 + q; bf16_t* op = Ob + (size_t)(tok0 + t) * D + 512 + h * 64 + q;
            op[0] = (bf16_t)(cvtpk(bf2f(gp[0]) * (a0[r] + bias), 0.f) & 0xffffu); op[32] = (bf16_t)(cvtpk(bf2f(gp[32]) * (a1[r] + bias), 0.f) & 0xffffu); }
    }
    LDS_WAIT();
}

DI void p4_router(const Frame& F0, LAS unsigned char* lds) {
    const Frame F = opaque(F0);
    unsigned char* ws = wsp(); float* out = outp();
    LAS float* wrT = (LAS float*)lds;
    LAS int* cnt = (LAS int*)(lds + MISC_OFF + 256);
    { const float* w_router = inp<I_WR>(); for (int i = F.tid; i < D * NE; i += NTHREADS) { const int c = i >> 5, e = i & 31; wrT[e * D + c] = w_router[i]; } }
    if (F.tid < 32) cnt[F.tid] = 0;
    __syncthreads();
    const int R = T / G, rpw = R / NWAVES;
    int* tok_e = (int*)(ws + WS_TOKE); float* tok_g = (float*)(ws + WS_TOKG); int* tok_l = (int*)(ws + WS_TOKL);
    const int lane = F.lane;
    f32x4 g1[4], b1[4];
#pragma unroll
    for (int j = 0; j < 4; ++j) { g1[j] = ((const f32x4*)inp<I_LN1G>())[lane + 64 * j]; b1[j] = ((const f32x4*)inp<I_LN1B>())[lane + 64 * j]; }
    const float br = inp<I_BR>()[lane >> 1];
#pragma unroll 1
    for (int i = 0; i < rpw; ++i) {
        const int tok = F.bid * R + F.wave * rpw + i;
        float* rowp = out + (size_t)tok * D;
        f32x4 v[4]; float s = 0.f;
#pragma unroll
        for (int j = 0; j < 4; ++j) { v[j] = ((const GAS f32x4*)rowp)[lane + 64 * j]; s += (v[j].x + v[j].y) + (v[j].z + v[j].w); }
        const float mean = wave_sum(s) * (1.f / D); float s2 = 0.f;
#pragma unroll
        for (int j = 0; j < 4; ++j) { v[j] = v[j] - mean; s2 += (v[j].x * v[j].x + v[j].y * v[j].y) + (v[j].z * v[j].z + v[j].w * v[j].w); }
        const float rstd = 1.f / sqrtf(wave_sum(s2) * (1.f / D) + LN_EPS);
#pragma unroll
        for (int j = 0; j < 4; ++j) v[j] = v[j] * rstd * g1[j] + b1[j];
        GAS u32x2* hp = (GAS u32x2*)rowp + lane; GAS u32x2* lp = (GAS u32x2*)(rowp + 512) + lane;
#pragma unroll
        for (int j = 0; j < 4; ++j) {
            u32x2 wh; wh.x = cvtpk(v[j].x, v[j].y); wh.y = cvtpk(v[j].z, v[j].w);
            u32x2 wl; wl.x = cvtpk(v[j].x - bflo(wh.x), v[j].y - bfhi(wh.x)); wl.y = cvtpk(v[j].z - bflo(wh.y), v[j].w - bfhi(wh.y));
            hp[64 * j] = wh; lp[64 * j] = wl;
        }
        float acc[32];
        unsigned wb0 = (unsigned)(16 * lane), wb1 = wb0 + 65536u; asm volatile("" : "+v"(wb0), "+v"(wb1));
#pragma unroll
        for (int e = 0; e < 32; ++e) {
            f32x2 a2 = {0.f, 0.f};
#pragma unroll
            for (int j = 0; j < 4; ++j) { const f32x4 w4 = *(const LAS f32x4*)((LAS unsigned char*)wrT + (e < 16 ? wb0 : wb1) + (e & 15) * 4096 + 1024 * j);
                a2 = a2 + (f32x2){v[j].x, v[j].y} * (f32x2){w4.x, w4.y}; a2 = a2 + (f32x2){v[j].z, v[j].w} * (f32x2){w4.z, w4.w}; }
            acc[e] = a2.x + a2.y;
        }
#pragma unroll
        for (int e = 0; e < 16; ++e) { const bool up = (lane & 32) != 0; const float keep = up ? acc[e + 16] : acc[e], send = up ? acc[e] : acc[e + 16]; acc[e] = keep + __shfl_xor(send, 32); }
#pragma unroll
        for (int e = 0; e < 8; ++e) { const bool up = (lane & 16) != 0; const float keep = up ? acc[e + 8] : acc[e], send = up ? acc[e] : acc[e + 8]; acc[e] = keep + __shfl_xor(send, 16); }
#pragma unroll
        for (int e = 0; e < 4; ++e) { const bool up = (lane & 8) != 0; const float keep = up ? acc[e + 4] : acc[e], send = up ? acc[e] : acc[e + 4]; acc[e] = keep + __shfl_xor(send, 8); }
#pragma unroll
        for (int e = 0; e < 2; ++e) { const bool up = (lane & 4) != 0; const float keep = up ? acc[e + 2] : acc[e], send = up ? acc[e] : acc[e + 2]; acc[e] = keep + __shfl_xor(send, 4); }
        { const bool up = (lane & 2) != 0; const float keep = up ? acc[1] : acc[0], send = up ? acc[0] : acc[1]; acc[0] = keep + __shfl_xor(send, 2); }
        float logit = acc[0] + __shfl_xor(acc[0], 1) + br;
        const int myE = lane >> 1;
        float vals[4]; int idxs[4]; float cur = logit;
#pragma unroll
        for (int r = 0; r < 4; ++r) {
            float bv = cur; int bi = myE;
#pragma unroll
            for (int o = 2; o < 64; o <<= 1) { const float ov = __shfl_xor(bv, o); const int oi = __shfl_xor(bi, o); if (ov > bv || (ov == bv && oi < bi)) { bv = ov; bi = oi; } }
            vals[r] = bv; idxs[r] = bi; if (myE == bi) cur = -INFINITY;
        }
        const float e1 = __expf(vals[1] - vals[0]), e2 = __expf(vals[2] - vals[0]), e3 = __expf(vals[3] - vals[0]);
        const float inv = 1.0f / (1.0f + e1 + e2 + e3);
        if (lane < 4) {
            const float ee = lane == 0 ? 1.0f : lane == 1 ? e1 : lane == 2 ? e2 : e3;
            const int ex = lane == 0 ? idxs[0] : lane == 1 ? idxs[1] : lane == 2 ? idxs[2] : idxs[3];
            const int lp2 = atomicAdd((int*)(cnt + ex), 1);
            tok_e[tok * 4 + lane] = ex; tok_g[tok * 4 + lane] = ee * inv; tok_l[tok * 4 + lane] = lp2;
        }
    }
    __syncthreads();
    if (F.tid < 32) ((int*)(ws + WS_WGCOUNT))[F.bid * 32 + F.tid] = cnt[F.tid];
}
DI int p4b_lists(const Frame& F0, LAS unsigned char* lds) {
    const Frame F = opaque(F0);
    unsigned char* ws = wsp();
    LAS int* tab = (LAS int*)lds;
    LAS int* pstart = (LAS int*)(lds + MISC_OFF + 256);
    LAS int* mybase = pstart + 64;
    const int* wgc = (const int*)(ws + WS_WGCOUNT);
    for (int i = F.tid; i < G * 32; i += NTHREADS) tab[i] = (int)__hip_atomic_load((unsigned*)wgc + i, __ATOMIC_RELAXED, __HIP_MEMORY_SCOPE_AGENT);
    __syncthreads();
    if (F.tid < 32) { int tot = 0, mb = 0; for (int w = 0; w < G; ++w) { const int c = tab[w * 32 + F.tid]; if (w < F.bid) mb += c; tot += c; } mybase[F.tid] = mb; pstart[32 + 32 + 32 + F.tid] = tot; }
    __syncthreads();
    if (F.tid == 0) { int off = 0; for (int e = 0; e < 32; ++e) { pstart[e] = off; off += ((pstart[96 + e] + 255) >> 8) << 8; } pstart[32] = off; }
    __syncthreads();
    const int ngroups = pstart[32] >> 8;
    if (F.bid == 0) {
        int* grp_e = (int*)(ws + WS_GRPE);
        for (int g = F.tid; g < NGRP_MAX; g += NTHREADS) { int e = 0; for (int k = 1; k < 32; ++k) if (pstart[k] <= g * 256) e = k; grp_e[g] = (g < ngroups) ? e : 0; }
    }
    const int R = T / G;
    const int* tok_e = (const int*)(ws + WS_TOKE); const float* tok_g = (const float*)(ws + WS_TOKG); const int* tok_l = (const int*)(ws + WS_TOKL);
    int* slot_tok = (int*)(ws + WS_SLOTTOK); float* slot_gate = (float*)(ws + WS_SLOTGATE); int* slot_dest = (int*)(ws + WS_SLOTDEST);
    for (int i = F.tid; i < R * 4; i += NTHREADS) {
        const int idx = F.bid * R * 4 + i; const int e = tok_e[idx];
        const int slot = pstart[e] + mybase[e] + tok_l[idx];
        slot_tok[slot] = idx >> 2; slot_gate[slot] = tok_g[idx]; slot_dest[slot] = idx;
    }
    return ngroups;
}
DI void p7_final(const Frame& F0) {
    const Frame F = opaque(F0);
    unsigned char* ws = wsp(); float* out = outp();
    const bf16_t* yslot = (const bf16_t*)(ws + WS_YSLOT);
    const int gw = F.bid * NWAVES + F.wave, NGW = G * NWAVES, lane = F.lane;
    const float* ln2_g = inp<I_LN2G>(); const float* ln2_b = inp<I_LN2B>();
    for (int tok = gw; tok < T; tok += NGW) {
        float* rowp = out + (size_t)tok * D;
        f32x4 v[4];
#pragma unroll
        for (int j = 0; j < 4; ++j) {
            const u32x2 wh = ((const GAS u32x2*)rowp)[lane + 64 * j], wl = ((const GAS u32x2*)(rowp + 512))[lane + 64 * j];
            v[j] = (f32x4){bflo(wh.x) + bflo(wl.x), bfhi(wh.x) + bfhi(wl.x), bflo(wh.y) + bflo(wl.y), bfhi(wh.y) + bfhi(wl.y)} * ALPHA;
        }
#pragma unroll
        for (int k = 0; k < 4; ++k) {
            const GAS u32x2* yp = (const GAS u32x2*)(yslot + ((size_t)tok * 4 + k) * 1024) + lane;
#pragma unroll
            for (int j = 0; j < 4; ++j) { const u32x2 w = yp[64 * j]; v[j] = v[j] + (f32x4){bflo(w.x), bfhi(w.x), bflo(w.y), bfhi(w.y)}; }
        }
        float s = 0.f;
#pragma unroll
        for (int j = 0; j < 4; ++j) s += (v[j].x + v[j].y) + (v[j].z + v[j].w);
        const float mean = wave_sum(s) * (1.f / D); float s2 = 0.f;
#pragma unroll
        for (int j = 0; j < 4; ++j) { v[j] = v[j] - mean; s2 += (v[j].x * v[j].x + v[j].y * v[j].y) + (v[j].z * v[j].z + v[j].w * v[j].w); }
        const float rstd = 1.f / sqrtf(wave_sum(s2) * (1.f / D) + LN_EPS);
#pragma unroll
        for (int j = 0; j < 4; ++j) { const f32x4 gg = ((const f32x4*)ln2_g)[lane + 64 * j], bb = ((const f32x4*)ln2_b)[lane + 64 * j];
            ((GAS f32x4*)rowp)[lane + 64 * j] = v[j] * rstd * gg + bb; }
    }
}

struct CfgIn   { static constexpr size_t A_OFF = WS_H0B,  B_OFF = WS_WIN,  B_E_BYTES = 0; static constexpr bool GATHER = false; };
struct CfgOut  { static constexpr size_t A_OFF = WS_H0B,  B_OFF = WS_WOUT, B_E_BYTES = 0; static constexpr bool GATHER = false; };
struct CfgGU   { static constexpr size_t A_OFF = 0,       B_OFF = WS_WGU,  B_E_BYTES = (size_t)2048 * D * 2; static constexpr bool GATHER = true; };
struct CfgDown { static constexpr size_t A_OFF = WS_HMID, B_OFF = WS_WD,   B_E_BYTES = (size_t)D * D * 2; static constexpr bool GATHER = false; };
#ifndef PHASE_MASK
#define PHASE_MASK 0xFFFF
#endif
struct Args { const void* in[23]; float* out; unsigned char* ws; };
__global__ void __launch_bounds__(NTHREADS, 2) mk_fwd(Args args) {
    __shared__ __attribute__((aligned(16))) unsigned char lds_raw[LDS_BYTES];
    LAS unsigned char* lds = (LAS unsigned char*)lds_raw;
    Frame F;
    F.tid = threadIdx.x; F.lane = F.tid & 63; F.wave = __builtin_amdgcn_readfirstlane(F.tid >> 6); F.bid = blockIdx.x;
    volatile LAS unsigned* MISC = (volatile LAS unsigned*)(lds + MISC_OFF);
    if (F.tid < 64) MISC[F.tid] = 0u;
    __syncthreads();
    xcd_barrier_post((unsigned*)(wsp() + WS_CTL) + CW_BAR);
    volatile LAS unsigned* bst = MISC + 8;
    LAS unsigned char* tokbuf = lds + TOKBUF_OFF;

    if (PHASE_MASK & 1) p0_prologue(F, lds);
    xcd_barrier(bst);
    if (PHASE_MASK & 2) { pg8::StaticOrder<T, INW> S{F.bid}; EpiInProj E; pg8::gemm_phase<CfgIn>(lds, tokbuf, 0, S, E); }
    xcd_barrier(bst);
    if (PHASE_MASK & 4) for (int u = F.bid; u < NBATCH * 32 * 2; u += G) attn_unit(F, lds, u);
    if (PHASE_MASK & 8) for (int c = F.bid; c < T / 128; c += G) gmlp_unit(F, lds, c);
    xcd_barrier(bst);
    if (PHASE_MASK & 16) { pg8::StaticOrder<T, D> S{F.bid}; EpiOut E; pg8::gemm_phase<CfgOut>(lds, tokbuf, 0, S, E); }
    xcd_barrier(bst);
    if (PHASE_MASK & 32) p4_router(F, lds);
    xcd_barrier(bst);
    int ngroups = 1040; if (PHASE_MASK & 64) ngroups = p4b_lists(F, lds);
    xcd_barrier(bst);
#pragma unroll 1
    for (int ch = 0; ch < 2; ++ch) {
        const int g0 = ch == 0 ? 0 : CHUNK0_GROUPS;
        int g1 = ch == 0 ? (ngroups < CHUNK0_GROUPS ? ngroups : CHUNK0_GROUPS) : ngroups;
        if (g1 > g0 + HMID_GROUPS) g1 = g0 + HMID_GROUPS;
        if (PHASE_MASK & 128) { pg8::GroupOrder<8> S{g0, g1, F.bid}; EpiGateUp E{g0}; pg8::gemm_phase<CfgGU>(lds, tokbuf, 0, S, E); }
        xcd_barrier(bst);
        if (PHASE_MASK & 256) { pg8::GroupOrder<4> S{g0, g1, F.bid}; EpiDown E; pg8::gemm_phase<CfgDown>(lds, tokbuf, g0, S, E); }
        xcd_barrier(bst);
    }
    if (PHASE_MASK & 512) p7_final(F);
}

extern "C" void kernel_launch(void* const* d_in, const int* in_sizes, int n_in, void* d_out, int out_size, void* d_ws, size_t ws_size, hipStream_t stream) {
    static int grid = 0;
    if (grid == 0) {
        if (n_in != 23 || in_sizes[0] != T * D || out_size != T * D || ws_size < WS_END) {
            fprintf(stderr, "kernel_launch: unexpected shapes/workspace (n_in %d, in0 %d, out %d, ws %zu, need %zu); nothing launched\n", n_in, n_in > 0 ? in_sizes[0] : -1, out_size, ws_size, (size_t)WS_END);
            grid = -1; return;
        }
        int dev = 0, cus = 0, per_cu = 0;
        if (hipGetDevice(&dev) != hipSuccess || hipDeviceGetAttribute(&cus, hipDeviceAttributeMultiprocessorCount, dev) != hipSuccess) { grid = -1; return; }
        if (hipOccupancyMaxActiveBlocksPerMultiprocessor(&per_cu, (const void*)mk_fwd, NTHREADS, 0) != hipSuccess || per_cu < 1) {
            fprintf(stderr, "kernel_launch: occupancy query says %d blocks per CU; nothing launched\n", per_cu); (void)hipGetLastError(); grid = -1; return;
        }
        grid = cus;
        if (grid != G) { fprintf(stderr, "kernel_launch: built for a 256-CU device, found %d; nothing launched\n", cus); grid = -1; return; }
    }
    if (grid < 0) return;
    if (hipMemsetAsync((char*)d_ws + WS_CTL, 0, CTL_ZERO_BYTES, stream) != hipSuccess) return;
    Args a{};
    for (int i = 0; i < 23; ++i) a.in[i] = d_in[i];
    a.out = (float*)d_out; a.ws = (unsigned char*)d_ws;
    hipLaunchKernelGGL(mk_fwd, dim3(grid), dim3(NTHREADS), 0, stream, a);
}
```

```cpp
#include <hip/hip_runtime.h>
#include <cstdio>
#include <cstdint>

#define DI __device__ __forceinline__
#define LAS __attribute__((address_space(3)))
#define GAS __attribute__((address_space(1)))
typedef unsigned short bf16_t;
typedef short bf16x8 __attribute__((ext_vector_type(8)));
typedef short s16x4 __attribute__((ext_vector_type(4)));
typedef float f32x2 __attribute__((ext_vector_type(2)));
typedef float f32x4 __attribute__((ext_vector_type(4)));
typedef float f32x16 __attribute__((ext_vector_type(16)));
typedef unsigned u32x2 __attribute__((ext_vector_type(2)));
typedef unsigned u32x4 __attribute__((ext_vector_type(4)));
typedef __bf16 bf16x2_t __attribute__((ext_vector_type(2)));
typedef GAS unsigned gu32;

constexpr int D = 1024, SEQ = 4096, NBATCH = 16, T = NBATCH * SEQ;
constexpr int INW = 1792, NE = 32;
constexpr int NSLOT = T * 4 + NE * 256;
constexpr int NGRP_MAX = NSLOT / 256;
constexpr int CHUNK0_GROUPS = 512;
constexpr int HMID_GROUPS = 592;
constexpr float LN_EPS = 1e-5f;
constexpr float ALPHA = 1.189207115002721f;
constexpr float LOG2E = 1.4426950408889634f;
constexpr float QSCALE = 0.125f * LOG2E;
constexpr int NWAVES = 8, NTHREADS = 512;

constexpr size_t MiB = 1u << 20;
constexpr size_t WS_CTL = 0, CTL_ZERO_BYTES = 65536;
constexpr size_t WS_WGCOUNT = 1 * MiB;
constexpr size_t WS_GRPE = 1 * MiB + 65536;
constexpr size_t WS_OUTC = 1 * MiB + 131072;
constexpr size_t WS_WIN = 2 * MiB;
constexpr size_t WS_WOUT = 6 * MiB;
constexpr size_t WS_WSP = 8 * MiB;
constexpr size_t WS_STATS0 = 9 * MiB;
constexpr size_t WS_ROPE = 10 * MiB;
constexpr size_t WS_WGU = 16 * MiB;
constexpr size_t WS_WD = 144 * MiB;
constexpr size_t WS_TOKE = 208 * MiB;
constexpr size_t WS_TOKG = 209 * MiB;
constexpr size_t WS_TOKL = 210 * MiB;
constexpr size_t WS_SLOTTOK = 211 * MiB;
constexpr size_t WS_SLOTGATE = 212 * MiB + 512 * 1024;
constexpr size_t WS_SLOTDEST = 214 * MiB;
constexpr size_t WS_H0B = 216 * MiB;
constexpr size_t WS_QB = 344 * MiB;
constexpr size_t WS_KB = 408 * MiB;
constexpr size_t WS_VB = 424 * MiB;
constexpr size_t WS_GUB = 440 * MiB;
constexpr size_t WS_GVB = 504 * MiB;
constexpr size_t WS_YSLOT = 216 * MiB;
constexpr size_t WS_HMID = 728 * MiB;
constexpr size_t WS_END = 1024 * MiB;
static_assert(WS_HMID + (size_t)HMID_GROUPS * 256 * 1024 * 2 <= WS_END, "ws map");
static_assert(WS_YSLOT + (size_t)T * 4 * 1024 * 2 <= WS_HMID, "ws map");
constexpr int CW_BAR = 4096;

constexpr int RING_BYTES = 131072;
constexpr int MISC_OFF = RING_BYTES;
constexpr int TOKBUF_OFF = MISC_OFF + 1024;
constexpr int LDS_BYTES = 147456;

DI unsigned cvtpk(float lo, float hi) { f32x2 v = {lo, hi}; bf16x2_t b = __builtin_convertvector(v, bf16x2_t); return __builtin_bit_cast(unsigned, b); }
DI float bf2f(unsigned short h) { return __uint_as_float((unsigned)h << 16); }
DI float bflo(unsigned w) { return __uint_as_float(w << 16); }
DI float bfhi(unsigned w) { return __uint_as_float(w & 0xffff0000u); }
template <int CTRL> DI float dppf(float v) { return __builtin_bit_cast(float, __builtin_amdgcn_update_dpp(0, __builtin_bit_cast(int, v), CTRL, 0xf, 0xf, false)); }
DI void swap32(float& a, float& b) { asm("s_nop 1\n\tv_permlane32_swap_b32 %0, %1" : "+v"(a), "+v"(b)); }
DI void swap16(float& a, float& b) { asm("s_nop 1\n\tv_permlane16_swap_b32 %0, %1" : "+v"(a), "+v"(b)); }
template <int CTRL> DI int dppi(int v) { return __builtin_amdgcn_update_dpp(0, v, CTRL, 0xf, 0xf, false); }
constexpr int DPP_XOR1 = 0xB1, DPP_XOR2 = 0x4E, DPP_HMIRROR = 0x141, DPP_MIRROR = 0x140;
template <int LV> DI float partnerf(float v, int lane) {
    if constexpr (LV == 0) return dppf<DPP_XOR1>(v);
    else if constexpr (LV == 1) return dppf<DPP_XOR2>(v);
    else if constexpr (LV == 2) return dppf<DPP_HMIRROR>(v);
    else if constexpr (LV == 3) return dppf<DPP_MIRROR>(v);
    else if constexpr (LV == 4) { float a = v, b = v; swap16(a, b); return (lane & 16) ? a : b; }
    else { float a = v, b = v; swap32(a, b); return (lane & 32) ? a : b; }
}
template <int LV> DI int partneri(int v, int lane) { return __builtin_bit_cast(int, partnerf<LV>(__builtin_bit_cast(float, v), lane)); }
DI float wave_sum(float v) {
    v += dppf<DPP_XOR1>(v); v += dppf<DPP_XOR2>(v); v += dppf<DPP_HMIRROR>(v); v += dppf<DPP_MIRROR>(v);
    { float a = v, b = v; swap16(a, b); v = a + b; }
    { float a = v, b = v; swap32(a, b); v = a + b; }
    return v;
}
#define LDS_WAIT() asm volatile("s_waitcnt lgkmcnt(0)" ::: "memory")
#define VM_WAIT() asm volatile("s_waitcnt vmcnt(0)" ::: "memory")

DI f32x2 gelu_pk(f32x2 v) {
    const f32x2 av = __builtin_elementwise_abs(v), d = av * 0.2316418882f + 1.0f;
    f32x2 t; t.x = __builtin_amdgcn_rcpf(d.x); t.y = __builtin_amdgcn_rcpf(d.y);
    f32x2 q = t * 0.5307027145f + (-0.7265760135f); q = q * t + 0.7107068705f; q = q * t + (-0.142248368f); q = q * t + 0.127414796f; q = q * t;
    const f32x2 s = (v * v) * (-0.72134752044f);
    f32x2 e; e.x = __builtin_amdgcn_exp2f(s.x); e.y = __builtin_amdgcn_exp2f(s.y);
    const f32x2 m = v * (q * e), r = v - m;
    f32x2 o; o.x = v.x < 0.f ? m.x : r.x; o.y = v.y < 0.f ? m.y : r.y; return o;
}
DI f32x4 gelu4(f32x4 v) { f32x2 a = gelu_pk((f32x2){v[0], v[1]}), b = gelu_pk((f32x2){v[2], v[3]}); return (f32x4){a.x, a.y, b.x, b.y}; }


struct Frame { int tid, lane, wave, bid; };
DI Frame opaque(const Frame& f) { Frame r; r.tid = threadIdx.x; asm volatile("" : "+v"(r.tid)); r.lane = r.tid & 63; r.wave = __builtin_amdgcn_readfirstlane(r.tid >> 6); r.bid = f.bid; return r; }
constexpr int G = 256;
template <int K> DI const float* inp() { const float* p; asm volatile("s_load_dwordx2 %0, %1, %2\n\ts_waitcnt lgkmcnt(0)" : "=s"(p) : "s"(__builtin_amdgcn_kernarg_segment_ptr()), "i"(K * 8)); return p; }
DI float* outp() { float* p; asm volatile("s_load_dwordx2 %0, %1, %2\n\ts_waitcnt lgkmcnt(0)" : "=s"(p) : "s"(__builtin_amdgcn_kernarg_segment_ptr()), "i"(23 * 8)); return p; }
DI unsigned char* wsp() { unsigned char* p; asm volatile("s_load_dwordx2 %0, %1, %2\n\ts_waitcnt lgkmcnt(0)" : "=s"(p) : "s"(__builtin_amdgcn_kernarg_segment_ptr()), "i"(24 * 8)); return p; }
enum { I_X = 0, I_POS = 1, I_LNING = 2, I_LNINB = 3, I_WIN = 4, I_BIN = 5, I_SINKS = 6, I_GNG = 7, I_GNB = 8, I_WS = 9, I_BS = 10, I_WOUT = 11, I_BOUT = 12, I_LN1G = 13, I_LN1B = 14,
       I_WR = 15, I_BR = 16, I_WGU = 17, I_BGU = 18, I_WD = 19, I_BD = 20, I_LN2G = 21, I_LN2B = 22 };

#define XB_TMO      128
#define XB_XCNT(j)  (256  + 64 * (j))
#define XB_XSUB(j)  (1280 + 64 * (j))
#define XB_XGEN(j)  (2304 + 64 * (j))
#define XB_TOP      3328
#define XB_TOPGEN   3392
#define XCD_BAR_WORDS 3456
#define XB_SPIN_CAP (1u << 18)
DI unsigned xb_ld(unsigned* p)              { return __hip_atomic_load(p, __ATOMIC_RELAXED, __HIP_MEMORY_SCOPE_AGENT); }
DI unsigned xb_add(unsigned* p, unsigned v) { return __hip_atomic_fetch_add(p, v, __ATOMIC_RELAXED, __HIP_MEMORY_SCOPE_AGENT); }
DI unsigned xb_xcc_id() { return (unsigned)__builtin_amdgcn_s_getreg((3 << 11) | 20) & 0xFu; }
#define XB_SPIN(cond, bar) do { unsigned _sp = 0; while (cond) { __builtin_amdgcn_s_sleep(1); \
    if ((++_sp & 255u) == 0u) { if (xb_ld(&(bar)[XB_TMO])) break; if (_sp > XB_SPIN_CAP) { atomicAdd(&(bar)[XB_TMO], 1u); break; } } } } while (0)
DI void xcd_barrier_post(unsigned* bar) { if (threadIdx.x == 0) (void)xb_add(&bar[XB_XCNT(xb_xcc_id())], 1u); }
DI void xcd_barrier_complete(unsigned* bar, unsigned x, unsigned& nloc, unsigned& nx) {
    unsigned sum, cnt, mine, sp = 0u;
    for (;;) {
        sum = 0u; cnt = 0u; mine = 0u;
#pragma unroll
        for (unsigned j = 0; j < 16; ++j) { const unsigned c = xb_ld(&bar[XB_XCNT(j)]); sum += c; cnt += (c > 0u) ? 1u : 0u; mine = (j == x) ? c : mine; }
        if (sum == (unsigned)G) break;
        __builtin_amdgcn_s_sleep(1);
        if ((++sp & 255u) == 0u) { if (xb_ld(&bar[XB_TMO])) break; if (sp > XB_SPIN_CAP) { atomicAdd(&bar[XB_TMO], 1u); break; } }
    }
    nloc = mine > 0u ? mine : 1u; nx = cnt > 0u ? cnt : 1u;
}
DI void xcd_barrier(volatile LAS unsigned* st) {
    asm volatile("s_waitcnt vmcnt(0)" ::: "memory");
    __syncthreads();
    if (threadIdx.x == 0) {
        unsigned* bar = (unsigned*)(wsp() + WS_CTL) + CW_BAR; const unsigned x = xb_xcc_id();
        __builtin_amdgcn_s_waitcnt(0);
        unsigned nloc = st[0], nx = st[1];
        if (nloc == 0u) { xcd_barrier_complete(bar, x, nloc, nx); st[0] = nloc; st[1] = nx; }
        const unsigned old = xb_add(&bar[XB_XSUB(x)], 1u);
        const unsigned gen = old / nloc;
        if (old + 1u == (gen + 1u) * nloc) {
            __builtin_amdgcn_fence(__ATOMIC_RELEASE, "agent");
            asm volatile("s_waitcnt vmcnt(0)" ::: "memory");
            const unsigned og = xb_add(&bar[XB_TOP], 1u);
            const unsigned tg = og / nx;
            if (og + 1u == (tg + 1u) * nx) xb_add(&bar[XB_TOPGEN], 1u);
            else XB_SPIN(xb_ld(&bar[XB_TOPGEN]) == tg, bar);
            __builtin_amdgcn_fence(__ATOMIC_ACQUIRE, "agent");
            xb_add(&bar[XB_XGEN(x)], 1u);
            asm volatile("s_waitcnt vmcnt(0)" ::: "memory");
        } else {
            XB_SPIN(xb_ld(&bar[XB_XGEN(x)]) == gen, bar);
            __builtin_amdgcn_fence(__ATOMIC_ACQUIRE, "agent");
            asm volatile("s_waitcnt vmcnt(0)" ::: "memory");
        }
    }
    __syncthreads();
}

namespace pg8 {
constexpr int BM = 256, BK = 64, HALF = 128, HTB = HALF * BK * 2, NXCD = 8, WGM = 8, GK = 1024, NT = GK / BK;
constexpr size_t KSTEP = BK * 2, HSTEP = (size_t)HALF * GK * 2, TSTEP = 2 * HSTEP;
DI int lds_byte(int r, int c) { const int st = (r >> 4) * 2 + (c >> 5), rr = r & 15, cc = c & 31, ob = rr * 64 + cc * 2; return st * 1024 + (ob ^ (((ob >> 9) & 1) << 5)); }
DI void stage_rc(int b, int& R, int& C) { const int st = b / 1024, sb = b % 1024, swz = sb ^ (((sb >> 9) & 1) << 5); R = (st >> 1) * 16 + swz / 64; C = (st & 1) * 32 + (swz % 64) / 2; }
DI int perm32(int rho) { const int n = rho >> 4, i = rho & 15; return 8 * (i >> 2) + 4 * n + (i & 3); }

struct Unit { int pm, pn, e; };

template <int M, int N> struct StaticOrder {
    int c;
    DI bool next(int i, Unit& u) const {
        constexpr int nM = M / BM, nN = N / BM, nwg = nM * nN;
        const int L = i * G + c; if (L >= nwg) return false;
        int wgid = L; { constexpr int q = nwg / NXCD, r = nwg % NXCD; const int xcd = wgid % NXCD, off = wgid / NXCD; wgid = (xcd < r ? xcd * (q + 1) : r * (q + 1) + (xcd - r) * q) + off; }
        constexpr int nig = WGM * nN; const int gid = wgid / nig, fm = gid * WGM, gsz = (nM - fm) < WGM ? (nM - fm) : WGM;
        u.pm = fm + ((wgid % nig) % gsz); u.pn = (wgid % nig) / gsz; u.e = 0; return true;
    }
};
template <int NPN> struct GroupOrder {
    int g0, g1, c;
    DI bool next(int i, Unit& u) const {
        constexpr int GPX = 32 / NPN;
        const int x = c & 7, j = c >> 3;
        const int g = g0 + i * (8 * GPX) + x * GPX + j / NPN;
        if (g >= g1) return false;
        u.pm = g; u.pn = j % NPN;
        u.e = __builtin_amdgcn_readfirstlane((int)__hip_atomic_load((unsigned*)(wsp() + WS_GRPE) + g, __ATOMIC_RELAXED, __HIP_MEMORY_SCOPE_AGENT));
        return true;
    }
};
DI void piece_rc(int i, int& R, int& C) { int t = threadIdx.x; asm volatile("" : "+v"(t)); stage_rc(t * 16 + i * 8192, R, C); }
DI unsigned tok_off(const LAS int* tb, int h, int i, unsigned pitch) { int R, C; piece_rc(i, R, C); int tok = tb[h * HALF + R]; tok = tok < 0 ? 0 : tok; return (unsigned)tok * pitch + (unsigned)C * 2u; }

template <class Cfg, class Epi, class Sched>
DI void gemm_phase(LAS unsigned char* lds, LAS unsigned char* tokbuf, const int pm_bias, const Sched& S, const Epi& E) {
    constexpr bool GATHER = Cfg::GATHER;
    int tid = threadIdx.x; asm volatile("" : "+v"(tid));
    const int wid = __builtin_amdgcn_readfirstlane(tid >> 6), lane = tid & 63, wr = wid >> 2, wc = wid & 3, fr = lane & 15, fq = lane >> 4;
    unsigned voffB[2], vaC[2][2];
#pragma unroll
    for (int i = 0; i < 2; ++i) { int R, C; stage_rc(tid * 16 + i * 8192, R, C); const int Rb = Epi::PERM ? ((R & ~31) + perm32(R & 31)) : R;
        voffB[i] = (unsigned)(Rb * GK + C) * 2u; vaC[0][i] = (unsigned)(R * GK + C) * 2u; vaC[1][i] = vaC[0][i]; }
    constexpr size_t AHSTEP = GATHER ? (size_t)0 : HSTEP;
    const unsigned ldsw = (unsigned)wid * 1024u;
    const int aoff = lds_byte(wr * 64 + fr, fq * 8), boff = lds_byte(wc * 32 + fr, fq * 8);
#define PG8_SA(b, h) (((b) * 2 + (h)) * HTB)
#define PG8_SB(b, h) ((4 + (b) * 2 + (h)) * HTB)
#define PG8_STAGEB(bufoff, gbase) do { _Pragma("unroll") for (int _i = 0; _i < 2; ++_i) \
        __builtin_amdgcn_global_load_lds((const unsigned*)((const char*)(gbase) + voffB[_i]), (LAS unsigned*)(lds + (bufoff) + ldsw + _i * 8192), 16, 0, 0); } while (0)
#define PG8_STAGEA(bufoff, gbase, o0, o1) do { \
        __builtin_amdgcn_global_load_lds((const unsigned*)((const char*)(gbase) + (o0)), (LAS unsigned*)(lds + (bufoff) + ldsw), 16, 0, 0); \
        __builtin_amdgcn_global_load_lds((const unsigned*)((const char*)(gbase) + (o1)), (LAS unsigned*)(lds + (bufoff) + ldsw + 8192), 16, 0, 0); } while (0)
#define PG8_LDA(dst, b, h) do { _Pragma("unroll") for (int m = 0; m < 4; ++m) _Pragma("unroll") for (int k = 0; k < 2; ++k) dst[m][k] = *(const LAS bf16x8*)(lds + PG8_SA(b, h) + aoff + m * 2048 + k * 1024); } while (0)
#define PG8_LDB(dst, b, h) do { _Pragma("unroll") for (int n = 0; n < 2; ++n) _Pragma("unroll") for (int k = 0; k < 2; ++k) dst[n][k] = *(const LAS bf16x8*)(lds + PG8_SB(b, h) + boff + n * 2048 + k * 1024); } while (0)
#define PG8_MMA(ai, bj, At, Bt) do { __builtin_amdgcn_s_setprio(1); _Pragma("unroll") for (int m = 0; m < 4; ++m) _Pragma("unroll") for (int n = 0; n < 2; ++n) _Pragma("unroll") for (int k = 0; k < 2; ++k) \
        acc[ai][bj][m][n] = __builtin_amdgcn_mfma_f32_16x16x32_bf16(Bt[n][k], At[m][k], acc[ai][bj][m][n], 0, 0, 0); __builtin_amdgcn_s_setprio(0); } while (0)
#define PG8_WAIT_V(n) asm volatile("s_waitcnt vmcnt(" #n ")" ::: "memory")
#define PG8_WAIT_L(n) asm volatile("s_waitcnt lgkmcnt(" #n ")" ::: "memory")
#define PG8_BAR __builtin_amdgcn_s_barrier()
#define PG8_SCHED __builtin_amdgcn_sched_barrier(0)
#define PG8_ABASE(u) (GATHER ? (const char*)outp() : (const char*)wsp() + Cfg::A_OFF + (size_t)((u).pm - pm_bias) * TSTEP)
#define PG8_BBASE(u) ((const char*)wsp() + Cfg::B_OFF + (size_t)(u).e * Cfg::B_E_BYTES + (size_t)(u).pn * TSTEP)
#define PG8_TOKSRC(u) ((const unsigned*)((const int*)(wsp() + WS_SLOTTOK) + (size_t)(u).pm * 256 + lane * 4))
    Unit cur, nxt; int ui = 0;
    if (!S.next(0, cur)) return;
    if constexpr (GATHER) {
        if (wid == 0) __builtin_amdgcn_global_load_lds(PG8_TOKSRC(cur), (LAS unsigned*)(tokbuf), 16, 0, 0);
        PG8_WAIT_V(0); PG8_BAR;
#pragma unroll
        for (int h = 0; h < 2; ++h)
#pragma unroll
            for (int i = 0; i < 2; ++i) vaC[h][i] = tok_off((const LAS int*)tokbuf, h, i, 4096u);
        PG8_WAIT_L(0); PG8_BAR;
    }
    f32x4 acc[2][2][4][2];
#pragma unroll
    for (int a = 0; a < 2; ++a)
#pragma unroll
        for (int b = 0; b < 2; ++b)
#pragma unroll
            for (int m = 0; m < 4; ++m)
#pragma unroll
                for (int n = 0; n < 2; ++n) acc[a][b][m][n] = (f32x4){0.f, 0.f, 0.f, 0.f};
    bf16x8 At[4][2], B0[2][2], B1[2][2];
    const char* cA = PG8_ABASE(cur);
    const char* cB = PG8_BBASE(cur);
    PG8_STAGEB(PG8_SB(0, 0), cB); PG8_STAGEB(PG8_SB(0, 1), cB + HSTEP); PG8_STAGEA(PG8_SA(0, 0), cA, vaC[0][0], vaC[0][1]); PG8_STAGEA(PG8_SA(0, 1), cA + AHSTEP, vaC[1][0], vaC[1][1]);
    if (wr == 1) PG8_BAR;
    PG8_WAIT_V(2); PG8_BAR;
    PG8_STAGEB(PG8_SB(1, 0), cB + KSTEP); PG8_STAGEA(PG8_SA(1, 0), cA + KSTEP, vaC[0][0], vaC[0][1]); PG8_STAGEB(PG8_SB(1, 1), cB + HSTEP + KSTEP);
    PG8_WAIT_V(6); PG8_BAR;
    for (;;) {
        const bool has_next = S.next(ui + 1, nxt);
        const LAS int* tbn = (const LAS int*)(tokbuf + ((ui + 1) & 1) * 1024);
        if constexpr (GATHER) {
            if (has_next && wid == 0) __builtin_amdgcn_global_load_lds(PG8_TOKSRC(nxt), (LAS unsigned*)(tokbuf + ((ui + 1) & 1) * 1024), 16, 0, 0);
        }
#pragma unroll 1
        for (int t = 0; t < NT; t += 2) {
            const bool last = (t == NT - 2);
            const char* a1 = cA + (size_t)(t + 1) * KSTEP;
            const char* a2 = cA + (size_t)(t + 2) * KSTEP; const char* b2 = cB + (size_t)(t + 2) * KSTEP;
            unsigned o00 = vaC[0][0], o01 = vaC[0][1], o10 = vaC[1][0], o11 = vaC[1][1];
            if (last) {
                if (has_next) { a2 = PG8_ABASE(nxt); b2 = PG8_BBASE(nxt);
                    if constexpr (GATHER) { o00 = tok_off(tbn, 0, 0, 4096u); o01 = tok_off(tbn, 0, 1, 4096u); o10 = tok_off(tbn, 1, 0, 4096u); o11 = tok_off(tbn, 1, 1, 4096u); } }
                else { a2 = cA; b2 = cB; }
            }
            const char* a3 = a2 + KSTEP; const char* b3 = b2 + KSTEP;
            PG8_LDB(B0, 0, 0); PG8_LDB(B1, 0, 1); PG8_SCHED; PG8_LDA(At, 0, 0); PG8_STAGEA(PG8_SA(1, 1), a1 + AHSTEP, vaC[1][0], vaC[1][1]);
            PG8_WAIT_V(8); PG8_WAIT_L(0); PG8_BAR; PG8_MMA(0, 0, At, B0); PG8_MMA(0, 1, At, B1); PG8_BAR; PG8_SCHED;
            PG8_LDA(At, 0, 1); PG8_STAGEB(PG8_SB(0, 0), b2); PG8_STAGEB(PG8_SB(0, 1), b2 + HSTEP); PG8_STAGEA(PG8_SA(0, 0), a2, o00, o01);
            PG8_WAIT_V(8); PG8_WAIT_L(0); PG8_BAR; PG8_MMA(1, 0, At, B0); PG8_MMA(1, 1, At, B1); PG8_BAR; PG8_SCHED;
            PG8_LDB(B0, 1, 0); PG8_LDB(B1, 1, 1); PG8_SCHED; PG8_LDA(At, 1, 0); PG8_STAGEA(PG8_SA(0, 1), a2 + AHSTEP, o10, o11);
            PG8_WAIT_V(8); PG8_WAIT_L(0); PG8_BAR; PG8_MMA(0, 0, At, B0); PG8_MMA(0, 1, At, B1); PG8_BAR; PG8_SCHED;
            PG8_LDA(At, 1, 1); PG8_STAGEB(PG8_SB(1, 0), b3); PG8_STAGEB(PG8_SB(1, 1), b3 + HSTEP); PG8_STAGEA(PG8_SA(1, 0), a3, o00, o01);
            PG8_WAIT_V(8); PG8_WAIT_L(0); PG8_BAR; PG8_MMA(1, 0, At, B0); PG8_MMA(1, 1, At, B1); PG8_BAR; PG8_SCHED;
        }
        if (wr == 0) PG8_BAR;
        E(acc, cur, wr, wc, fr, fq);
        if (!has_next) break;
#pragma unroll
        for (int a = 0; a < 2; ++a)
#pragma unroll
            for (int b = 0; b < 2; ++b)
#pragma unroll
                for (int m = 0; m < 4; ++m)
#pragma unroll
                    for (int n = 0; n < 2; ++n) acc[a][b][m][n] = (f32x4){0.f, 0.f, 0.f, 0.f};
        if constexpr (GATHER) {
#pragma unroll
            for (int h = 0; h < 2; ++h)
#pragma unroll
                for (int i = 0; i < 2; ++i) vaC[h][i] = tok_off(tbn, h, i, 4096u);
            PG8_WAIT_L(0);
        }
        cur = nxt; cA = PG8_ABASE(cur); cB = PG8_BBASE(cur); ++ui;
        if (wr == 1) PG8_BAR;
    }
    PG8_WAIT_V(0);
    PG8_BAR;
#undef PG8_SA
#undef PG8_SB
#undef PG8_STAGEA
#undef PG8_STAGEB
#undef PG8_LDA
#undef PG8_LDB
#undef PG8_MMA
#undef PG8_WAIT_V
#undef PG8_WAIT_L
#undef PG8_BAR
#undef PG8_SCHED
#undef PG8_ABASE
#undef PG8_BBASE
#undef PG8_TOKSRC
}
}

struct EpiInProj {
    static constexpr bool PERM = true;
    DI void operator()(f32x4 (&acc)[2][2][4][2], const pg8::Unit& u, int wr, int wc, int fr, int fq) const {
        const int pn = u.pn;
        int kind, head, ldc; size_t boff;
        if (pn < 2) { kind = 0; head = 4 * pn + wc; boff = WS_QB; ldc = 512; }
        else if (pn == 2) { if (wc < 2) { kind = 1; head = wc; boff = WS_KB; } else { kind = 2; head = wc - 2; boff = WS_VB; } ldc = 128; }
        else if (pn < 5) { kind = 3; head = 4 * (pn - 3) + wc; boff = WS_GUB; ldc = 512; }
        else { kind = 4; head = 4 * (pn - 5) + wc; boff = WS_GVB; ldc = 512; }
        unsigned char* ws = wsp();
        bf16_t* base = (bf16_t*)(ws + boff);
        const float* b_in = inp<I_BIN>();
        const int src0 = 256 * pn + 64 * wc + 8 * fq;
#pragma unroll
        for (int bj = 0; bj < 2; ++bj)
#pragma unroll
            for (int n = 0; n < 2; ++n) { const f32x4 bv = *(const f32x4*)(b_in + src0 + 32 * bj + 4 * n);
#pragma unroll
                for (int ai = 0; ai < 2; ++ai)
#pragma unroll
                    for (int m = 0; m < 4; ++m) acc[ai][bj][m][n] += bv; }
        const float* rope = (const float*)(ws + WS_ROPE);
        const float* gn_g = inp<I_GNG>(); const float* gn_b = inp<I_GNB>();
        const int row0 = u.pm * 256 + wr * 64 + fr;
#pragma unroll
        for (int ai = 0; ai < 2; ++ai)
#pragma unroll
            for (int m = 0; m < 4; ++m) {
                const int row = row0 + ai * 128 + m * 16;
                f32x4 v[2][2];
#pragma unroll
                for (int bj = 0; bj < 2; ++bj)
#pragma unroll
                    for (int n = 0; n < 2; ++n) v[bj][n] = acc[ai][bj][m][n];
                if (kind <= 1) {
                    const float* cs = rope + (size_t)row * 16;
#pragma unroll
                    for (int n = 0; n < 2; ++n) {
                        const f32x4 c4 = *(const f32x4*)(cs + 4 * n), s4 = *(const f32x4*)(cs + 8 + 4 * n);
                        f32x4 p4; p4[0] = __shfl_xor(v[0][n][0], 16); p4[1] = __shfl_xor(v[0][n][1], 16); p4[2] = __shfl_xor(v[0][n][2], 16); p4[3] = __shfl_xor(v[0][n][3], 16);
                        const f32x4 sg = (fq & 1) ? s4 : -s4;
                        const f32x4 rot = v[0][n] * c4 + p4 * sg;
                        if (fq < 2) v[0][n] = rot;
                    }
                    if (kind == 0) {
#pragma unroll
                        for (int bj = 0; bj < 2; ++bj)
#pragma unroll
                            for (int n = 0; n < 2; ++n) v[bj][n] = v[bj][n] * QSCALE;
                    }
                } else if (kind >= 3) {
#pragma unroll
                    for (int bj = 0; bj < 2; ++bj)
#pragma unroll
                        for (int n = 0; n < 2; ++n) v[bj][n] = gelu4(v[bj][n]);
                    if (kind == 4) {
                        float s = 0.f;
#pragma unroll
                        for (int bj = 0; bj < 2; ++bj)
#pragma unroll
                            for (int n = 0; n < 2; ++n) s += (v[bj][n][0] + v[bj][n][1]) + (v[bj][n][2] + v[bj][n][3]);
                        s += __shfl_xor(s, 16); s += __shfl_xor(s, 32);
                        const float mean = s * (1.0f / 64.0f); float q = 0.f;
#pragma unroll
                        for (int bj = 0; bj < 2; ++bj)
#pragma unroll
                            for (int n = 0; n < 2; ++n) { v[bj][n] = v[bj][n] - mean; const f32x4 d = v[bj][n]; q += (d[0] * d[0] + d[1] * d[1]) + (d[2] * d[2] + d[3] * d[3]); }
                        q += __shfl_xor(q, 16); q += __shfl_xor(q, 32);
                        const float rstd = 1.0f / sqrtf(q * (1.0f / 64.0f) + LN_EPS);
#pragma unroll
                        for (int bj = 0; bj < 2; ++bj)
#pragma unroll
                            for (int n = 0; n < 2; ++n) v[bj][n] = v[bj][n] * rstd * *(const f32x4*)(gn_g + 32 * bj + 8 * fq + 4 * n) + *(const f32x4*)(gn_b + 32 * bj + 8 * fq + 4 * n);
                    }
                }
                bf16_t* rowp = base + (size_t)row * ldc + head * 64 + 8 * fq;
#pragma unroll
                for (int bj = 0; bj < 2; ++bj) { u32x4 w; w.x = cvtpk(v[bj][0][0], v[bj][0][1]); w.y = cvtpk(v[bj][0][2], v[bj][0][3]); w.z = cvtpk(v[bj][1][0], v[bj][1][1]); w.w = cvtpk(v[bj][1][2], v[bj][1][3]);
                    *(u32x4*)(rowp + 32 * bj) = w; }
            }
    }
};
struct EpiOut {
    static constexpr bool PERM = false;
    DI void operator()(f32x4 (&acc)[2][2][4][2], const pg8::Unit& u, int wr, int wc, int fr, int fq) const {
        const int col0 = u.pn * 256 + wc * 32 + 4 * fq;
        unsigned char* ws = wsp(); float* y1 = outp();
        const float* outc = (const float*)(ws + WS_OUTC); const float* stats0 = (const float*)(ws + WS_STATS0);
        const float* x = inp<I_X>();
        f32x4 ca[2][2];
#pragma unroll
        for (int bj = 0; bj < 2; ++bj)
#pragma unroll
            for (int n = 0; n < 2; ++n) { ca[bj][n] = *(const f32x4*)(outc + col0 + bj * 128 + n * 16); const f32x4 cb = *(const f32x4*)(outc + 1024 + col0 + bj * 128 + n * 16);
#pragma unroll
                for (int ai = 0; ai < 2; ++ai)
#pragma unroll
                    for (int m = 0; m < 4; ++m) acc[ai][bj][m][n] += cb; }
        const int row0 = u.pm * 256 + wr * 64 + fr;
#pragma unroll
        for (int ai = 0; ai < 2; ++ai)
#pragma unroll
            for (int m = 0; m < 4; ++m) {
                const int row = row0 + ai * 128 + m * 16;
                const f32x2 st = *(const f32x2*)(stats0 + (size_t)row * 2);
                const size_t off = (size_t)row * D + col0;
#pragma unroll
                for (int bj = 0; bj < 2; ++bj)
#pragma unroll
                    for (int n = 0; n < 2; ++n) { const f32x4 xv = *(const f32x4*)(x + off + bj * 128 + n * 16);
                        const f32x4 o = acc[ai][bj][m][n] + (xv - st.x) * st.y * ca[bj][n];
                        *(f32x4*)(y1 + off + bj * 128 + n * 16) = o; }
                if (m & 1) asm volatile("" ::: "memory");
            }
    }
};
struct EpiGateUp {
    static constexpr bool PERM = true;
    int g0;
    DI void operator()(f32x4 (&acc)[2][2][4][2], const pg8::Unit& u, int wr, int wc, int fr, int fq) const {
        const int hcol0 = 128 * u.pn + 32 * wc + 8 * fq;
        const float* bias = inp<I_BGU>() + (size_t)u.e * 2048;
        bf16_t* hmid = (bf16_t*)(wsp() + WS_HMID);
        f32x4 bg[2], bu[2];
#pragma unroll
        for (int n = 0; n < 2; ++n) { bg[n] = *(const f32x4*)(bias + hcol0 + 4 * n); bu[n] = *(const f32x4*)(bias + 1024 + hcol0 + 4 * n); }
        const size_t row0 = (size_t)(u.pm - g0) * 256 + wr * 64 + fr;
#pragma unroll
        for (int ai = 0; ai < 2; ++ai)
#pragma unroll
            for (int m = 0; m < 4; ++m) {
                float h[2][4];
#pragma unroll
                for (int n = 0; n < 2; ++n) {
                    const f32x4 gt = acc[ai][0][m][n] + bg[n], up = acc[ai][1][m][n] + bu[n];
#pragma unroll
                    for (int j = 0; j < 4; ++j) {
                        const float gc = fminf(gt[j], 7.0f), uc = fminf(fmaxf(up[j], -7.0f), 7.0f);
                        const float sg = __builtin_amdgcn_rcpf(1.0f + __builtin_amdgcn_exp2f(gc * (-1.702f * LOG2E)));
                        h[n][j] = (uc + 1.0f) * (gc * sg);
                    }
                }
                u32x4 w; w.x = cvtpk(h[0][0], h[0][1]); w.y = cvtpk(h[0][2], h[0][3]); w.z = cvtpk(h[1][0], h[1][1]); w.w = cvtpk(h[1][2], h[1][3]);
                *(u32x4*)(hmid + (row0 + ai * 128 + m * 16) * 1024 + hcol0) = w;
            }
    }
};
struct EpiDown {
    static constexpr bool PERM = true;
    DI void operator()(f32x4 (&acc)[2][2][4][2], const pg8::Unit& u, int wr, int wc, int fr, int fq) const {
        const int col0 = 256 * u.pn + 32 * wc + 8 * fq;
        const float* bias = inp<I_BD>() + (size_t)u.e * 1024;
        unsigned char* ws = wsp();
        bf16_t* yslot = (bf16_t*)(ws + WS_YSLOT); const int* slot_dest = (const int*)(ws + WS_SLOTDEST); const float* slot_gate = (const float*)(ws + WS_SLOTGATE);
        f32x4 bd[2][2];
#pragma unroll
        for (int bj = 0; bj < 2; ++bj)
#pragma unroll
            for (int n = 0; n < 2; ++n) bd[bj][n] = *(const f32x4*)(bias + col0 + 128 * bj + 4 * n);
        const int slot0 = u.pm * 256 + wr * 64 + fr;
#pragma unroll
        for (int ai = 0; ai < 2; ++ai)
#pragma unroll
            for (int m = 0; m < 4; ++m) {
                const int slot = slot0 + ai * 128 + m * 16;
                const int dest = slot_dest[slot];
                const float gt = slot_gate[slot];
                if (dest >= 0) {
                    bf16_t* rowp = yslot + (size_t)dest * 1024 + col0;
#pragma unroll
                    for (int bj = 0; bj < 2; ++bj) { const f32x4 v0 = (acc[ai][bj][m][0] + bd[bj][0]) * gt, v1 = (acc[ai][bj][m][1] + bd[bj][1]) * gt;
                        u32x4 w; w.x = cvtpk(v0[0], v0[1]); w.y = cvtpk(v0[2], v0[3]); w.z = cvtpk(v1[0], v1[1]); w.w = cvtpk(v1[2], v1[3]);
                        *(u32x4*)(rowp + 128 * bj) = w; }
                }
            }
    }
};

DI int rowmap(int kind, int n) {
    if (kind == 0) { const int pn = n >> 8, ch = n & 255, wc = ch >> 6, bj = (ch >> 5) & 1, w = ch & 31; return (pn << 8) + (bj << 7) + (wc << 5) + w; }
    if (kind == 2) { return n < 1024 ? ((n >> 7) << 8) + (n & 127) : (((n - 1024) >> 7) << 8) + 128 + ((n - 1024) & 127); }
    return n;
}
DI void p0_transpose_item(const float* W, int N, bf16_t* WT, int kind, LAS unsigned char* scr, int item, int lane) {
    const int nblk = N / 64, kb = item / nblk, nb = item % nblk, k0 = 64 * kb, n0 = 64 * nb;
    const int nq = lane >> 2, kr = lane & 3;
    f32x4 a[8], b[8];
#pragma unroll
    for (int i = 0; i < 8; ++i) { const float* p = W + (size_t)(k0 + 8 * i + 2 * kr) * N + n0 + 4 * nq; a[i] = *(const GAS f32x4*)p; b[i] = *(const GAS f32x4*)(p + N); }
#pragma unroll
    for (int i = 0; i < 8; ++i)
#pragma unroll
        for (int c = 0; c < 4; ++c) *(LAS unsigned*)(scr + (4 * nq + c) * 132 + (8 * i + 2 * kr) * 2) = cvtpk(a[i][c], b[i][c]);
    LDS_WAIT(); asm volatile("" ::: "memory");
    const int c8 = lane & 7;
#pragma unroll
    for (int j = 0; j < 8; ++j) { const int n = (lane >> 3) + 8 * j; const LAS unsigned* s = (const LAS unsigned*)(scr + n * 132 + 16 * c8);
        u32x4 o; o.x = s[0]; o.y = s[1]; o.z = s[2]; o.w = s[3];
        *(GAS u32x4*)(WT + (size_t)rowmap(kind, n0 + n) * 1024 + k0 + 8 * c8) = o; }
    LDS_WAIT(); asm volatile("" ::: "memory");
}
DI void p0_prologue(const Frame& F0, LAS unsigned char* lds) {
    const Frame F = opaque(F0);
    unsigned char* ws = wsp();
    LAS unsigned char* scr = lds + F.wave * 16384;
    const int gw = F.bid * NWAVES + F.wave, NGW = G * NWAVES;
    const int gt = F.bid * NTHREADS + F.tid, NGT = G * NTHREADS;
    constexpr int I_IN = (D / 64) * (INW / 64), I_OUT = (D / 64) * (D / 64), I_GU = (D / 64) * (2048 / 64), I_D = (D / 64) * (D / 64);
    constexpr int NITEMS = I_IN + I_OUT + NE * (I_GU + I_D);
    for (int it = gw; it < NITEMS; it += NGW) {
        int r = it;
        if (r < I_IN) { p0_transpose_item(inp<I_WIN>(), INW, (bf16_t*)(ws + WS_WIN), 0, scr, r, F.lane); continue; } r -= I_IN;
        if (r < I_OUT) { p0_transpose_item(inp<I_WOUT>(), D, (bf16_t*)(ws + WS_WOUT), 1, scr, r, F.lane); continue; } r -= I_OUT;
        if (r < NE * I_GU) { const int e = r / I_GU; p0_transpose_item(inp<I_WGU>() + (size_t)e * D * 2048, 2048, (bf16_t*)(ws + WS_WGU) + (size_t)e * 2048 * D, 2, scr, r % I_GU, F.lane); continue; } r -= NE * I_GU;
        { const int e = r / I_D; p0_transpose_item(inp<I_WD>() + (size_t)e * D * D, D, (bf16_t*)(ws + WS_WD) + (size_t)e * D * D, 1, scr, r % I_D, F.lane); }
    }
    bf16_t* h0b = (bf16_t*)(ws + WS_H0B); float* stats0 = (float*)(ws + WS_STATS0);
    const float* xin = inp<I_X>(); const float* lg = inp<I_LNING>(); const float* lb = inp<I_LNINB>();
    for (int m = gw; m < T; m += NGW) {
        const GAS f32x4* xr = (const GAS f32x4*)(xin + (size_t)m * D) + F.lane;
        f32x4 v[4]; float s = 0.f;
#pragma unroll
        for (int j = 0; j < 4; ++j) { v[j] = xr[64 * j]; s += (v[j].x + v[j].y) + (v[j].z + v[j].w); }
        const float mean = wave_sum(s) * (1.f / D); float s2 = 0.f;
#pragma unroll
        for (int j = 0; j < 4; ++j) { v[j] = v[j] - mean; s2 += (v[j].x * v[j].x + v[j].y * v[j].y) + (v[j].z * v[j].z + v[j].w * v[j].w); }
        const float rstd = 1.f / sqrtf(wave_sum(s2) * (1.f / D) + LN_EPS);
        GAS u32x2* o8 = (GAS u32x2*)(h0b + (size_t)m * D) + F.lane;
#pragma unroll
        for (int j = 0; j < 4; ++j) { const f32x4 gg = ((const f32x4*)lg)[F.lane + 64 * j], bb = ((const f32x4*)lb)[F.lane + 64 * j];
            const f32x4 r = v[j] * rstd * gg + bb; u32x2 w; w.x = cvtpk(r.x, r.y); w.y = cvtpk(r.z, r.w); o8[64 * j] = w; }
        if (F.lane == 0) { stats0[2 * m] = mean; stats0[2 * m + 1] = rstd; }
    }
    float* rope = (float*)(ws + WS_ROPE); const int* positions = (const int*)inp<I_POS>();
    for (int i = gt; i < T * 8; i += NGT) {
        const int tok = i >> 3, j = i & 7;
        const float inv = powf(500000.0f, -(float)(2 * j) / 16.0f);
        const float ang = (float)positions[tok] * inv;
        rope[tok * 16 + j] = cosf(ang); rope[tok * 16 + 8 + j] = sinf(ang);
    }
    int* slot_tok = (int*)(ws + WS_SLOTTOK); int* slot_dest = (int*)(ws + WS_SLOTDEST);
    for (int i = gt; i < NSLOT; i += NGT) { slot_tok[i] = -1; slot_dest[i] = -1; }
    float* outc = (float*)(ws + WS_OUTC); const float* bo = inp<I_BOUT>();
    for (int i = gt; i < D; i += NGT) { outc[i] = ALPHA * lg[i]; outc[1024 + i] = bo[i] + ALPHA * lb[i]; }
    bf16_t* wsp = (bf16_t*)(ws + WS_WSP); const float* w_s = inp<I_WS>();
    for (int i = gt; i < 8 * 128 * 128; i += NGT) {
        const int j = i & 7, hi = (i >> 3) & 1, ks = (i >> 4) & 7, t = (i >> 7) & 127, h = i >> 14;
        const int s = 16 * ks + 8 * (j >> 2) + 4 * hi + (j & 3);
        const float w = (s <= t) ? w_s[((size_t)h * 128 + t) * 128 + s] : 0.f;
        wsp[i] = (bf16_t)(cvtpk(w, 0.f) & 0xffffu);
    }
}

#define MFMA32(a, b, c) __builtin_amdgcn_mfma_f32_32x32x16_bf16((a), (b), (c), 0, 0, 0)
DI int crow(int r, int hi) { return (r & 3) + 8 * (r >> 2) + 4 * hi; }
DI bf16x8 cat4(s16x4 lo, s16x4 hi) { return __builtin_shufflevector(lo, hi, 0, 1, 2, 3, 4, 5, 6, 7); }
DI void attn_unit(const Frame& F0, LAS unsigned char* lds, int u) {
    const Frame F = opaque(F0);
    unsigned char* ws = wsp();
    const int b = u >> 6, n = (u >> 1) & 31, kvh = u & 1;
    const int tok0 = b * SEQ + n * 128;
    const bf16_t* Qb = (const bf16_t*)(ws + WS_QB); const bf16_t* Kb = (const bf16_t*)(ws + WS_KB); const bf16_t* Vb = (const bf16_t*)(ws + WS_VB);
    bf16_t* Ob = (bf16_t*)(ws + WS_H0B);
    LAS unsigned char* Kl = lds;
    LAS unsigned char* Vt = lds + 36864;
    LAS float* scr = (LAS float*)(lds + 36864 + 32768) + F.wave * 64;
#pragma unroll
    for (int rep = 0; rep < 4; ++rep) {
        const int c = F.tid + 512 * rep, kw = c >> 3, ch = c & 7;
        int tokk = tok0 - 128 + kw; if (n == 0 && kw < 128) tokk = tok0 + kw;
        const u32x4 kv = *(const u32x4*)(Kb + (size_t)tokk * 128 + kvh * 64 + ch * 8);
        *(LAS u32x4*)(Kl + kw * 144 + ch * 16) = kv;
        const u32x4 vv = *(const u32x4*)(Vb + (size_t)tokk * 128 + kvh * 64 + ch * 8);
        const unsigned wv[4] = {vv.x, vv.y, vv.z, vv.w};
#pragma unroll
        for (int e = 0; e < 8; ++e) { const int d = ch * 8 + e; const unsigned short val = (unsigned short)((e & 1) ? (wv[e >> 1] >> 16) : (wv[e >> 1] & 0xffffu));
            *(LAS unsigned short*)(Vt + d * 512 + ((((kw >> 2) ^ (d & 31))) << 3) + (kw & 3) * 2) = val; }
    }
    __syncthreads();
    const int g = F.wave >> 1, rh = F.wave & 1, hq = kvh * 4 + g;
    const int q = F.lane & 31, hi = F.lane >> 5;
    const float sink2 = inp<I_SINKS>()[hq] * LOG2E;
#pragma unroll 1
    for (int sb = 0; sb < 2; ++sb) {
        const int r0 = rh * 64 + sb * 32, kb0 = r0 >> 5;
        const bf16_t* qp = Qb + (size_t)(tok0 + r0 + q) * 512 + hq * 64 + hi * 8;
        bf16x8 qf[4];
#pragma unroll
        for (int ds = 0; ds < 4; ++ds) qf[ds] = *(const bf16x8*)(qp + ds * 16);
        f32x16 p[5];
#pragma unroll
        for (int kbi = 0; kbi < 5; ++kbi) {
            f32x16 a = {};
#pragma unroll
            for (int ds = 0; ds < 4; ++ds) { const bf16x8 kf = *(const LAS bf16x8*)(Kl + ((kb0 + kbi) * 32 + q) * 144 + (ds * 16 + hi * 8) * 2); a = MFMA32(kf, qf[ds], a); }
            p[kbi] = a;
        }
        const int qi = 128 + r0 + q;
        float mx = sink2;
#pragma unroll
        for (int kbi = 0; kbi < 5; ++kbi)
#pragma unroll
            for (int r = 0; r < 16; ++r) { const int kw = (kb0 + kbi) * 32 + crow(r, hi); const bool ok = (kw <= qi) && (qi - kw < 128) && (n > 0 || kw >= 128);
                const float s = ok ? p[kbi][r] : -1e30f; p[kbi][r] = s; mx = fmaxf(mx, s); }
        mx = fmaxf(mx, __shfl_xor(mx, 32));
        float l = 0.f;
#pragma unroll
        for (int kbi = 0; kbi < 5; ++kbi)
#pragma unroll
            for (int r = 0; r < 16; ++r) { const float e = __builtin_amdgcn_exp2f(p[kbi][r] - mx); p[kbi][r] = e; l += e; }
        l += __shfl_xor(l, 32); l += __builtin_amdgcn_exp2f(sink2 - mx);
        f32x16 o0 = {}, o1 = {};
#pragma unroll
        for (int kbi = 0; kbi < 5; ++kbi)
#pragma unroll
            for (int s2 = 0; s2 < 2; ++s2) {
                u32x4 pw; pw.x = cvtpk(p[kbi][8 * s2 + 0], p[kbi][8 * s2 + 1]); pw.y = cvtpk(p[kbi][8 * s2 + 2], p[kbi][8 * s2 + 3]);
                pw.z = cvtpk(p[kbi][8 * s2 + 4], p[kbi][8 * s2 + 5]); pw.w = cvtpk(p[kbi][8 * s2 + 6], p[kbi][8 * s2 + 7]);
                const bf16x8 pa = __builtin_bit_cast(bf16x8, pw);
                const int kc = ((kb0 + kbi) * 32 + 16 * s2 + 4 * hi) >> 2;
                { const int d = q; const s16x4 lo = *(const LAS s16x4*)(Vt + d * 512 + ((kc ^ (d & 31)) << 3)), hh = *(const LAS s16x4*)(Vt + d * 512 + (((kc + 2) ^ (d & 31)) << 3)); o0 = MFMA32(pa, cat4(lo, hh), o0); }
                { const int d = 32 + q; const s16x4 lo = *(const LAS s16x4*)(Vt + d * 512 + ((kc ^ (d & 31)) << 3)), hh = *(const LAS s16x4*)(Vt + d * 512 + (((kc + 2) ^ (d & 31)) << 3)); o1 = MFMA32(pa, cat4(lo, hh), o1); }
            }
        if (hi == 0) scr[q] = l;
        LDS_WAIT();
        bf16_t* op = Ob + (size_t)(tok0 + r0) * D + hq * 64 + q;
#pragma unroll
        for (int r = 0; r < 16; ++r) { const int qr = crow(r, hi); const float rl = __builtin_amdgcn_rcpf(scr[qr]);
            op[(size_t)qr * D] = (bf16_t)(cvtpk(o0[r] * rl, 0.f) & 0xffffu); op[(size_t)qr * D + 32] = (bf16_t)(cvtpk(o1[r] * rl, 0.f) & 0xffffu); }
        LDS_WAIT();
    }
    __syncthreads();
}
DI void gmlp_unit(const Frame& F0, LAS unsigned char* lds, int chunk) {
    const Frame F = opaque(F0);
    unsigned char* ws = wsp();
    const int h = F.wave, tok0 = chunk * 128;
    const bf16_t* GUb = (const bf16_t*)(ws + WS_GUB); const bf16_t* GVb = (const bf16_t*)(ws + WS_GVB); const bf16_t* wsp = (const bf16_t*)(ws + WS_WSP);
    bf16_t* Ob = (bf16_t*)(ws + WS_H0B);
    LAS unsigned char* Vt = lds + F.wave * 16384;
#pragma unroll 4
    for (int rep = 0; rep < 16; ++rep) {
        const int c = F.lane + 64 * rep, s = c >> 3, ch = c & 7;
        const u32x4 vv = *(const u32x4*)(GVb + (size_t)(tok0 + s) * 512 + h * 64 + ch * 8);
        const unsigned wv[4] = {vv.x, vv.y, vv.z, vv.w};
#pragma unroll
        for (int e = 0; e < 8; ++e) { const int d = ch * 8 + e; const unsigned short val = (unsigned short)((e & 1) ? (wv[e >> 1] >> 16) : (wv[e >> 1] & 0xffffu));
            *(LAS unsigned short*)(Vt + d * 256 + (((s >> 2) ^ (d & 31)) << 3) + (s & 3) * 2) = val; }
    }
    LDS_WAIT();
    const int q = F.lane & 31, hi = F.lane >> 5;
    const float* b_s = inp<I_BS>();
#pragma unroll 1
    for (int tb = 0; tb < 4; ++tb) {
        f32x16 a0 = {}, a1 = {};
        const bf16_t* wp = wsp + ((size_t)(h * 128 + tb * 32 + q) * 8) * 16 + hi * 8;
        for (int ks = 0; ks < 2 * tb + 2; ++ks) {
            const bf16x8 wa = *(const bf16x8*)(wp + ks * 16);
            const int kc = (16 * ks + 4 * hi) >> 2;
            { const int d = q; const s16x4 lo = *(const LAS s16x4*)(Vt + d * 256 + ((kc ^ (d & 31)) << 3)), hh = *(const LAS s16x4*)(Vt + d * 256 + (((kc + 2) ^ (d & 31)) << 3)); a0 = MFMA32(wa, cat4(lo, hh), a0); }
            { const int d = 32 + q; const s16x4 lo = *(const LAS s16x4*)(Vt + d * 256 + ((kc ^ (d & 31)) << 3)), hh = *(const LAS s16x4*)(Vt + d * 256 + (((kc + 2) ^ (d & 31)) << 3)); a1 = MFMA32(wa, cat4(lo, hh), a1); }
        }
#pragma unroll
        for (int r = 0; r < 16; ++r) { const int t = tb * 32 + crow(r, hi); const float bias = b_s[h * 128 + t];
            const bf16_t* gp = GUb + (size_t)(tok0 + t) * 512 + h * 64 + q; bf16_t* op = Ob + (size_t)(tok0 + t) * D + 512 + h * 64 + q;
            op[0] = (bf16_t)(cvtpk(bf2f(gp[0]) * (a0[r] + bias), 0.f) & 0xffffu); op[32] = (bf16_t)(cvtpk(bf2f(gp[32]) * (a1[r] + bias), 0.f) & 0xffffu); }
    }
    LDS_WAIT();
}

DI void p4_router(const Frame& F0, LAS unsigned char* lds) {
    const Frame F = opaque(F0);
    unsigned char* ws = wsp(); float* out = outp();
    LAS float* wrT = (LAS float*)lds;
    LAS int* cnt = (LAS int*)(lds + MISC_OFF + 256);
    { const float* w_router = inp<I_WR>(); for (int i = F.tid; i < D * NE; i += NTHREADS) { const int c = i >> 5, e = i & 31; wrT[e * D + c] = w_router[i]; } }
    if (F.tid < 32) cnt[F.tid] = 0;
    __syncthreads();
    const int R = T / G, rpw = R / NWAVES;
    int* tok_e = (int*)(ws + WS_TOKE); float* tok_g = (float*)(ws + WS_TOKG); int* tok_l = (int*)(ws + WS_TOKL);
    const int lane = F.lane;
    f32x4 g1[4], b1[4];
#pragma unroll
    for (int j = 0; j < 4; ++j) { g1[j] = ((const f32x4*)inp<I_LN1G>())[lane + 64 * j]; b1[j] = ((const f32x4*)inp<I_LN1B>())[lane + 64 * j]; }
    const float br = inp<I_BR>()[lane >> 1];
    constexpr int NR = 1;
#pragma unroll 1
    for (int i = 0; i < rpw; i += NR) {
        const int tok0 = F.bid * R + F.wave * rpw + i;
        f32x4 v[NR][4];
#pragma unroll
        for (int r = 0; r < NR; ++r) {
            const float* rowp = out + (size_t)(tok0 + r) * D;
#pragma unroll
            for (int j = 0; j < 4; ++j) v[r][j] = ((const GAS f32x4*)rowp)[lane + 64 * j];
        }
        float s[NR], s2[NR];
#pragma unroll
        for (int r = 0; r < NR; ++r) { s[r] = 0.f;
#pragma unroll
            for (int j = 0; j < 4; ++j) s[r] += (v[r][j].x + v[r][j].y) + (v[r][j].z + v[r][j].w); }
        for (int r = 0; r < NR; ++r) s[r] = wave_sum(s[r]) * (1.f / D);
#pragma unroll
        for (int r = 0; r < NR; ++r) { s2[r] = 0.f;
#pragma unroll
            for (int j = 0; j < 4; ++j) { v[r][j] = v[r][j] - s[r]; s2[r] += (v[r][j].x * v[r][j].x + v[r][j].y * v[r][j].y) + (v[r][j].z * v[r][j].z + v[r][j].w * v[r][j].w); } }
        for (int r = 0; r < NR; ++r) s2[r] = 1.f / sqrtf(wave_sum(s2[r]) * (1.f / D) + LN_EPS);
#pragma unroll
        for (int r = 0; r < NR; ++r) {
            float* rowp = out + (size_t)(tok0 + r) * D;
            GAS u32x2* hp = (GAS u32x2*)rowp + lane; GAS u32x2* lp = (GAS u32x2*)(rowp + 512) + lane;
#pragma unroll
            for (int j = 0; j < 4; ++j) {
                v[r][j] = v[r][j] * s2[r] * g1[j] + b1[j];
                u32x2 wh; wh.x = cvtpk(v[r][j].x, v[r][j].y); wh.y = cvtpk(v[r][j].z, v[r][j].w);
                u32x2 wl; wl.x = cvtpk(v[r][j].x - bflo(wh.x), v[r][j].y - bfhi(wh.x)); wl.y = cvtpk(v[r][j].z - bflo(wh.y), v[r][j].w - bfhi(wh.y));
                hp[64 * j] = wh; lp[64 * j] = wl;
            }
        }
        float acc[NR][32];
        unsigned wb0 = (unsigned)(16 * lane), wb1 = wb0 + 65536u; asm volatile("" : "+v"(wb0), "+v"(wb1));
#pragma unroll
        for (int e = 0; e < 32; ++e) {
            f32x2 a2[NR]; for (int r = 0; r < NR; ++r) a2[r] = (f32x2){0.f, 0.f};
#pragma unroll
            for (int j = 0; j < 4; ++j) { const f32x4 w4 = *(const LAS f32x4*)((LAS unsigned char*)wrT + (e < 16 ? wb0 : wb1) + (e & 15) * 4096 + 1024 * j);
#pragma unroll
                for (int r = 0; r < NR; ++r) { a2[r] = a2[r] + (f32x2){v[r][j].x, v[r][j].y} * (f32x2){w4.x, w4.y}; a2[r] = a2[r] + (f32x2){v[r][j].z, v[r][j].w} * (f32x2){w4.z, w4.w}; } }
            for (int r = 0; r < NR; ++r) acc[r][e] = a2[r].x + a2[r].y;
            if ((e & 1) == 1) __builtin_amdgcn_sched_barrier(0);
        }
#pragma unroll
        for (int r = 0; r < NR; ++r) {
#pragma unroll
            for (int e = 0; e < 16; ++e) { float a = acc[r][e], b = acc[r][e + 16]; swap32(a, b); acc[r][e] = a + b; }
#pragma unroll
            for (int e = 0; e < 8; ++e) { float a = acc[r][e], b = acc[r][e + 8]; swap16(a, b); acc[r][e] = a + b; }
#pragma unroll
            for (int e = 0; e < 4; ++e) { const bool up = (lane & 8) != 0; const float keep = up ? acc[r][e + 4] : acc[r][e], send = up ? acc[r][e] : acc[r][e + 4]; acc[r][e] = keep + dppf<DPP_MIRROR>(send); }
#pragma unroll
            for (int e = 0; e < 2; ++e) { const bool up = (lane & 4) != 0; const float keep = up ? acc[r][e + 2] : acc[r][e], send = up ? acc[r][e] : acc[r][e + 2]; acc[r][e] = keep + dppf<DPP_HMIRROR>(send); }
            { const bool up = (lane & 2) != 0; const float keep = up ? acc[r][1] : acc[r][0], send = up ? acc[r][0] : acc[r][1]; acc[r][0] = keep + dppf<DPP_XOR2>(send); }
            const float logit = acc[r][0] + dppf<DPP_XOR1>(acc[r][0]) + br;
            const int myE = lane >> 1;
            float vals[4]; int idxs[4]; float cur = logit;
#pragma unroll
            for (int k = 0; k < 4; ++k) {
                float bv = cur; int bi = myE;
#define P4_STEP(LV) { const float ov = partnerf<LV>(bv, lane); const int oi = partneri<LV>(bi, lane); if (ov > bv || (ov == bv && oi < bi)) { bv = ov; bi = oi; } }
                P4_STEP(1) P4_STEP(2) P4_STEP(3) P4_STEP(4) P4_STEP(5)
#undef P4_STEP
                vals[k] = bv; idxs[k] = bi; if (myE == bi) cur = -INFINITY;
            }
            const float e1 = __expf(vals[1] - vals[0]), e2 = __expf(vals[2] - vals[0]), e3 = __expf(vals[3] - vals[0]);
            const float inv = 1.0f / (1.0f + e1 + e2 + e3);
            if (lane < 4) {
                const int tok = tok0 + r;
                const float ee = lane == 0 ? 1.0f : lane == 1 ? e1 : lane == 2 ? e2 : e3;
                const int ex = lane == 0 ? idxs[0] : lane == 1 ? idxs[1] : lane == 2 ? idxs[2] : idxs[3];
                const int lp2 = atomicAdd((int*)(cnt + ex), 1);
                tok_e[tok * 4 + lane] = ex; tok_g[tok * 4 + lane] = ee * inv; tok_l[tok * 4 + lane] = lp2;
            }
        }
    }
    __syncthreads();
    if (F.tid < 32) ((int*)(ws + WS_WGCOUNT))[F.bid * 32 + F.tid] = cnt[F.tid];
}
DI int p4b_lists(const Frame& F0, LAS unsigned char* lds) {
    const Frame F = opaque(F0);
    unsigned char* ws = wsp();
    LAS int* tab = (LAS int*)lds;
    LAS int* pstart = (LAS int*)(lds + MISC_OFF + 256);
    LAS int* mybase = pstart + 64;
    const int* wgc = (const int*)(ws + WS_WGCOUNT);
    for (int i = F.tid; i < G * 32; i += NTHREADS) tab[i] = (int)__hip_atomic_load((unsigned*)wgc + i, __ATOMIC_RELAXED, __HIP_MEMORY_SCOPE_AGENT);
    __syncthreads();
    if (F.tid < 32) { int tot = 0, mb = 0; for (int w = 0; w < G; ++w) { const int c = tab[w * 32 + F.tid]; if (w < F.bid) mb += c; tot += c; } mybase[F.tid] = mb; pstart[32 + 32 + 32 + F.tid] = tot; }
    __syncthreads();
    if (F.tid == 0) { int off = 0; for (int e = 0; e < 32; ++e) { pstart[e] = off; off += ((pstart[96 + e] + 255) >> 8) << 8; } pstart[32] = off; }
    __syncthreads();
    const int ngroups = pstart[32] >> 8;
    if (F.bid == 0) {
        int* grp_e = (int*)(ws + WS_GRPE);
        for (int g = F.tid; g < NGRP_MAX; g += NTHREADS) { int e = 0; for (int k = 1; k < 32; ++k) if (pstart[k] <= g * 256) e = k; grp_e[g] = (g < ngroups) ? e : 0; }
    }
    const int R = T / G;
    const int* tok_e = (const int*)(ws + WS_TOKE); const float* tok_g = (const float*)(ws + WS_TOKG); const int* tok_l = (const int*)(ws + WS_TOKL);
    int* slot_tok = (int*)(ws + WS_SLOTTOK); float* slot_gate = (float*)(ws + WS_SLOTGATE); int* slot_dest = (int*)(ws + WS_SLOTDEST);
    for (int i = F.tid; i < R * 4; i += NTHREADS) {
        const int idx = F.bid * R * 4 + i; const int e = tok_e[idx];
        const int slot = pstart[e] + mybase[e] + tok_l[idx];
        slot_tok[slot] = idx >> 2; slot_gate[slot] = tok_g[idx]; slot_dest[slot] = idx;
    }
    return ngroups;
}
DI void p7_final(const Frame& F0) {
    const Frame F = opaque(F0);
    unsigned char* ws = wsp(); float* out = outp();
    const bf16_t* yslot = (const bf16_t*)(ws + WS_YSLOT);
    const int gw = F.bid * NWAVES + F.wave, NGW = G * NWAVES, lane = F.lane;
    const float* ln2_g = inp<I_LN2G>(); const float* ln2_b = inp<I_LN2B>();
    for (int tok = gw; tok < T; tok += NGW) {
        float* rowp = out + (size_t)tok * D;
        f32x4 v[4];
#pragma unroll
        for (int j = 0; j < 4; ++j) {
            const u32x2 wh = ((const GAS u32x2*)rowp)[lane + 64 * j], wl = ((const GAS u32x2*)(rowp + 512))[lane + 64 * j];
            v[j] = (f32x4){bflo(wh.x) + bflo(wl.x), bfhi(wh.x) + bfhi(wl.x), bflo(wh.y) + bflo(wl.y), bfhi(wh.y) + bfhi(wl.y)} * ALPHA;
        }
#pragma unroll
        for (int k = 0; k < 4; ++k) {
            const GAS u32x2* yp = (const GAS u32x2*)(yslot + ((size_t)tok * 4 + k) * 1024) + lane;
#pragma unroll
            for (int j = 0; j < 4; ++j) { const u32x2 w = yp[64 * j]; v[j] = v[j] + (f32x4){bflo(w.x), bfhi(w.x), bflo(w.y), bfhi(w.y)}; }
        }
        float s = 0.f;
#pragma unroll
        for (int j = 0; j < 4; ++j) s += (v[j].x + v[j].y) + (v[j].z + v[j].w);
        const float mean = wave_sum(s) * (1.f / D); float s2 = 0.f;
#pragma unroll
        for (int j = 0; j < 4; ++j) { v[j] = v[j] - mean; s2 += (v[j].x * v[j].x + v[j].y * v[j].y) + (v[j].z * v[j].z + v[j].w * v[j].w); }
        const float rstd = 1.f / sqrtf(wave_sum(s2) * (1.f / D) + LN_EPS);
#pragma unroll
        for (int j = 0; j < 4; ++j) { const f32x4 gg = ((const f32x4*)ln2_g)[lane + 64 * j], bb = ((const f32x4*)ln2_b)[lane + 64 * j];
            ((GAS f32x4*)rowp)[lane + 64 * j] = v[j] * rstd * gg + bb; }
    }
}

struct CfgIn   { static constexpr size_t A_OFF = WS_H0B,  B_OFF = WS_WIN,  B_E_BYTES = 0; static constexpr bool GATHER = false; };
struct CfgOut  { static constexpr size_t A_OFF = WS_H0B,  B_OFF = WS_WOUT, B_E_BYTES = 0; static constexpr bool GATHER = false; };
struct CfgGU   { static constexpr size_t A_OFF = 0,       B_OFF = WS_WGU,  B_E_BYTES = (size_t)2048 * D * 2; static constexpr bool GATHER = true; };
struct CfgDown { static constexpr size_t A_OFF = WS_HMID, B_OFF = WS_WD,   B_E_BYTES = (size_t)D * D * 2; static constexpr bool GATHER = false; };
#ifndef PHASE_MASK
#define PHASE_MASK 0xFFFF
#endif
struct Args { const void* in[23]; float* out; unsigned char* ws; };
__global__ void __launch_bounds__(NTHREADS, 2) mk_fwd(Args args) {
    __shared__ __attribute__((aligned(16))) unsigned char lds_raw[LDS_BYTES];
    LAS unsigned char* lds = (LAS unsigned char*)lds_raw;
    Frame F;
    F.tid = threadIdx.x; F.lane = F.tid & 63; F.wave = __builtin_amdgcn_readfirstlane(F.tid >> 6); F.bid = blockIdx.x;
    volatile LAS unsigned* MISC = (volatile LAS unsigned*)(lds + MISC_OFF);
    if (F.tid < 64) MISC[F.tid] = 0u;
    __syncthreads();
    xcd_barrier_post((unsigned*)(wsp() + WS_CTL) + CW_BAR);
    volatile LAS unsigned* bst = MISC + 8;
#ifdef PROBE_A
    int n_stamp = 0;
#define STAMP() do { if (F.bid == 0 && F.tid == 0) { __hip_atomic_store((unsigned long long*)(wsp() + WS_CTL + 32768) + n_stamp, (unsigned long long)__builtin_amdgcn_s_memrealtime(), __ATOMIC_RELAXED, __HIP_MEMORY_SCOPE_AGENT); } ++n_stamp; } while (0)
#else
#define STAMP() do {} while (0)
#endif
    STAMP();
    LAS unsigned char* tokbuf = lds + TOKBUF_OFF;

    if (PHASE_MASK & 1) p0_prologue(F, lds);
    xcd_barrier(bst); STAMP();
    if (PHASE_MASK & 2) { pg8::StaticOrder<T, INW> S{F.bid}; EpiInProj E; pg8::gemm_phase<CfgIn>(lds, tokbuf, 0, S, E); }
    xcd_barrier(bst); STAMP();
    if (PHASE_MASK & 4) for (int u = F.bid; u < NBATCH * 32 * 2; u += G) attn_unit(F, lds, u);
    if (PHASE_MASK & 8) for (int c = F.bid; c < T / 128; c += G) gmlp_unit(F, lds, c);
    xcd_barrier(bst); STAMP();
    if (PHASE_MASK & 16) { pg8::StaticOrder<T, D> S{F.bid}; EpiOut E; pg8::gemm_phase<CfgOut>(lds, tokbuf, 0, S, E); }
    xcd_barrier(bst); STAMP();
    if (PHASE_MASK & 32) p4_router(F, lds);
    xcd_barrier(bst); STAMP();
    int ngroups = 1040; if (PHASE_MASK & 64) ngroups = p4b_lists(F, lds);
    xcd_barrier(bst); STAMP();
#pragma unroll 1
    for (int ch = 0; ch < 2; ++ch) {
        const int g0 = ch == 0 ? 0 : CHUNK0_GROUPS;
        int g1 = ch == 0 ? (ngroups < CHUNK0_GROUPS ? ngroups : CHUNK0_GROUPS) : ngroups;
        if (g1 > g0 + HMID_GROUPS) g1 = g0 + HMID_GROUPS;
        if (PHASE_MASK & 128) { pg8::GroupOrder<8> S{g0, g1, F.bid}; EpiGateUp E{g0}; pg8::gemm_phase<CfgGU>(lds, tokbuf, 0, S, E); }
        xcd_barrier(bst); STAMP();
        if (PHASE_MASK & 256) { pg8::GroupOrder<4> S{g0, g1, F.bid}; EpiDown E; pg8::gemm_phase<CfgDown>(lds, tokbuf, g0, S, E); }
        xcd_barrier(bst); STAMP();
    }
    if (PHASE_MASK & 512) p7_final(F);
#ifdef PROBE_A
    STAMP();
    if (F.bid == 0 && F.tid == 0) {
        unsigned long long* ts = (unsigned long long*)(wsp() + WS_CTL + 32768);
        unsigned long long extra = 0ull;
        for (int k = 1; k < 12; ++k) if ((PROBE_A >> k) & 1) extra += __hip_atomic_load(ts + k, __ATOMIC_RELAXED, __HIP_MEMORY_SCOPE_AGENT) - __hip_atomic_load(ts + k - 1, __ATOMIC_RELAXED, __HIP_MEMORY_SCOPE_AGENT);
        const unsigned long long t0 = __builtin_amdgcn_s_memrealtime();
        while (__builtin_amdgcn_s_memrealtime() - t0 < extra) __builtin_amdgcn_s_sleep(8);
    }
#endif
}

extern "C" void kernel_launch(void* const* d_in, const int* in_sizes, int n_in, void* d_out, int out_size, void* d_ws, size_t ws_size, hipStream_t stream) {
    static int grid = 0;
    if (grid == 0) {
        if (n_in != 23 || in_sizes[0] != T * D || out_size != T * D || ws_size < WS_END) {
            fprintf(stderr, "kernel_launch: unexpected shapes/workspace (n_in %d, in0 %d, out %d, ws %zu, need %zu); nothing launched\n", n_in, n_in > 0 ? in_sizes[0] : -1, out_size, ws_size, (size_t)WS_END);
            grid = -1; return;
        }
        int dev = 0, cus = 0, per_cu = 0;
        if (hipGetDevice(&dev) != hipSuccess || hipDeviceGetAttribute(&cus, hipDeviceAttributeMultiprocessorCount, dev) != hipSuccess) { grid = -1; return; }
        if (hipOccupancyMaxActiveBlocksPerMultiprocessor(&per_cu, (const void*)mk_fwd, NTHREADS, 0) != hipSuccess || per_cu < 1) {
            fprintf(stderr, "kernel_launch: occupancy query says %d blocks per CU; nothing launched\n", per_cu); (void)hipGetLastError(); grid = -1; return;
        }
        grid = cus;
        if (grid != G) { fprintf(stderr, "kernel_launch: built for a 256-CU device, found %d; nothing launched\n", cus); grid = -1; return; }
    }
    if (grid < 0) return;
    if (hipMemsetAsync((char*)d_ws + WS_CTL, 0, CTL_ZERO_BYTES, stream) != hipSuccess) return;
    Args a{};
    for (int i = 0; i < 23; ++i) a.in[i] = d_in[i];
    a.out = (float*)d_out; a.ws = (unsigned char*)d_ws;
    hipLaunchKernelGGL(mk_fwd, dim3(grid), dim3(NTHREADS), 0, stream, a);
}
```

```cpp
#include <hip/hip_runtime.h>
#include <cstdio>
#include <cstdint>
#include <type_traits>

#define DI __device__ __forceinline__
#define LAS __attribute__((address_space(3)))
#define GAS __attribute__((address_space(1)))
typedef unsigned short bf16_t;
typedef short bf16x8 __attribute__((ext_vector_type(8)));
typedef short s16x4 __attribute__((ext_vector_type(4)));
typedef float f32x2 __attribute__((ext_vector_type(2)));
typedef float f32x4 __attribute__((ext_vector_type(4)));
typedef float f32x16 __attribute__((ext_vector_type(16)));
typedef unsigned u32x2 __attribute__((ext_vector_type(2)));
typedef unsigned u32x4 __attribute__((ext_vector_type(4)));
typedef __bf16 bf16x2_t __attribute__((ext_vector_type(2)));
typedef GAS unsigned gu32;
typedef int v8i __attribute__((ext_vector_type(8)));

constexpr int D = 1024, SEQ = 4096, NBATCH = 16, T = NBATCH * SEQ;
constexpr int INW = 1792, NE = 32;
constexpr int NSLOT = T * 4 + NE * 256;
constexpr int NGRP_MAX = NSLOT / 256;
constexpr float LN_EPS = 1e-5f;
constexpr float ALPHA = 1.189207115002721f;
constexpr float LOG2E = 1.4426950408889634f;
constexpr float QSCALE = 0.125f * LOG2E;
constexpr float WQ_SCALE = 64.0f;
constexpr int WQ_E8M0 = 127 - 6;
constexpr int NWAVES = 8, NTHREADS = 512;

constexpr size_t MiB = 1u << 20;
constexpr size_t WS_CTL = 0, CTL_ZERO_BYTES = 65536;
constexpr size_t WS_WGCOUNT = 1 * MiB;
constexpr size_t WS_GRPE = 1 * MiB + 65536;
constexpr size_t WS_OUTC = 1 * MiB + 131072;
constexpr size_t WS_WIN = 2 * MiB;
constexpr size_t WS_WOUT = 6 * MiB;
constexpr size_t WS_WSP = 8 * MiB;
constexpr size_t WS_STATS0 = 9 * MiB;
constexpr size_t WS_ROPE = 10 * MiB;
constexpr size_t WS_WGU = 16 * MiB;
constexpr size_t WS_WD = 80 * MiB;
constexpr size_t WS_H1Q = 112 * MiB;
constexpr size_t WS_TOKE = 208 * MiB;
constexpr size_t WS_TOKG = 209 * MiB;
constexpr size_t WS_TOKL = 210 * MiB;
constexpr size_t WS_SLOTTOK = 211 * MiB;
constexpr size_t WS_SLOTGATE = 212 * MiB + 512 * 1024;
constexpr size_t WS_SLOTDEST = 214 * MiB;
constexpr size_t WS_H0B = 216 * MiB;
constexpr size_t WS_QB = 344 * MiB;
constexpr size_t WS_KB = 408 * MiB;
constexpr size_t WS_VB = 424 * MiB;
constexpr size_t WS_GUB = 440 * MiB;
constexpr size_t WS_GVB = 504 * MiB;
constexpr size_t WS_YSLOT = 216 * MiB;
constexpr size_t WS_HMID = 728 * MiB;
constexpr size_t WS_END = 1024 * MiB;
static_assert(WS_HMID + (size_t)NSLOT * 1024 <= WS_END && WS_H1Q + (size_t)T * 1024 <= 208 * MiB, "ws map");
static_assert(WS_YSLOT + (size_t)T * 4 * 1024 * 2 <= WS_HMID, "ws map");
constexpr int CW_BAR = 4096;

constexpr int RING_BYTES = 131072;
constexpr int MISC_OFF = RING_BYTES;
constexpr int TOKBUF_OFF = MISC_OFF + 1024;
constexpr int LDS_BYTES = 147456;

DI unsigned cvtpk(float lo, float hi) { f32x2 v = {lo, hi}; bf16x2_t b = __builtin_convertvector(v, bf16x2_t); return __builtin_bit_cast(unsigned, b); }
DI unsigned cvt4_fp8(float a, float b, float c, float d) { int p = __builtin_amdgcn_cvt_pk_fp8_f32(a, b, 0, false); p = __builtin_amdgcn_cvt_pk_fp8_f32(c, d, p, true); return (unsigned)p; }
DI float bf2f(unsigned short h) { return __uint_as_float((unsigned)h << 16); }
DI float bflo(unsigned w) { return __uint_as_float(w << 16); }
DI float bfhi(unsigned w) { return __uint_as_float(w & 0xffff0000u); }
template <int CTRL> DI float dppf(float v) { return __builtin_bit_cast(float, __builtin_amdgcn_update_dpp(0, __builtin_bit_cast(int, v), CTRL, 0xf, 0xf, false)); }
DI void swap32(float& a, float& b) { asm("s_nop 1\n\tv_permlane32_swap_b32 %0, %1" : "+v"(a), "+v"(b)); }
DI void swap16(float& a, float& b) { asm("s_nop 1\n\tv_permlane16_swap_b32 %0, %1" : "+v"(a), "+v"(b)); }
template <int CTRL> DI int dppi(int v) { return __builtin_amdgcn_update_dpp(0, v, CTRL, 0xf, 0xf, false); }
constexpr int DPP_XOR1 = 0xB1, DPP_XOR2 = 0x4E, DPP_HMIRROR = 0x141, DPP_MIRROR = 0x140;
template <int LV> DI float partnerf(float v, int lane) {
    if constexpr (LV == 0) return dppf<DPP_XOR1>(v);
    else if constexpr (LV == 1) return dppf<DPP_XOR2>(v);
    else if constexpr (LV == 2) return dppf<DPP_HMIRROR>(v);
    else if constexpr (LV == 3) return dppf<DPP_MIRROR>(v);
    else if constexpr (LV == 4) { float a = v, b = v; swap16(a, b); return (lane & 16) ? a : b; }
    else { float a = v, b = v; swap32(a, b); return (lane & 32) ? a : b; }
}
template <int LV> DI int partneri(int v, int lane) { return __builtin_bit_cast(int, partnerf<LV>(__builtin_bit_cast(float, v), lane)); }
DI float wave_sum(float v) {
    v += dppf<DPP_XOR1>(v); v += dppf<DPP_XOR2>(v); v += dppf<DPP_HMIRROR>(v); v += dppf<DPP_MIRROR>(v);
    { float a = v, b = v; swap16(a, b); v = a + b; }
    { float a = v, b = v; swap32(a, b); v = a + b; }
    return v;
}
#define LDS_WAIT() asm volatile("s_waitcnt lgkmcnt(0)" ::: "memory")
#define VM_WAIT() asm volatile("s_waitcnt vmcnt(0)" ::: "memory")

DI f32x2 gelu_pk(f32x2 v) {
    const f32x2 av = __builtin_elementwise_abs(v), d = av * 0.2316418882f + 1.0f;
    f32x2 t; t.x = __builtin_amdgcn_rcpf(d.x); t.y = __builtin_amdgcn_rcpf(d.y);
    f32x2 q = t * 0.5307027145f + (-0.7265760135f); q = q * t + 0.7107068705f; q = q * t + (-0.142248368f); q = q * t + 0.127414796f; q = q * t;
    const f32x2 s = (v * v) * (-0.72134752044f);
    f32x2 e; e.x = __builtin_amdgcn_exp2f(s.x); e.y = __builtin_amdgcn_exp2f(s.y);
    const f32x2 m = v * (q * e), r = v - m;
    f32x2 o; o.x = v.x < 0.f ? m.x : r.x; o.y = v.y < 0.f ? m.y : r.y; return o;
}
DI f32x4 gelu4(f32x4 v) { f32x2 a = gelu_pk((f32x2){v[0], v[1]}), b = gelu_pk((f32x2){v[2], v[3]}); return (f32x4){a.x, a.y, b.x, b.y}; }


struct Frame { int tid, lane, wave, bid; };
DI Frame opaque(const Frame& f) { Frame r; r.tid = threadIdx.x; asm volatile("" : "+v"(r.tid)); r.lane = r.tid & 63; r.wave = __builtin_amdgcn_readfirstlane(r.tid >> 6); r.bid = f.bid; return r; }
constexpr int G = 256;
template <int K> DI const float* inp() { const float* p; asm volatile("s_load_dwordx2 %0, %1, %2\n\ts_waitcnt lgkmcnt(0)" : "=s"(p) : "s"(__builtin_amdgcn_kernarg_segment_ptr()), "i"(K * 8)); return p; }
DI float* outp() { float* p; asm volatile("s_load_dwordx2 %0, %1, %2\n\ts_waitcnt lgkmcnt(0)" : "=s"(p) : "s"(__builtin_amdgcn_kernarg_segment_ptr()), "i"(23 * 8)); return p; }
DI unsigned char* wsp() { unsigned char* p; asm volatile("s_load_dwordx2 %0, %1, %2\n\ts_waitcnt lgkmcnt(0)" : "=s"(p) : "s"(__builtin_amdgcn_kernarg_segment_ptr()), "i"(24 * 8)); return p; }
enum { I_X = 0, I_POS = 1, I_LNING = 2, I_LNINB = 3, I_WIN = 4, I_BIN = 5, I_SINKS = 6, I_GNG = 7, I_GNB = 8, I_WS = 9, I_BS = 10, I_WOUT = 11, I_BOUT = 12, I_LN1G = 13, I_LN1B = 14,
       I_WR = 15, I_BR = 16, I_WGU = 17, I_BGU = 18, I_WD = 19, I_BD = 20, I_LN2G = 21, I_LN2B = 22 };

#define XB_TMO      128
#define XB_XCNT(j)  (256  + 64 * (j))
#define XB_XSUB(j)  (1280 + 64 * (j))
#define XB_XGEN(j)  (2304 + 64 * (j))
#define XB_TOP      3328
#define XB_TOPGEN   3392
#define XCD_BAR_WORDS 3456
#define XB_SPIN_CAP (1u << 18)
DI unsigned xb_ld(unsigned* p)              { return __hip_atomic_load(p, __ATOMIC_RELAXED, __HIP_MEMORY_SCOPE_AGENT); }
DI unsigned xb_add(unsigned* p, unsigned v) { return __hip_atomic_fetch_add(p, v, __ATOMIC_RELAXED, __HIP_MEMORY_SCOPE_AGENT); }
DI unsigned xb_xcc_id() { return (unsigned)__builtin_amdgcn_s_getreg((3 << 11) | 20) & 0xFu; }
#define XB_SPIN(cond, bar) do { unsigned _sp = 0; while (cond) { __builtin_amdgcn_s_sleep(1); \
    if ((++_sp & 255u) == 0u) { if (xb_ld(&(bar)[XB_TMO])) break; if (_sp > XB_SPIN_CAP) { atomicAdd(&(bar)[XB_TMO], 1u); break; } } } } while (0)
DI void xcd_barrier_post(unsigned* bar) { if (threadIdx.x == 0) (void)xb_add(&bar[XB_XCNT(xb_xcc_id())], 1u); }
DI void xcd_barrier_complete(unsigned* bar, unsigned x, unsigned& nloc, unsigned& nx) {
    unsigned sum, cnt, mine, sp = 0u;
    for (;;) {
        sum = 0u; cnt = 0u; mine = 0u;
#pragma unroll
        for (unsigned j = 0; j < 16; ++j) { const unsigned c = xb_ld(&bar[XB_XCNT(j)]); sum += c; cnt += (c > 0u) ? 1u : 0u; mine = (j == x) ? c : mine; }
        if (sum == (unsigned)G) break;
        __builtin_amdgcn_s_sleep(1);
        if ((++sp & 255u) == 0u) { if (xb_ld(&bar[XB_TMO])) break; if (sp > XB_SPIN_CAP) { atomicAdd(&bar[XB_TMO], 1u); break; } }
    }
    nloc = mine > 0u ? mine : 1u; nx = cnt > 0u ? cnt : 1u;
}
DI void xcd_barrier(volatile LAS unsigned* st) {
    asm volatile("s_waitcnt vmcnt(0)" ::: "memory");
    __syncthreads();
    if (threadIdx.x == 0) {
        unsigned* bar = (unsigned*)(wsp() + WS_CTL) + CW_BAR; const unsigned x = xb_xcc_id();
        __builtin_amdgcn_s_waitcnt(0);
        unsigned nloc = st[0], nx = st[1];
        if (nloc == 0u) { xcd_barrier_complete(bar, x, nloc, nx); st[0] = nloc; st[1] = nx; }
        const unsigned old = xb_add(&bar[XB_XSUB(x)], 1u);
        const unsigned gen = old / nloc;
        if (old + 1u == (gen + 1u) * nloc) {
            __builtin_amdgcn_fence(__ATOMIC_RELEASE, "agent");
            asm volatile("s_waitcnt vmcnt(0)" ::: "memory");
            const unsigned og = xb_add(&bar[XB_TOP], 1u);
            const unsigned tg = og / nx;
            if (og + 1u == (tg + 1u) * nx) xb_add(&bar[XB_TOPGEN], 1u);
            else XB_SPIN(xb_ld(&bar[XB_TOPGEN]) == tg, bar);
            __builtin_amdgcn_fence(__ATOMIC_ACQUIRE, "agent");
            xb_add(&bar[XB_XGEN(x)], 1u);
            asm volatile("s_waitcnt vmcnt(0)" ::: "memory");
        } else {
            XB_SPIN(xb_ld(&bar[XB_XGEN(x)]) == gen, bar);
            __builtin_amdgcn_fence(__ATOMIC_ACQUIRE, "agent");
            asm volatile("s_waitcnt vmcnt(0)" ::: "memory");
        }
    }
    __syncthreads();
}

namespace pg8 {
constexpr int BM = 256, HALF = 128, HTB = HALF * 128, NXCD = 8, WGM = 8, GK = 1024;
constexpr size_t KSTEP = 128;
DI int lds_byte(int r, int c) { const int st = (r >> 4) * 2 + (c >> 5), rr = r & 15, cc = c & 31, ob = rr * 64 + cc * 2; return st * 1024 + (ob ^ (((ob >> 9) & 1) << 5)); }
DI void stage_rc(int b, int& R, int& C) { const int st = b / 1024, sb = b % 1024, swz = sb ^ (((sb >> 9) & 1) << 5); R = (st >> 1) * 16 + swz / 64; C = (st & 1) * 32 + (swz % 64) / 2; }
DI int perm32(int rho) { const int n = rho >> 4, i = rho & 15; return 8 * (i >> 2) + 4 * n + (i & 3); }

struct Unit { int pm, pn, e; };

template <int M, int N> struct StaticOrder {
    int c;
    DI bool next(int i, Unit& u) const {
        constexpr int nM = M / BM, nN = N / BM, nwg = nM * nN;
        const int L = i * G + c; if (L >= nwg) return false;
        int wgid = L; { constexpr int q = nwg / NXCD, r = nwg % NXCD; const int xcd = wgid % NXCD, off = wgid / NXCD; wgid = (xcd < r ? xcd * (q + 1) : r * (q + 1) + (xcd - r) * q) + off; }
        constexpr int nig = WGM * nN; const int gid = wgid / nig, fm = gid * WGM, gsz = (nM - fm) < WGM ? (nM - fm) : WGM;
        u.pm = fm + ((wgid % nig) % gsz); u.pn = (wgid % nig) / gsz; u.e = 0; return true;
    }
};
template <int NPN> struct GroupOrder {
    int g0, g1, c;
    DI bool next(int i, Unit& u) const {
        constexpr int GPX = 32 / NPN;
        const int x = c & 7, j = c >> 3;
        const int g = g0 + i * (8 * GPX) + x * GPX + j / NPN;
        if (g >= g1) return false;
        u.pm = g; u.pn = j % NPN;
        u.e = __builtin_amdgcn_readfirstlane((int)__hip_atomic_load((unsigned*)(wsp() + WS_GRPE) + g, __ATOMIC_RELAXED, __HIP_MEMORY_SCOPE_AGENT));
        return true;
    }
};
DI void piece_rc(int i, int& R, int& C) { int t = threadIdx.x; asm volatile("" : "+v"(t)); stage_rc(t * 16 + i * 8192, R, C); }
DI unsigned tok_off(const LAS int* tb, int h, int i, unsigned pitch) { int R, C; piece_rc(i, R, C); int tok = tb[h * HALF + R]; tok = tok < 0 ? 0 : tok; return (unsigned)tok * pitch + (unsigned)C * 2u; }

struct FragBF { bf16x8 k0, k1; };
struct FragF8 { v8i v; };
DI void ldfrag(FragBF& f, const LAS unsigned char* p) { f.k0 = *(const LAS bf16x8*)p; f.k1 = *(const LAS bf16x8*)(p + 1024); }
typedef int v8i_a16 __attribute__((ext_vector_type(8), aligned(16)));
DI void ldfrag(FragF8& f, const LAS unsigned char* p) { f.v = *(const LAS v8i_a16*)p; }
DI void mma(f32x4& acc, const FragBF& w, const FragBF& a) { acc = __builtin_amdgcn_mfma_f32_16x16x32_bf16(w.k0, a.k0, acc, 0, 0, 0); acc = __builtin_amdgcn_mfma_f32_16x16x32_bf16(w.k1, a.k1, acc, 0, 0, 0); }
DI void mma(f32x4& acc, const FragF8& w, const FragF8& a) { acc = __builtin_amdgcn_mfma_scale_f32_16x16x128_f8f6f4(w.v, a.v, acc, 0, 0, 0, WQ_E8M0, 0, 127); }
template <class Cfg, class Epi, class Sched>
DI void gemm_phase(LAS unsigned char* lds, LAS unsigned char* tokbuf, const int pm_bias, const Sched& S, const Epi& E) {
    constexpr bool GATHER = Cfg::GATHER, FP8 = Cfg::FP8;
    constexpr int ROWB = FP8 ? GK : 2 * GK, NT = ROWB / 128;
    constexpr size_t HSTEP = (size_t)HALF * ROWB, TSTEP = 2 * HSTEP;
    using Frag = typename std::conditional<FP8, FragF8, FragBF>::type;
    int tid = threadIdx.x; asm volatile("" : "+v"(tid));
    const int wid = __builtin_amdgcn_readfirstlane(tid >> 6), lane = tid & 63, wr = wid >> 2, wc = wid & 3, fr = lane & 15, fq = lane >> 4;
    unsigned voffB[2], vaC[2][2];
#pragma unroll
    for (int i = 0; i < 2; ++i) { int R, C; stage_rc(tid * 16 + i * 8192, R, C); const int Rb = Epi::PERM ? ((R & ~31) + perm32(R & 31)) : R;
        voffB[i] = (unsigned)(Rb * ROWB + C * 2); vaC[0][i] = (unsigned)(R * ROWB + C * 2); vaC[1][i] = vaC[0][i]; }
    constexpr size_t AHSTEP = GATHER ? (size_t)0 : HSTEP;
    const unsigned ldsw = (unsigned)wid * 1024u;
    const int cfr = FP8 ? (fq >> 1) * 32 + (fq & 1) * 16 : fq * 8;
    const int aoff = lds_byte(wr * 64 + fr, cfr);
    int boff = lds_byte(wc * 32 + fr, cfr) + 4 * HTB; asm volatile("" : "+v"(boff));
#define PG8_SA(b, h) (((b) * 2 + (h)) * HTB)
#define PG8_SB(b, h) ((4 + (b) * 2 + (h)) * HTB)
    const __amdgpu_buffer_rsrc_t rs = __builtin_amdgcn_make_buffer_rsrc((void*)wsp(), 0, 0x40000000, 0x00020000);
#define PG8_STAGEB(bufoff, soff) do { _Pragma("unroll") for (int _i = 0; _i < 2; ++_i) \
        __builtin_amdgcn_raw_ptr_buffer_load_lds(rs, (LAS void*)(lds + (bufoff) + ldsw + _i * 8192), 16, voffB[_i], (int)(soff), 0, 0); } while (0)
#define PG8_STAGEA(bufoff, soff, o0, o1) do { \
        __builtin_amdgcn_raw_ptr_buffer_load_lds(rs, (LAS void*)(lds + (bufoff) + ldsw), 16, (o0), (int)(soff), 0, 0); \
        __builtin_amdgcn_raw_ptr_buffer_load_lds(rs, (LAS void*)(lds + (bufoff) + ldsw + 8192), 16, (o1), (int)(soff), 0, 0); } while (0)
#define PG8_LDA(dst, b, h) do { _Pragma("unroll") for (int m = 0; m < 4; ++m) ldfrag(dst[m], lds + PG8_SA(b, h) + aoff + m * 2048); } while (0)
#define PG8_LDB(dst, b, h) do { _Pragma("unroll") for (int n = 0; n < 2; ++n) ldfrag(dst[n], lds + ((b) * 2 + (h)) * HTB + boff + n * 2048); } while (0)
#define PG8_MMA(ai, bj, At, Bt) do { __builtin_amdgcn_s_setprio(1); _Pragma("unroll") for (int m = 0; m < 4; ++m) _Pragma("unroll") for (int n = 0; n < 2; ++n) \
        mma(acc[ai][bj][m][n], Bt[n], At[m]); __builtin_amdgcn_s_setprio(0); } while (0)
#define PG8_WAIT_V(n) asm volatile("s_waitcnt vmcnt(" #n ")" ::: "memory")
#define PG8_WAIT_L(n) asm volatile("s_waitcnt lgkmcnt(" #n ")" ::: "memory")
#define PG8_BAR __builtin_amdgcn_s_barrier()
#define PG8_SCHED __builtin_amdgcn_sched_barrier(0)
#define PG8_ABASE(u) (GATHER ? (unsigned)Cfg::A_OFF : (unsigned)(Cfg::A_OFF + (size_t)((u).pm - pm_bias) * TSTEP))
#define PG8_BBASE(u) ((unsigned)(Cfg::B_OFF + (size_t)(u).e * Cfg::B_E_BYTES + (size_t)(u).pn * TSTEP))
#define PG8_TOKDMA(u, dst) __builtin_amdgcn_raw_ptr_buffer_load_lds(rs, (LAS void*)(dst), 16, (unsigned)lane * 16u, (int)(WS_SLOTTOK + (size_t)(u).pm * 1024), 0, 0)
    Unit cur, nxt; int ui = 0;
    if (!S.next(0, cur)) return;
    if constexpr (GATHER) {
        if (wid == 0) PG8_TOKDMA(cur, tokbuf);
        PG8_WAIT_V(0); PG8_BAR;
#pragma unroll
        for (int h = 0; h < 2; ++h)
#pragma unroll
            for (int i = 0; i < 2; ++i) vaC[h][i] = tok_off((const LAS int*)tokbuf, h, i, Cfg::A_PITCH);
        PG8_WAIT_L(0); PG8_BAR;
    }
    f32x4 acc[2][2][4][2];
#pragma unroll
    for (int a = 0; a < 2; ++a)
#pragma unroll
        for (int b = 0; b < 2; ++b)
#pragma unroll
            for (int m = 0; m < 4; ++m)
#pragma unroll
                for (int n = 0; n < 2; ++n) acc[a][b][m][n] = (f32x4){0.f, 0.f, 0.f, 0.f};
    Frag At[4], B0[2], B1[2];
    unsigned cA = PG8_ABASE(cur);
    unsigned cB = PG8_BBASE(cur);
    PG8_STAGEB(PG8_SB(0, 0), cB); PG8_STAGEB(PG8_SB(0, 1), cB + (unsigned)HSTEP); PG8_STAGEA(PG8_SA(0, 0), cA, vaC[0][0], vaC[0][1]); PG8_STAGEA(PG8_SA(0, 1), cA + (unsigned)AHSTEP, vaC[1][0], vaC[1][1]);
    if (wr == 1) PG8_BAR;
    PG8_WAIT_V(2); PG8_BAR;
    PG8_STAGEB(PG8_SB(1, 0), cB + (unsigned)KSTEP); PG8_STAGEA(PG8_SA(1, 0), cA + (unsigned)KSTEP, vaC[0][0], vaC[0][1]); PG8_STAGEB(PG8_SB(1, 1), cB + (unsigned)(HSTEP + KSTEP));
    PG8_WAIT_V(6); PG8_BAR;
    for (;;) {
        const bool has_next = S.next(ui + 1, nxt);
        const LAS int* tbn = (const LAS int*)(tokbuf + ((ui + 1) & 1) * 1024);
        if constexpr (GATHER) {
            if (has_next && wid == 0) PG8_TOKDMA(nxt, tokbuf + ((ui + 1) & 1) * 1024);
        }
#pragma unroll 1
        for (int t = 0; t < NT; t += 2) {
            const bool last = (t == NT - 2);
            const unsigned a1 = cA + (unsigned)(t + 1) * (unsigned)KSTEP;
            unsigned a2 = cA + (unsigned)(t + 2) * (unsigned)KSTEP, b2 = cB + (unsigned)(t + 2) * (unsigned)KSTEP;
            if (last) {
                if (has_next) { a2 = PG8_ABASE(nxt); b2 = PG8_BBASE(nxt);
                    if constexpr (GATHER) { vaC[0][0] = tok_off(tbn, 0, 0, Cfg::A_PITCH); vaC[0][1] = tok_off(tbn, 0, 1, Cfg::A_PITCH); } }
                else { a2 = cA; b2 = cB; }
            }
            const unsigned a3 = a2 + (unsigned)KSTEP, b3 = b2 + (unsigned)KSTEP;
            PG8_LDB(B0, 0, 0); PG8_LDB(B1, 0, 1); PG8_SCHED; PG8_LDA(At, 0, 0); PG8_STAGEA(PG8_SA(1, 1), a1 + (unsigned)AHSTEP, vaC[1][0], vaC[1][1]);
            if constexpr (GATHER) { if (last && has_next) { vaC[1][0] = tok_off(tbn, 1, 0, Cfg::A_PITCH); vaC[1][1] = tok_off(tbn, 1, 1, Cfg::A_PITCH); } }
            PG8_WAIT_V(8); PG8_WAIT_L(0); PG8_BAR; PG8_MMA(0, 0, At, B0); PG8_MMA(0, 1, At, B1); PG8_BAR; PG8_SCHED;
            PG8_LDA(At, 0, 1); PG8_STAGEB(PG8_SB(0, 0), b2); PG8_STAGEB(PG8_SB(0, 1), b2 + (unsigned)HSTEP); PG8_STAGEA(PG8_SA(0, 0), a2, vaC[0][0], vaC[0][1]);
            PG8_WAIT_V(8); PG8_WAIT_L(0); PG8_BAR; PG8_MMA(1, 0, At, B0); PG8_MMA(1, 1, At, B1); PG8_BAR; PG8_SCHED;
            PG8_LDB(B0, 1, 0); PG8_LDB(B1, 1, 1); PG8_SCHED; PG8_LDA(At, 1, 0); PG8_STAGEA(PG8_SA(0, 1), a2 + (unsigned)AHSTEP, vaC[1][0], vaC[1][1]);
            PG8_WAIT_V(8); PG8_WAIT_L(0); PG8_BAR; PG8_MMA(0, 0, At, B0); PG8_MMA(0, 1, At, B1); PG8_BAR; PG8_SCHED;
            PG8_LDA(At, 1, 1); PG8_STAGEB(PG8_SB(1, 0), b3); PG8_STAGEB(PG8_SB(1, 1), b3 + (unsigned)HSTEP); PG8_STAGEA(PG8_SA(1, 0), a3, vaC[0][0], vaC[0][1]);
            PG8_WAIT_V(8); PG8_WAIT_L(0); PG8_BAR; PG8_MMA(1, 0, At, B0); PG8_MMA(1, 1, At, B1); PG8_BAR; PG8_SCHED;
        }
        if (wr == 0) PG8_BAR;
        E(acc, cur, wr, wc, fr, fq);
        if (!has_next) break;
#pragma unroll
        for (int a = 0; a < 2; ++a)
#pragma unroll
            for (int b = 0; b < 2; ++b)
#pragma unroll
                for (int m = 0; m < 4; ++m)
#pragma unroll
                    for (int n = 0; n < 2; ++n) acc[a][b][m][n] = (f32x4){0.f, 0.f, 0.f, 0.f};
        cur = nxt; cA = PG8_ABASE(cur); cB = PG8_BBASE(cur); ++ui;
        if (wr == 1) PG8_BAR;
    }
    PG8_WAIT_V(0);
    PG8_BAR;
#undef PG8_SA
#undef PG8_SB
#undef PG8_STAGEA
#undef PG8_STAGEB
#undef PG8_LDA
#undef PG8_LDB
#undef PG8_MMA
#undef PG8_WAIT_V
#undef PG8_WAIT_L
#undef PG8_BAR
#undef PG8_SCHED
#undef PG8_ABASE
#undef PG8_BBASE
#undef PG8_TOKDMA
}
}

struct EpiInProj {
    static constexpr bool PERM = true;
    DI void operator()(f32x4 (&acc)[2][2][4][2], const pg8::Unit& u, int wr, int wc, int fr, int fq) const {
        const int pn = u.pn;
        int kind, head, ldc; size_t boff;
        if (pn < 2) { kind = 0; head = 4 * pn + wc; boff = WS_QB; ldc = 512; }
        else if (pn == 2) { if (wc < 2) { kind = 1; head = wc; boff = WS_KB; } else { kind = 2; head = wc - 2; boff = WS_VB; } ldc = 128; }
        else if (pn < 5) { kind = 3; head = 4 * (pn - 3) + wc; boff = WS_GUB; ldc = 512; }
        else { kind = 4; head = 4 * (pn - 5) + wc; boff = WS_GVB; ldc = 512; }
        unsigned char* ws = wsp();
        bf16_t* base = (bf16_t*)(ws + boff);
        const float* b_in = inp<I_BIN>();
        const int src0 = 256 * pn + 64 * wc + 8 * fq;
#pragma unroll
        for (int bj = 0; bj < 2; ++bj)
#pragma unroll
            for (int n = 0; n < 2; ++n) { const f32x4 bv = *(const f32x4*)(b_in + src0 + 32 * bj + 4 * n);
#pragma unroll
                for (int ai = 0; ai < 2; ++ai)
#pragma unroll
                    for (int m = 0; m < 4; ++m) acc[ai][bj][m][n] += bv; }
        const float* rope = (const float*)(ws + WS_ROPE);
        const float* gn_g = inp<I_GNG>(); const float* gn_b = inp<I_GNB>();
        const int row0 = u.pm * 256 + wr * 64 + fr;
#pragma unroll
        for (int ai = 0; ai < 2; ++ai)
#pragma unroll
            for (int m = 0; m < 4; ++m) {
                const int row = row0 + ai * 128 + m * 16;
                f32x4 v[2][2];
#pragma unroll
                for (int bj = 0; bj < 2; ++bj)
#pragma unroll
                    for (int n = 0; n < 2; ++n) v[bj][n] = acc[ai][bj][m][n];
                if (kind <= 1) {
                    const float* cs = rope + (size_t)row * 16;
#pragma unroll
                    for (int n = 0; n < 2; ++n) {
                        const f32x4 c4 = *(const f32x4*)(cs + 4 * n), s4 = *(const f32x4*)(cs + 8 + 4 * n);
                        f32x4 p4; p4[0] = __shfl_xor(v[0][n][0], 16); p4[1] = __shfl_xor(v[0][n][1], 16); p4[2] = __shfl_xor(v[0][n][2], 16); p4[3] = __shfl_xor(v[0][n][3], 16);
                        const f32x4 sg = (fq & 1) ? s4 : -s4;
                        const f32x4 rot = v[0][n] * c4 + p4 * sg;
                        if (fq < 2) v[0][n] = rot;
                    }
                    if (kind == 0) {
#pragma unroll
                        for (int bj = 0; bj < 2; ++bj)
#pragma unroll
                            for (int n = 0; n < 2; ++n) v[bj][n] = v[bj][n] * QSCALE;
                    }
                } else if (kind >= 3) {
#pragma unroll
                    for (int bj = 0; bj < 2; ++bj)
#pragma unroll
                        for (int n = 0; n < 2; ++n) v[bj][n] = gelu4(v[bj][n]);
                    if (kind == 4) {
                        float s = 0.f;
#pragma unroll
                        for (int bj = 0; bj < 2; ++bj)
#pragma unroll
                            for (int n = 0; n < 2; ++n) s += (v[bj][n][0] + v[bj][n][1]) + (v[bj][n][2] + v[bj][n][3]);
                        s += __shfl_xor(s, 16); s += __shfl_xor(s, 32);
                        const float mean = s * (1.0f / 64.0f); float q = 0.f;
#pragma unroll
                        for (int bj = 0; bj < 2; ++bj)
#pragma unroll
                            for (int n = 0; n < 2; ++n) { v[bj][n] = v[bj][n] - mean; const f32x4 d = v[bj][n]; q += (d[0] * d[0] + d[1] * d[1]) + (d[2] * d[2] + d[3] * d[3]); }
                        q += __shfl_xor(q, 16); q += __shfl_xor(q, 32);
                        const float rstd = 1.0f / sqrtf(q * (1.0f / 64.0f) + LN_EPS);
#pragma unroll
                        for (int bj = 0; bj < 2; ++bj)
#pragma unroll
                            for (int n = 0; n < 2; ++n) v[bj][n] = v[bj][n] * rstd * *(const f32x4*)(gn_g + 32 * bj + 8 * fq + 4 * n) + *(const f32x4*)(gn_b + 32 * bj + 8 * fq + 4 * n);
                    }
                }
                bf16_t* rowp = base + (size_t)row * ldc + head * 64 + 8 * fq;
#pragma unroll
                for (int bj = 0; bj < 2; ++bj) { u32x4 w; w.x = cvtpk(v[bj][0][0], v[bj][0][1]); w.y = cvtpk(v[bj][0][2], v[bj][0][3]); w.z = cvtpk(v[bj][1][0], v[bj][1][1]); w.w = cvtpk(v[bj][1][2], v[bj][1][3]);
                    *(u32x4*)(rowp + 32 * bj) = w; }
            }
    }
};
struct EpiOut {
    static constexpr bool PERM = false;
    DI void operator()(f32x4 (&acc)[2][2][4][2], const pg8::Unit& u, int wr, int wc, int fr, int fq) const {
        const int col0 = u.pn * 256 + wc * 32 + 4 * fq;
        unsigned char* ws = wsp(); float* y1 = outp();
        const float* outc = (const float*)(ws + WS_OUTC); const float* stats0 = (const float*)(ws + WS_STATS0);
        const float* x = inp<I_X>();
        f32x4 ca[2][2];
#pragma unroll
        for (int bj = 0; bj < 2; ++bj)
#pragma unroll
            for (int n = 0; n < 2; ++n) { ca[bj][n] = *(const f32x4*)(outc + col0 + bj * 128 + n * 16); const f32x4 cb = *(const f32x4*)(outc + 1024 + col0 + bj * 128 + n * 16);
#pragma unroll
                for (int ai = 0; ai < 2; ++ai)
#pragma unroll
                    for (int m = 0; m < 4; ++m) acc[ai][bj][m][n] += cb; }
        const int row0 = u.pm * 256 + wr * 64 + fr;
#pragma unroll
        for (int ai = 0; ai < 2; ++ai)
#pragma unroll
            for (int m = 0; m < 4; ++m) {
                const int row = row0 + ai * 128 + m * 16;
                const f32x2 st = *(const f32x2*)(stats0 + (size_t)row * 2);
                const size_t off = (size_t)row * D + col0;
#pragma unroll
                for (int bj = 0; bj < 2; ++bj)
#pragma unroll
                    for (int n = 0; n < 2; ++n) { const f32x4 xv = *(const f32x4*)(x + off + bj * 128 + n * 16);
                        const f32x4 o = acc[ai][bj][m][n] + (xv - st.x) * st.y * ca[bj][n];
                        *(f32x4*)(y1 + off + bj * 128 + n * 16) = o; }
                if (m & 1) asm volatile("" ::: "memory");
            }
    }
};
struct EpiGateUp {
    static constexpr bool PERM = true;
    DI void operator()(f32x4 (&acc)[2][2][4][2], const pg8::Unit& u, int wr, int wc, int fr, int fq) const {
        const int hcol0 = 128 * u.pn + 32 * wc + 8 * fq;
        const float* bias = inp<I_BGU>() + (size_t)u.e * 2048;
        unsigned char* hmid = wsp() + WS_HMID;
        f32x4 bg[2], bu[2];
#pragma unroll
        for (int n = 0; n < 2; ++n) { bg[n] = *(const f32x4*)(bias + hcol0 + 4 * n); bu[n] = *(const f32x4*)(bias + 1024 + hcol0 + 4 * n); }
        const size_t row0 = (size_t)u.pm * 256 + wr * 64 + fr;
#pragma unroll
        for (int ai = 0; ai < 2; ++ai)
#pragma unroll
            for (int m = 0; m < 4; ++m) {
                float h[2][4];
#pragma unroll
                for (int n = 0; n < 2; ++n) {
                    const f32x4 gt = acc[ai][0][m][n] + bg[n], up = acc[ai][1][m][n] + bu[n];
#pragma unroll
                    for (int j = 0; j < 4; ++j) {
                        const float gc = fminf(gt[j], 7.0f), uc = fminf(fmaxf(up[j], -7.0f), 7.0f);
                        const float sg = __builtin_amdgcn_rcpf(1.0f + __builtin_amdgcn_exp2f(gc * (-1.702f * LOG2E)));
                        h[n][j] = (uc + 1.0f) * (gc * sg);
                    }
                }
                u32x2 w; w.x = cvt4_fp8(h[0][0], h[0][1], h[0][2], h[0][3]); w.y = cvt4_fp8(h[1][0], h[1][1], h[1][2], h[1][3]);
                *(u32x2*)(hmid + (row0 + ai * 128 + m * 16) * 1024 + hcol0) = w;
            }
    }
};
struct EpiDown {
    static constexpr bool PERM = true;
    DI void operator()(f32x4 (&acc)[2][2][4][2], const pg8::Unit& u, int wr, int wc, int fr, int fq) const {
        const int col0 = 256 * u.pn + 32 * wc + 8 * fq;
        const float* bias = inp<I_BD>() + (size_t)u.e * 1024;
        unsigned char* ws = wsp();
        bf16_t* yslot = (bf16_t*)(ws + WS_YSLOT); const int* slot_dest = (const int*)(ws + WS_SLOTDEST); const float* slot_gate = (const float*)(ws + WS_SLOTGATE);
        f32x4 bd[2][2];
#pragma unroll
        for (int bj = 0; bj < 2; ++bj)
#pragma unroll
            for (int n = 0; n < 2; ++n) bd[bj][n] = *(const f32x4*)(bias + col0 + 128 * bj + 4 * n);
        const int slot0 = u.pm * 256 + wr * 64 + fr;
#pragma unroll
        for (int ai = 0; ai < 2; ++ai)
#pragma unroll
            for (int m = 0; m < 4; ++m) {
                const int slot = slot0 + ai * 128 + m * 16;
                const int dest = slot_dest[slot];
                const float gt = slot_gate[slot];
                if (dest >= 0) {
                    bf16_t* rowp = yslot + (size_t)dest * 1024 + col0;
#pragma unroll
                    for (int bj = 0; bj < 2; ++bj) { const f32x4 v0 = (acc[ai][bj][m][0] + bd[bj][0]) * gt, v1 = (acc[ai][bj][m][1] + bd[bj][1]) * gt;
                        u32x4 w; w.x = cvtpk(v0[0], v0[1]); w.y = cvtpk(v0[2], v0[3]); w.z = cvtpk(v1[0], v1[1]); w.w = cvtpk(v1[2], v1[3]);
                        *(u32x4*)(rowp + 128 * bj) = w; }
                }
            }
    }
};

DI int rowmap(int kind, int n) {
    if (kind == 0) { const int pn = n >> 8, ch = n & 255, wc = ch >> 6, bj = (ch >> 5) & 1, w = ch & 31; return (pn << 8) + (bj << 7) + (wc << 5) + w; }
    if (kind == 2) { return n < 1024 ? ((n >> 7) << 8) + (n & 127) : (((n - 1024) >> 7) << 8) + 128 + ((n - 1024) & 127); }
    return n;
}
DI void p0_transpose_item(const float* W, int N, bf16_t* WT, int kind, LAS unsigned char* scr, int item, int lane) {
    const int nblk = N / 64, kb = item / nblk, nb = item % nblk, k0 = 64 * kb, n0 = 64 * nb;
    const int nq = lane >> 2, kr = lane & 3;
    f32x4 a[8], b[8];
#pragma unroll
    for (int i = 0; i < 8; ++i) { const float* p = W + (size_t)(k0 + 8 * i + 2 * kr) * N + n0 + 4 * nq; a[i] = *(const GAS f32x4*)p; b[i] = *(const GAS f32x4*)(p + N); }
#pragma unroll
    for (int i = 0; i < 8; ++i)
#pragma unroll
        for (int c = 0; c < 4; ++c) *(LAS unsigned*)(scr + (4 * nq + c) * 132 + (8 * i + 2 * kr) * 2) = cvtpk(a[i][c], b[i][c]);
    LDS_WAIT(); asm volatile("" ::: "memory");
    const int c8 = lane & 7;
#pragma unroll
    for (int j = 0; j < 8; ++j) { const int n = (lane >> 3) + 8 * j; const LAS unsigned* s = (const LAS unsigned*)(scr + n * 132 + 16 * c8);
        u32x4 o; o.x = s[0]; o.y = s[1]; o.z = s[2]; o.w = s[3];
        *(GAS u32x4*)(WT + (size_t)rowmap(kind, n0 + n) * 1024 + k0 + 8 * c8) = o; }
    LDS_WAIT(); asm volatile("" ::: "memory");
}
DI void p0_transpose_item_q(const float* W, int N, unsigned char* WT, int kind, LAS unsigned char* scr, int item, int lane) {
    const int nblk = N / 32, kb = item / nblk, nb = item % nblk, k0 = 128 * kb, n0 = 32 * nb;
    const int nq = lane >> 3, kr = lane & 7;
#pragma unroll
    for (int i = 0; i < 4; ++i) {
        const float* p = W + (size_t)(k0 + 32 * i + 4 * kr) * N + n0 + 4 * nq;
        const f32x4 a0 = *(const GAS f32x4*)p, a1 = *(const GAS f32x4*)(p + N), a2 = *(const GAS f32x4*)(p + 2 * (size_t)N), a3 = *(const GAS f32x4*)(p + 3 * (size_t)N);
#pragma unroll
        for (int c = 0; c < 4; ++c) *(LAS unsigned*)(scr + (4 * nq + c) * 136 + 32 * i + 4 * kr) = cvt4_fp8(a0[c] * WQ_SCALE, a1[c] * WQ_SCALE, a2[c] * WQ_SCALE, a3[c] * WQ_SCALE);
    }
    LDS_WAIT(); asm volatile("" ::: "memory");
    const int c8 = lane & 7;
#pragma unroll
    for (int j = 0; j < 4; ++j) { const int n = (lane >> 3) + 8 * j; const LAS u32x2* s = (const LAS u32x2*)(scr + n * 136 + 16 * c8);
        const u32x2 x = s[0], y = s[1]; u32x4 o; o.x = x.x; o.y = x.y; o.z = y.x; o.w = y.y;
        *(GAS u32x4*)(WT + (size_t)rowmap(kind, n0 + n) * 1024 + k0 + 16 * c8) = o; }
    LDS_WAIT(); asm volatile("" ::: "memory");
}
DI void p0_prologue(const Frame& F0, LAS unsigned char* lds) {
    const Frame F = opaque(F0);
    unsigned char* ws = wsp();
    LAS unsigned char* scr = lds + F.wave * 16384;
    const int gw = F.bid * NWAVES + F.wave, NGW = G * NWAVES;
    const int gt = F.bid * NTHREADS + F.tid, NGT = G * NTHREADS;
    constexpr int I_IN = (D / 64) * (INW / 64), I_OUT = (D / 64) * (D / 64), I_GU = (D / 128) * (2048 / 32), I_D = (D / 128) * (D / 32);
    constexpr int NITEMS = I_IN + I_OUT + NE * (I_GU + I_D);
    for (int it = gw; it < NITEMS; it += NGW) {
        int r = it;
        if (r < I_IN) { p0_transpose_item(inp<I_WIN>(), INW, (bf16_t*)(ws + WS_WIN), 0, scr, r, F.lane); continue; } r -= I_IN;
        if (r < I_OUT) { p0_transpose_item(inp<I_WOUT>(), D, (bf16_t*)(ws + WS_WOUT), 1, scr, r, F.lane); continue; } r -= I_OUT;
        if (r < NE * I_GU) { const int e = r / I_GU; p0_transpose_item_q(inp<I_WGU>() + (size_t)e * D * 2048, 2048, ws + WS_WGU + (size_t)e * 2048 * D, 2, scr, r % I_GU, F.lane); continue; } r -= NE * I_GU;
        { const int e = r / I_D; p0_transpose_item_q(inp<I_WD>() + (size_t)e * D * D, D, ws + WS_WD + (size_t)e * D * D, 1, scr, r % I_D, F.lane); }
    }
    bf16_t* h0b = (bf16_t*)(ws + WS_H0B); float* stats0 = (float*)(ws + WS_STATS0);
    const float* xin = inp<I_X>(); const float* lg = inp<I_LNING>(); const float* lb = inp<I_LNINB>();
    {
        f32x4 pf0[4], pf1[4];
#pragma unroll
        for (int j = 0; j < 4; ++j) { pf0[j] = ((const GAS f32x4*)(xin + (size_t)gw * D))[F.lane + 64 * j]; pf1[j] = ((const GAS f32x4*)(xin + (size_t)(gw + NGW) * D))[F.lane + 64 * j]; }
        f32x4 gg[4], bb[4];
#pragma unroll
        for (int j = 0; j < 4; ++j) { gg[j] = ((const f32x4*)lg)[F.lane + 64 * j]; bb[j] = ((const f32x4*)lb)[F.lane + 64 * j]; }
#pragma unroll 1
        for (int m = gw; m < T; m += NGW) {
            f32x4 v[4]; float s = 0.f;
#pragma unroll
            for (int j = 0; j < 4; ++j) { v[j] = pf0[j]; pf0[j] = pf1[j]; s += (v[j].x + v[j].y) + (v[j].z + v[j].w); }
            { const int mn = (m + 2 * NGW < T) ? m + 2 * NGW : m;
#pragma unroll
              for (int j = 0; j < 4; ++j) pf1[j] = ((const GAS f32x4*)(xin + (size_t)mn * D))[F.lane + 64 * j]; }
            const float mean = wave_sum(s) * (1.f / D); float s2 = 0.f;
#pragma unroll
            for (int j = 0; j < 4; ++j) { v[j] = v[j] - mean; s2 += (v[j].x * v[j].x + v[j].y * v[j].y) + (v[j].z * v[j].z + v[j].w * v[j].w); }
            const float rstd = 1.f / sqrtf(wave_sum(s2) * (1.f / D) + LN_EPS);
            GAS u32x2* o8 = (GAS u32x2*)(h0b + (size_t)m * D) + F.lane;
#pragma unroll
            for (int j = 0; j < 4; ++j) { const f32x4 r = v[j] * rstd * gg[j] + bb[j]; u32x2 w; w.x = cvtpk(r.x, r.y); w.y = cvtpk(r.z, r.w); o8[64 * j] = w; }
            if (F.lane == 0) { stats0[2 * m] = mean; stats0[2 * m + 1] = rstd; }
        }
    }
    float* rope = (float*)(ws + WS_ROPE); const int* positions = (const int*)inp<I_POS>();
    for (int i = gt; i < T * 8; i += NGT) {
        const int tok = i >> 3, j = i & 7;
        const float inv = powf(500000.0f, -(float)(2 * j) / 16.0f);
        const float ang = (float)positions[tok] * inv;
        rope[tok * 16 + j] = cosf(ang); rope[tok * 16 + 8 + j] = sinf(ang);
    }
    int* slot_tok = (int*)(ws + WS_SLOTTOK); int* slot_dest = (int*)(ws + WS_SLOTDEST);
    for (int i = gt; i < NSLOT; i += NGT) { slot_tok[i] = -1; slot_dest[i] = -1; }
    float* outc = (float*)(ws + WS_OUTC); const float* bo = inp<I_BOUT>();
    for (int i = gt; i < D; i += NGT) { outc[i] = ALPHA * lg[i]; outc[1024 + i] = bo[i] + ALPHA * lb[i]; }
    bf16_t* wsp = (bf16_t*)(ws + WS_WSP); const float* w_s = inp<I_WS>();
    for (int i = gt; i < 8 * 128 * 128; i += NGT) {
        const int j = i & 7, hi = (i >> 3) & 1, ks = (i >> 4) & 7, t = (i >> 7) & 127, h = i >> 14;
        const int s = 16 * ks + 8 * (j >> 2) + 4 * hi + (j & 3);
        const float w = (s <= t) ? w_s[((size_t)h * 128 + t) * 128 + s] : 0.f;
        wsp[i] = (bf16_t)(cvtpk(w, 0.f) & 0xffffu);
    }
}

#define MFMA32(a, b, c) __builtin_amdgcn_mfma_f32_32x32x16_bf16((a), (b), (c), 0, 0, 0)
DI int crow(int r, int hi) { return (r & 3) + 8 * (r >> 2) + 4 * hi; }
DI bf16x8 cat4(s16x4 lo, s16x4 hi) { return __builtin_shufflevector(lo, hi, 0, 1, 2, 3, 4, 5, 6, 7); }
DI void attn_unit(const Frame& F0, LAS unsigned char* lds, int u) {
    const Frame F = opaque(F0);
    unsigned char* ws = wsp();
    const int b = u >> 6, n = (u >> 1) & 31, kvh = u & 1;
    const int tok0 = b * SEQ + n * 128;
    const bf16_t* Qb = (const bf16_t*)(ws + WS_QB); const bf16_t* Kb = (const bf16_t*)(ws + WS_KB); const bf16_t* Vb = (const bf16_t*)(ws + WS_VB);
    bf16_t* Ob = (bf16_t*)(ws + WS_H0B);
    LAS unsigned char* Kl = lds;
    LAS unsigned char* Vt = lds + 36864;
#pragma unroll
    for (int rep = 0; rep < 4; ++rep) {
        const int c = F.tid + 512 * rep, kw = c >> 3, ch = c & 7;
        int tokk = tok0 - 128 + kw; if (n == 0 && kw < 128) tokk = tok0 + kw;
        const u32x4 kv = *(const u32x4*)(Kb + (size_t)tokk * 128 + kvh * 64 + ch * 8);
        *(LAS u32x4*)(Kl + kw * 144 + ch * 16) = kv;
        const u32x4 vv = *(const u32x4*)(Vb + (size_t)tokk * 128 + kvh * 64 + ch * 8);
        const unsigned wv[4] = {vv.x, vv.y, vv.z, vv.w};
#pragma unroll
        for (int e = 0; e < 8; ++e) { const int d = ch * 8 + e; const unsigned short val = (unsigned short)((e & 1) ? (wv[e >> 1] >> 16) : (wv[e >> 1] & 0xffffu));
            *(LAS unsigned short*)(Vt + d * 512 + ((((kw >> 2) ^ (d & 31))) << 3) + (kw & 3) * 2) = val; }
    }
    __syncthreads();
    const int g = F.wave >> 1, rh = F.wave & 1, hq = kvh * 4 + g;
    const int q = F.lane & 31, hi = F.lane >> 5;
    const float sink2 = inp<I_SINKS>()[hq] * LOG2E;
#pragma unroll 1
    for (int sb = 0; sb < 2; ++sb) {
        const int r0 = rh * 64 + sb * 32, kb0 = r0 >> 5;
        const bf16_t* qp = Qb + (size_t)(tok0 + r0 + q) * 512 + hq * 64 + hi * 8;
        bf16x8 qf[4];
#pragma unroll
        for (int ds = 0; ds < 4; ++ds) qf[ds] = *(const bf16x8*)(qp + ds * 16);
        f32x16 p[5];
#pragma unroll
        for (int kbi = 0; kbi < 5; ++kbi) {
            f32x16 a = {};
#pragma unroll
            for (int ds = 0; ds < 4; ++ds) { const bf16x8 kf = *(const LAS bf16x8*)(Kl + ((kb0 + kbi) * 32 + q) * 144 + (ds * 16 + hi * 8) * 2); a = MFMA32(kf, qf[ds], a); }
            p[kbi] = a;
        }
        const int qi = 128 + r0 + q;
        float mx = sink2;
#pragma unroll
        for (int kbi = 0; kbi < 5; ++kbi)
#pragma unroll
            for (int r = 0; r < 16; ++r) { const int kw = (kb0 + kbi) * 32 + crow(r, hi); const bool ok = (kw <= qi) && (qi - kw < 128) && (n > 0 || kw >= 128);
                const float s = ok ? p[kbi][r] : -1e30f; p[kbi][r] = s; mx = fmaxf(mx, s); }
        mx = fmaxf(mx, __shfl_xor(mx, 32));
        float l = 0.f;
#pragma unroll
        for (int kbi = 0; kbi < 5; ++kbi)
#pragma unroll
            for (int r = 0; r < 16; ++r) { const float e = __builtin_amdgcn_exp2f(p[kbi][r] - mx); p[kbi][r] = e; l += e; }
        l += __shfl_xor(l, 32); l += __builtin_amdgcn_exp2f(sink2 - mx);
        f32x16 o0 = {}, o1 = {};
#pragma unroll
        for (int kbi = 0; kbi < 5; ++kbi)
#pragma unroll
            for (int s2 = 0; s2 < 2; ++s2) {
                u32x4 pw; pw.x = cvtpk(p[kbi][8 * s2 + 0], p[kbi][8 * s2 + 1]); pw.y = cvtpk(p[kbi][8 * s2 + 2], p[kbi][8 * s2 + 3]);
                pw.z = cvtpk(p[kbi][8 * s2 + 4], p[kbi][8 * s2 + 5]); pw.w = cvtpk(p[kbi][8 * s2 + 6], p[kbi][8 * s2 + 7]);
                const bf16x8 pa = __builtin_bit_cast(bf16x8, pw);
                const int kc = ((kb0 + kbi) * 32 + 16 * s2 + 4 * hi) >> 2;
                { const int d = q; const s16x4 lo = *(const LAS s16x4*)(Vt + d * 512 + ((kc ^ (d & 31)) << 3)), hh = *(const LAS s16x4*)(Vt + d * 512 + (((kc + 2) ^ (d & 31)) << 3)); o0 = MFMA32(cat4(lo, hh), pa, o0); }
                { const int d = 32 + q; const s16x4 lo = *(const LAS s16x4*)(Vt + d * 512 + ((kc ^ (d & 31)) << 3)), hh = *(const LAS s16x4*)(Vt + d * 512 + (((kc + 2) ^ (d & 31)) << 3)); o1 = MFMA32(cat4(lo, hh), pa, o1); }
            }
        const float rl = __builtin_amdgcn_rcpf(l);
        bf16_t* op = Ob + (size_t)(tok0 + r0 + q) * D + hq * 64 + 4 * hi;
#pragma unroll
        for (int g4 = 0; g4 < 4; ++g4) {
            u32x2 w0, w1; w0.x = cvtpk(o0[4 * g4] * rl, o0[4 * g4 + 1] * rl); w0.y = cvtpk(o0[4 * g4 + 2] * rl, o0[4 * g4 + 3] * rl);
            w1.x = cvtpk(o1[4 * g4] * rl, o1[4 * g4 + 1] * rl); w1.y = cvtpk(o1[4 * g4 + 2] * rl, o1[4 * g4 + 3] * rl);
            *(u32x2*)(op + 8 * g4) = w0; *(u32x2*)(op + 32 + 8 * g4) = w1;
        }
    }
    __syncthreads();
}
DI void gmlp_unit(const Frame& F0, LAS unsigned char* lds, int chunk) {
    const Frame F = opaque(F0);
    unsigned char* ws = wsp();
    const int h = F.wave, tok0 = chunk * 128;
    const bf16_t* GUb = (const bf16_t*)(ws + WS_GUB); const bf16_t* GVb = (const bf16_t*)(ws + WS_GVB); const bf16_t* wsp = (const bf16_t*)(ws + WS_WSP);
    bf16_t* Ob = (bf16_t*)(ws + WS_H0B);
    LAS unsigned char* Vt = lds + F.wave * 16384;
#pragma unroll 4
    for (int rep = 0; rep < 16; ++rep) {
        const int c = F.lane + 64 * rep, s = c >> 3, ch = c & 7;
        const u32x4 vv = *(const u32x4*)(GVb + (size_t)(tok0 + s) * 512 + h * 64 + ch * 8);
        const unsigned wv[4] = {vv.x, vv.y, vv.z, vv.w};
#pragma unroll
        for (int e = 0; e < 8; ++e) { const int d = ch * 8 + e; const unsigned short val = (unsigned short)((e & 1) ? (wv[e >> 1] >> 16) : (wv[e >> 1] & 0xffffu));
            *(LAS unsigned short*)(Vt + d * 256 + (((s >> 2) ^ (d & 31)) << 3) + (s & 3) * 2) = val; }
    }
    LDS_WAIT();
    const int q = F.lane & 31, hi = F.lane >> 5;
    const float* b_s = inp<I_BS>();
#pragma unroll 1
    for (int tb = 0; tb < 4; ++tb) {
        f32x16 a0 = {}, a1 = {};
        const int t = tb * 32 + q;
        const bf16_t* gp = GUb + (size_t)(tok0 + t) * 512 + h * 64 + 4 * hi;
        u32x2 gu0[4], gu1[4];
#pragma unroll
        for (int g4 = 0; g4 < 4; ++g4) { gu0[g4] = *(const u32x2*)(gp + 8 * g4); gu1[g4] = *(const u32x2*)(gp + 32 + 8 * g4); }
        const float bias = b_s[h * 128 + t];
        const bf16_t* wp = wsp + ((size_t)(h * 128 + t) * 8) * 16 + hi * 8;
        for (int ks = 0; ks < 2 * tb + 2; ++ks) {
            const bf16x8 wa = *(const bf16x8*)(wp + ks * 16);
            const int kc = (16 * ks + 4 * hi) >> 2;
            { const int d = q; const s16x4 lo = *(const LAS s16x4*)(Vt + d * 256 + ((kc ^ (d & 31)) << 3)), hh = *(const LAS s16x4*)(Vt + d * 256 + (((kc + 2) ^ (d & 31)) << 3)); a0 = MFMA32(cat4(lo, hh), wa, a0); }
            { const int d = 32 + q; const s16x4 lo = *(const LAS s16x4*)(Vt + d * 256 + ((kc ^ (d & 31)) << 3)), hh = *(const LAS s16x4*)(Vt + d * 256 + (((kc + 2) ^ (d & 31)) << 3)); a1 = MFMA32(cat4(lo, hh), wa, a1); }
        }
        bf16_t* op = Ob + (size_t)(tok0 + t) * D + 512 + h * 64 + 4 * hi;
#pragma unroll
        for (int g4 = 0; g4 < 4; ++g4) {
            u32x2 w0, w1;
            w0.x = cvtpk(bflo(gu0[g4].x) * (a0[4 * g4] + bias), bfhi(gu0[g4].x) * (a0[4 * g4 + 1] + bias)); w0.y = cvtpk(bflo(gu0[g4].y) * (a0[4 * g4 + 2] + bias), bfhi(gu0[g4].y) * (a0[4 * g4 + 3] + bias));
            w1.x = cvtpk(bflo(gu1[g4].x) * (a1[4 * g4] + bias), bfhi(gu1[g4].x) * (a1[4 * g4 + 1] + bias)); w1.y = cvtpk(bflo(gu1[g4].y) * (a1[4 * g4 + 2] + bias), bfhi(gu1[g4].y) * (a1[4 * g4 + 3] + bias));
            *(u32x2*)(op + 8 * g4) = w0; *(u32x2*)(op + 32 + 8 * g4) = w1;
        }
    }
    LDS_WAIT();
}

DI void p4_router(const Frame& F0, LAS unsigned char* lds) {
    const Frame F = opaque(F0);
    unsigned char* ws = wsp(); float* out = outp();
    LAS float* wrT = (LAS float*)lds;
    LAS int* cnt = (LAS int*)(lds + MISC_OFF + 256);
    { const float* w_router = inp<I_WR>();
      for (int i = F.tid; i < D * 8; i += NTHREADS) { const int c = i & 1023, eq = i >> 10; const f32x4 w4 = *(const f32x4*)(w_router + c * 32 + 4 * eq);
          wrT[(4 * eq + 0) * D + c] = w4.x; wrT[(4 * eq + 1) * D + c] = w4.y; wrT[(4 * eq + 2) * D + c] = w4.z; wrT[(4 * eq + 3) * D + c] = w4.w; } }
    if (F.tid < 32) cnt[F.tid] = 0;
    __syncthreads();
    const int R = T / G, rpw = R / NWAVES;
    int* tok_e = (int*)(ws + WS_TOKE); float* tok_g = (float*)(ws + WS_TOKG); int* tok_l = (int*)(ws + WS_TOKL);
    const int lane = F.lane;
    f32x4 g1[4], b1[4];
#pragma unroll
    for (int j = 0; j < 4; ++j) { g1[j] = ((const f32x4*)inp<I_LN1G>())[lane + 64 * j]; b1[j] = ((const f32x4*)inp<I_LN1B>())[lane + 64 * j]; }
    const float br = inp<I_BR>()[lane >> 1];
    constexpr int NR = 1;
    f32x4 pf0[4], pf1[4];
    { const int tokb = F.bid * R + F.wave * rpw;
#pragma unroll
      for (int j = 0; j < 4; ++j) { pf0[j] = ((const GAS f32x4*)(out + (size_t)tokb * D))[lane + 64 * j]; pf1[j] = ((const GAS f32x4*)(out + (size_t)(tokb + 1) * D))[lane + 64 * j]; } }
#pragma unroll 1
    for (int i = 0; i < rpw; i += NR) {
        const int tok0 = F.bid * R + F.wave * rpw + i;
        f32x4 v[NR][4];
#pragma unroll
        for (int j = 0; j < 4; ++j) { v[0][j] = pf0[j]; pf0[j] = pf1[j]; }
        { const int tn = (i + 2 < rpw) ? tok0 + 2 : tok0;
#pragma unroll
          for (int j = 0; j < 4; ++j) pf1[j] = ((const GAS f32x4*)(out + (size_t)tn * D))[lane + 64 * j]; }
        float s[NR], s2[NR];
#pragma unroll
        for (int r = 0; r < NR; ++r) { s[r] = 0.f;
#pragma unroll
            for (int j = 0; j < 4; ++j) s[r] += (v[r][j].x + v[r][j].y) + (v[r][j].z + v[r][j].w); }
        for (int r = 0; r < NR; ++r) s[r] = wave_sum(s[r]) * (1.f / D);
#pragma unroll
        for (int r = 0; r < NR; ++r) { s2[r] = 0.f;
#pragma unroll
            for (int j = 0; j < 4; ++j) { v[r][j] = v[r][j] - s[r]; s2[r] += (v[r][j].x * v[r][j].x + v[r][j].y * v[r][j].y) + (v[r][j].z * v[r][j].z + v[r][j].w * v[r][j].w); } }
        for (int r = 0; r < NR; ++r) s2[r] = 1.f / sqrtf(wave_sum(s2[r]) * (1.f / D) + LN_EPS);
#pragma unroll
        for (int r = 0; r < NR; ++r) {
            float* rowp = out + (size_t)(tok0 + r) * D;
            GAS u32x2* hp = (GAS u32x2*)rowp + lane; GAS u32x2* lp = (GAS u32x2*)(rowp + 512) + lane;
#pragma unroll
            for (int j = 0; j < 4; ++j) {
                v[r][j] = v[r][j] * s2[r] * g1[j] + b1[j];
                u32x2 wh; wh.x = cvtpk(v[r][j].x, v[r][j].y); wh.y = cvtpk(v[r][j].z, v[r][j].w);
                u32x2 wl; wl.x = cvtpk(v[r][j].x - bflo(wh.x), v[r][j].y - bfhi(wh.x)); wl.y = cvtpk(v[r][j].z - bflo(wh.y), v[r][j].w - bfhi(wh.y));
                hp[64 * j] = wh; lp[64 * j] = wl;
                ((GAS unsigned*)(ws + WS_H1Q + (size_t)(tok0 + r) * 1024))[lane + 64 * j] = cvt4_fp8(v[r][j].x, v[r][j].y, v[r][j].z, v[r][j].w);
            }
        }
        float acc[NR][32];
        unsigned wb0 = (unsigned)(16 * lane), wb1 = wb0 + 65536u; asm volatile("" : "+v"(wb0), "+v"(wb1));
#pragma unroll
        for (int e = 0; e < 32; ++e) {
            f32x2 a2[NR]; for (int r = 0; r < NR; ++r) a2[r] = (f32x2){0.f, 0.f};
#pragma unroll
            for (int j = 0; j < 4; ++j) { const f32x4 w4 = *(const LAS f32x4*)((LAS unsigned char*)wrT + (e < 16 ? wb0 : wb1) + (e & 15) * 4096 + 1024 * j);
#pragma unroll
                for (int r = 0; r < NR; ++r) { a2[r] = a2[r] + (f32x2){v[r][j].x, v[r][j].y} * (f32x2){w4.x, w4.y}; a2[r] = a2[r] + (f32x2){v[r][j].z, v[r][j].w} * (f32x2){w4.z, w4.w}; } }
            for (int r = 0; r < NR; ++r) acc[r][e] = a2[r].x + a2[r].y;
            if ((e & 1) == 1) __builtin_amdgcn_sched_barrier(0);
        }
#pragma unroll
        for (int r = 0; r < NR; ++r) {
#pragma unroll
            for (int e = 0; e < 16; ++e) { float a = acc[r][e], b = acc[r][e + 16]; swap32(a, b); acc[r][e] = a + b; }
#pragma unroll
            for (int e = 0; e < 8; ++e) { float a = acc[r][e], b = acc[r][e + 8]; swap16(a, b); acc[r][e] = a + b; }
#pragma unroll
            for (int e = 0; e < 4; ++e) { const bool up = (lane & 8) != 0; const float keep = up ? acc[r][e + 4] : acc[r][e], send = up ? acc[r][e] : acc[r][e + 4]; acc[r][e] = keep + dppf<DPP_MIRROR>(send); }
#pragma unroll
            for (int e = 0; e < 2; ++e) { const bool up = (lane & 4) != 0; const float keep = up ? acc[r][e + 2] : acc[r][e], send = up ? acc[r][e] : acc[r][e + 2]; acc[r][e] = keep + dppf<DPP_HMIRROR>(send); }
            { const bool up = (lane & 2) != 0; const float keep = up ? acc[r][1] : acc[r][0], send = up ? acc[r][0] : acc[r][1]; acc[r][0] = keep + dppf<DPP_XOR2>(send); }
            const float logit = acc[r][0] + dppf<DPP_XOR1>(acc[r][0]) + br;
            const int myE = lane >> 1;
            float vals[4]; int idxs[4]; float cur = logit;
#pragma unroll
            for (int k = 0; k < 4; ++k) {
                float bv = cur; int bi = myE;
#define P4_STEP(LV) { const float ov = partnerf<LV>(bv, lane); const int oi = partneri<LV>(bi, lane); if (ov > bv || (ov == bv && oi < bi)) { bv = ov; bi = oi; } }
                P4_STEP(1) P4_STEP(2) P4_STEP(3) P4_STEP(4) P4_STEP(5)
#undef P4_STEP
                vals[k] = bv; idxs[k] = bi; if (myE == bi) cur = -INFINITY;
            }
            const float e1 = __expf(vals[1] - vals[0]), e2 = __expf(vals[2] - vals[0]), e3 = __expf(vals[3] - vals[0]);
            const float inv = 1.0f / (1.0f + e1 + e2 + e3);
            if (lane < 4) {
                const int tok = tok0 + r;
                const float ee = lane == 0 ? 1.0f : lane == 1 ? e1 : lane == 2 ? e2 : e3;
                const int ex = lane == 0 ? idxs[0] : lane == 1 ? idxs[1] : lane == 2 ? idxs[2] : idxs[3];
                const int lp2 = atomicAdd((int*)(cnt + ex), 1);
                tok_e[tok * 4 + lane] = ex; tok_g[tok * 4 + lane] = ee * inv; tok_l[tok * 4 + lane] = lp2;
            }
        }
    }
    __syncthreads();
    if (F.tid < 32) ((int*)(ws + WS_WGCOUNT))[F.bid * 32 + F.tid] = cnt[F.tid];
}
DI int p4b_lists(const Frame& F0, LAS unsigned char* lds) {
    const Frame F = opaque(F0);
    unsigned char* ws = wsp();
    LAS int* tab = (LAS int*)lds;
    LAS int* pstart = (LAS int*)(lds + MISC_OFF + 256);
    LAS int* mybase = pstart + 64;
    const int* wgc = (const int*)(ws + WS_WGCOUNT);
    for (int i = F.tid; i < G * 32; i += NTHREADS) tab[i] = (int)__hip_atomic_load((unsigned*)wgc + i, __ATOMIC_RELAXED, __HIP_MEMORY_SCOPE_AGENT);
    __syncthreads();
    if (F.tid < 32) { int tot = 0, mb = 0; for (int w = 0; w < G; ++w) { const int c = tab[w * 32 + F.tid]; if (w < F.bid) mb += c; tot += c; } mybase[F.tid] = mb; pstart[32 + 32 + 32 + F.tid] = tot; }
    __syncthreads();
    if (F.tid == 0) { int off = 0; for (int e = 0; e < 32; ++e) { pstart[e] = off; off += ((pstart[96 + e] + 255) >> 8) << 8; } pstart[32] = off; }
    __syncthreads();
    const int ngroups = pstart[32] >> 8;
    if (F.bid == 0) {
        int* grp_e = (int*)(ws + WS_GRPE);
        for (int g = F.tid; g < NGRP_MAX; g += NTHREADS) { int e = 0; for (int k = 1; k < 32; ++k) if (pstart[k] <= g * 256) e = k; grp_e[g] = (g < ngroups) ? e : 0; }
    }
    const int R = T / G;
    const int* tok_e = (const int*)(ws + WS_TOKE); const float* tok_g = (const float*)(ws + WS_TOKG); const int* tok_l = (const int*)(ws + WS_TOKL);
    int* slot_tok = (int*)(ws + WS_SLOTTOK); float* slot_gate = (float*)(ws + WS_SLOTGATE); int* slot_dest = (int*)(ws + WS_SLOTDEST);
    for (int i = F.tid; i < R * 4; i += NTHREADS) {
        const int idx = F.bid * R * 4 + i; const int e = tok_e[idx];
        const int slot = pstart[e] + mybase[e] + tok_l[idx];
        slot_tok[slot] = idx >> 2; slot_gate[slot] = tok_g[idx]; slot_dest[slot] = idx;
    }
    return ngroups;
}
DI void p7_final(const Frame& F0) {
    const Frame F = opaque(F0);
    unsigned char* ws = wsp(); float* out = outp();
    const bf16_t* yslot = (const bf16_t*)(ws + WS_YSLOT);
    const int gw = F.bid * NWAVES + F.wave, NGW = G * NWAVES, lane = F.lane;
    const float* ln2_g = inp<I_LN2G>(); const float* ln2_b = inp<I_LN2B>();
    for (int tok = gw; tok < T; tok += NGW) {
        float* rowp = out + (size_t)tok * D;
        f32x4 v[4];
#pragma unroll
        for (int j = 0; j < 4; ++j) {
            const u32x2 wh = ((const GAS u32x2*)rowp)[lane + 64 * j], wl = ((const GAS u32x2*)(rowp + 512))[lane + 64 * j];
            v[j] = (f32x4){bflo(wh.x) + bflo(wl.x), bfhi(wh.x) + bfhi(wl.x), bflo(wh.y) + bflo(wl.y), bfhi(wh.y) + bfhi(wl.y)} * ALPHA;
        }
#pragma unroll
        for (int k = 0; k < 4; ++k) {
            const GAS u32x2* yp = (const GAS u32x2*)(yslot + ((size_t)tok * 4 + k) * 1024) + lane;
#pragma unroll
            for (int j = 0; j < 4; ++j) { const u32x2 w = yp[64 * j]; v[j] = v[j] + (f32x4){bflo(w.x), bfhi(w.x), bflo(w.y), bfhi(w.y)}; }
        }
        float s = 0.f;
#pragma unroll
        for (int j = 0; j < 4; ++j) s += (v[j].x + v[j].y) + (v[j].z + v[j].w);
        const float mean = wave_sum(s) * (1.f / D); float s2 = 0.f;
#pragma unroll
        for (int j = 0; j < 4; ++j) { v[j] = v[j] - mean; s2 += (v[j].x * v[j].x + v[j].y * v[j].y) + (v[j].z * v[j].z + v[j].w * v[j].w); }
        const float rstd = 1.f / sqrtf(wave_sum(s2) * (1.f / D) + LN_EPS);
#pragma unroll
        for (int j = 0; j < 4; ++j) { const f32x4 gg = ((const f32x4*)ln2_g)[lane + 64 * j], bb = ((const f32x4*)ln2_b)[lane + 64 * j];
            ((GAS f32x4*)rowp)[lane + 64 * j] = v[j] * rstd * gg + bb; }
    }
}

struct CfgIn   { static constexpr bool FP8 = false, GATHER = false; static constexpr size_t A_OFF = WS_H0B,  B_OFF = WS_WIN,  B_E_BYTES = 0; static constexpr unsigned A_PITCH = 0; };
struct CfgOut  { static constexpr bool FP8 = false, GATHER = false; static constexpr size_t A_OFF = WS_H0B,  B_OFF = WS_WOUT, B_E_BYTES = 0; static constexpr unsigned A_PITCH = 0; };
struct CfgGU   { static constexpr bool FP8 = true,  GATHER = true;  static constexpr size_t A_OFF = WS_H1Q,  B_OFF = WS_WGU,  B_E_BYTES = (size_t)2048 * D; static constexpr unsigned A_PITCH = 1024u; };
struct CfgDown { static constexpr bool FP8 = true,  GATHER = false; static constexpr size_t A_OFF = WS_HMID, B_OFF = WS_WD,   B_E_BYTES = (size_t)D * D; static constexpr unsigned A_PITCH = 0; };
#ifndef PHASE_MASK
#define PHASE_MASK 0xFFFF
#endif
struct Args { const void* in[23]; float* out; unsigned char* ws; };
__global__ void __launch_bounds__(NTHREADS, 2) mk_fwd(Args args) {
    __shared__ __attribute__((aligned(16))) unsigned char lds_raw[LDS_BYTES];
    LAS unsigned char* lds = (LAS unsigned char*)lds_raw;
    Frame F;
    F.tid = threadIdx.x; F.lane = F.tid & 63; F.wave = __builtin_amdgcn_readfirstlane(F.tid >> 6); F.bid = blockIdx.x;
    volatile LAS unsigned* MISC = (volatile LAS unsigned*)(lds + MISC_OFF);
    if (F.tid < 64) MISC[F.tid] = 0u;
    __syncthreads();
    xcd_barrier_post((unsigned*)(wsp() + WS_CTL) + CW_BAR);
    volatile LAS unsigned* bst = MISC + 8;
#ifdef PROBE_A
    int n_stamp = 0;
#define STAMP() do { if (F.bid == 0 && F.tid == 0) { __hip_atomic_store((unsigned long long*)(wsp() + WS_CTL + 32768) + n_stamp, (unsigned long long)__builtin_amdgcn_s_memrealtime(), __ATOMIC_RELAXED, __HIP_MEMORY_SCOPE_AGENT); } ++n_stamp; } while (0)
#else
#define STAMP() do {} while (0)
#endif
    STAMP();
    LAS unsigned char* tokbuf = lds + TOKBUF_OFF;

    if (PHASE_MASK & 1) p0_prologue(F, lds);
    xcd_barrier(bst); STAMP();
    if (PHASE_MASK & 2) { pg8::StaticOrder<T, INW> S{F.bid}; EpiInProj E; pg8::gemm_phase<CfgIn>(lds, tokbuf, 0, S, E); }
    xcd_barrier(bst); STAMP();
    if (PHASE_MASK & 4) for (int u = F.bid; u < NBATCH * 32 * 2; u += G) attn_unit(F, lds, u);
    if (PHASE_MASK & 8) for (int c = F.bid; c < T / 128; c += G) gmlp_unit(F, lds, c);
    xcd_barrier(bst); STAMP();
    if (PHASE_MASK & 16) { pg8::StaticOrder<T, D> S{F.bid}; EpiOut E; pg8::gemm_phase<CfgOut>(lds, tokbuf, 0, S, E); }
    xcd_barrier(bst); STAMP();
    if (PHASE_MASK & 32) p4_router(F, lds);
    xcd_barrier(bst); STAMP();
    int ngroups = 1040; if (PHASE_MASK & 64) ngroups = p4b_lists(F, lds);
    xcd_barrier(bst); STAMP();
    if (PHASE_MASK & 128) { pg8::GroupOrder<8> S{0, ngroups, F.bid}; EpiGateUp E; pg8::gemm_phase<CfgGU>(lds, tokbuf, 0, S, E); }
    xcd_barrier(bst); STAMP();
    if (PHASE_MASK & 256) { pg8::GroupOrder<4> S{0, ngroups, F.bid}; EpiDown E; pg8::gemm_phase<CfgDown>(lds, tokbuf, 0, S, E); }
    xcd_barrier(bst); STAMP();
    if (PHASE_MASK & 512) p7_final(F);
#ifdef PROBE_A
    STAMP();
    if (F.bid == 0 && F.tid == 0) {
        unsigned long long* ts = (unsigned long long*)(wsp() + WS_CTL + 32768);
        unsigned long long extra = 0ull;
        for (int k = 1; k < 12; ++k) if ((PROBE_A >> k) & 1) extra += __hip_atomic_load(ts + k, __ATOMIC_RELAXED, __HIP_MEMORY_SCOPE_AGENT) - __hip_atomic_load(ts + k - 1, __ATOMIC_RELAXED, __HIP_MEMORY_SCOPE_AGENT);
        const unsigned long long t0 = __builtin_amdgcn_s_memrealtime();
        while (__builtin_amdgcn_s_memrealtime() - t0 < extra) __builtin_amdgcn_s_sleep(8);
    }
#endif
}

extern "C" void kernel_launch(void* const* d_in, const int* in_sizes, int n_in, void* d_out, int out_size, void* d_ws, size_t ws_size, hipStream_t stream) {
    static int grid = 0;
    if (grid == 0) {
        if (n_in != 23 || in_sizes[0] != T * D || out_size != T * D || ws_size < WS_END) {
            fprintf(stderr, "kernel_launch: unexpected shapes/workspace (n_in %d, in0 %d, out %d, ws %zu, need %zu); nothing launched\n", n_in, n_in > 0 ? in_sizes[0] : -1, out_size, ws_size, (size_t)WS_END);
            grid = -1; return;
        }
        int dev = 0, cus = 0, per_cu = 0;
        if (hipGetDevice(&dev) != hipSuccess || hipDeviceGetAttribute(&cus, hipDeviceAttributeMultiprocessorCount, dev) != hipSuccess) { grid = -1; return; }
        if (hipOccupancyMaxActiveBlocksPerMultiprocessor(&per_cu, (const void*)mk_fwd, NTHREADS, 0) != hipSuccess || per_cu < 1) {
            fprintf(stderr, "kernel_launch: occupancy query says %d blocks per CU; nothing launched\n", per_cu); (void)hipGetLastError(); grid = -1; return;
        }
        grid = cus;
        if (grid != G) { fprintf(stderr, "kernel_launch: built for a 256-CU device, found %d; nothing launched\n", cus); grid = -1; return; }
    }
    if (grid < 0) return;
    if (hipMemsetAsync((char*)d_ws + WS_CTL, 0, CTL_ZERO_BYTES, stream) != hipSuccess) return;
    Args a{};
    for (int i = 0; i < 23; ++i) a.in[i] = d_in[i];
    a.out = (float*)d_out; a.ws = (unsigned char*)d_ws;
    hipLaunchKernelGGL(mk_fwd, dim3(grid), dim3(NTHREADS), 0, stream, a);
}
```

```cpp
#include <hip/hip_runtime.h>
#include <cstdio>
#include <cstdint>
#include <type_traits>

#define DI __device__ __forceinline__
#define LAS __attribute__((address_space(3)))
#define GAS __attribute__((address_space(1)))
typedef unsigned short bf16_t;
typedef short bf16x8 __attribute__((ext_vector_type(8)));
typedef short s16x4 __attribute__((ext_vector_type(4)));
typedef float f32x2 __attribute__((ext_vector_type(2)));
typedef float f32x4 __attribute__((ext_vector_type(4)));
typedef float f32x16 __attribute__((ext_vector_type(16)));
typedef unsigned u32x2 __attribute__((ext_vector_type(2)));
typedef unsigned u32x4 __attribute__((ext_vector_type(4)));
typedef __bf16 bf16x2_t __attribute__((ext_vector_type(2)));
typedef GAS unsigned gu32;
typedef int v8i __attribute__((ext_vector_type(8)));

constexpr int D = 1024, SEQ = 4096, NBATCH = 16, T = NBATCH * SEQ;
constexpr int INW = 1792, NE = 32;
constexpr int NSLOT = T * 4 + NE * 256;
constexpr int NGRP_MAX = NSLOT / 256;
constexpr float LN_EPS = 1e-5f;
constexpr float ALPHA = 1.189207115002721f;
constexpr float LOG2E = 1.4426950408889634f;
constexpr float QSCALE = 0.125f * LOG2E;
constexpr float WQ_SCALE = 64.0f;
constexpr int WQ_E8M0 = 127 - 6;
constexpr int NWAVES = 8, NTHREADS = 512;

constexpr size_t MiB = 1u << 20;
constexpr size_t WS_CTL = 0, CTL_ZERO_BYTES = 65536;
constexpr size_t WS_WGCOUNT = 1 * MiB;
constexpr size_t WS_GRPE = 1 * MiB + 65536;
constexpr size_t WS_OUTC = 1 * MiB + 131072;
constexpr size_t WS_WIN = 2 * MiB;
constexpr size_t WS_WOUT = 6 * MiB;
constexpr size_t WS_WSP = 8 * MiB;
constexpr size_t WS_STATS0 = 9 * MiB;
constexpr size_t WS_ROPE = 10 * MiB;
constexpr size_t WS_WGU = 16 * MiB;
constexpr size_t WS_WD = 80 * MiB;
constexpr size_t WS_H1Q = 112 * MiB;
constexpr size_t WS_TOKE = 208 * MiB;
constexpr size_t WS_TOKG = 209 * MiB;
constexpr size_t WS_TOKL = 210 * MiB;
constexpr size_t WS_SLOTTOK = 211 * MiB;
constexpr size_t WS_SLOTGATE = 212 * MiB + 512 * 1024;
constexpr size_t WS_SLOTDEST = 214 * MiB;
constexpr size_t WS_H0B = 216 * MiB;
constexpr size_t WS_QB = 344 * MiB;
constexpr size_t WS_KB = 408 * MiB;
constexpr size_t WS_VB = 424 * MiB;
constexpr size_t WS_GUB = 440 * MiB;
constexpr size_t WS_GVB = 504 * MiB;
constexpr size_t WS_YSLOT = 216 * MiB;
constexpr size_t WS_HMID = 728 * MiB;
constexpr size_t WS_END = 1024 * MiB;
static_assert(WS_HMID + (size_t)NSLOT * 1024 <= WS_END && WS_H1Q + (size_t)T * 1024 <= 208 * MiB, "ws map");
static_assert(WS_YSLOT + (size_t)T * 4 * 1024 * 2 <= WS_HMID, "ws map");
constexpr int CW_BAR = 4096;

constexpr int RING_BYTES = 131072;
constexpr int MISC_OFF = RING_BYTES;
constexpr int TOKBUF_OFF = MISC_OFF + 1024;
constexpr int EPIBUF_OFF = MISC_OFF + 4096;
constexpr int LDS_BYTES = 147456;

DI unsigned cvtpk(float lo, float hi) { f32x2 v = {lo, hi}; bf16x2_t b = __builtin_convertvector(v, bf16x2_t); return __builtin_bit_cast(unsigned, b); }
DI unsigned cvt4_fp8(float a, float b, float c, float d) { int p = __builtin_amdgcn_cvt_pk_fp8_f32(a, b, 0, false); p = __builtin_amdgcn_cvt_pk_fp8_f32(c, d, p, true); return (unsigned)p; }
DI float bf2f(unsigned short h) { return __uint_as_float((unsigned)h << 16); }
DI float bflo(unsigned w) { return __uint_as_float(w << 16); }
DI float bfhi(unsigned w) { return __uint_as_float(w & 0xffff0000u); }
template <int CTRL> DI float dppf(float v) { return __builtin_bit_cast(float, __builtin_amdgcn_update_dpp(0, __builtin_bit_cast(int, v), CTRL, 0xf, 0xf, false)); }
DI void swap32(float& a, float& b) { asm("s_nop 1\n\tv_permlane32_swap_b32 %0, %1" : "+v"(a), "+v"(b)); }
DI void swap16(float& a, float& b) { asm("s_nop 1\n\tv_permlane16_swap_b32 %0, %1" : "+v"(a), "+v"(b)); }
template <int CTRL> DI int dppi(int v) { return __builtin_amdgcn_update_dpp(0, v, CTRL, 0xf, 0xf, false); }
constexpr int DPP_XOR1 = 0xB1, DPP_XOR2 = 0x4E, DPP_HMIRROR = 0x141, DPP_MIRROR = 0x140;
template <int LV> DI float partnerf(float v, int lane) {
    if constexpr (LV == 0) return dppf<DPP_XOR1>(v);
    else if constexpr (LV == 1) return dppf<DPP_XOR2>(v);
    else if constexpr (LV == 2) return dppf<DPP_HMIRROR>(v);
    else if constexpr (LV == 3) return dppf<DPP_MIRROR>(v);
    else if constexpr (LV == 4) { float a = v, b = v; swap16(a, b); return (lane & 16) ? a : b; }
    else { float a = v, b = v; swap32(a, b); return (lane & 32) ? a : b; }
}
template <int LV> DI int partneri(int v, int lane) { return __builtin_bit_cast(int, partnerf<LV>(__builtin_bit_cast(float, v), lane)); }
DI float wave_sum(float v) {
    v += dppf<DPP_XOR1>(v); v += dppf<DPP_XOR2>(v); v += dppf<DPP_HMIRROR>(v); v += dppf<DPP_MIRROR>(v);
    { float a = v, b = v; swap16(a, b); v = a + b; }
    { float a = v, b = v; swap32(a, b); v = a + b; }
    return v;
}
#define LDS_WAIT() asm volatile("s_waitcnt lgkmcnt(0)" ::: "memory")
#define VM_WAIT() asm volatile("s_waitcnt vmcnt(0)" ::: "memory")

DI f32x2 gelu_pk(f32x2 v) {
    const f32x2 av = __builtin_elementwise_abs(v), d = av * 0.2316418882f + 1.0f;
    f32x2 t; t.x = __builtin_amdgcn_rcpf(d.x); t.y = __builtin_amdgcn_rcpf(d.y);
    f32x2 q = t * 0.5307027145f + (-0.7265760135f); q = q * t + 0.7107068705f; q = q * t + (-0.142248368f); q = q * t + 0.127414796f; q = q * t;
    const f32x2 s = (v * v) * (-0.72134752044f);
    f32x2 e; e.x = __builtin_amdgcn_exp2f(s.x); e.y = __builtin_amdgcn_exp2f(s.y);
    const f32x2 m = v * (q * e), r = v - m;
    f32x2 o; o.x = v.x < 0.f ? m.x : r.x; o.y = v.y < 0.f ? m.y : r.y; return o;
}
DI f32x4 gelu4(f32x4 v) { f32x2 a = gelu_pk((f32x2){v[0], v[1]}), b = gelu_pk((f32x2){v[2], v[3]}); return (f32x4){a.x, a.y, b.x, b.y}; }


struct Frame { int tid, lane, wave, bid; };
DI Frame opaque(const Frame& f) { Frame r; r.tid = threadIdx.x; asm volatile("" : "+v"(r.tid)); r.lane = r.tid & 63; r.wave = __builtin_amdgcn_readfirstlane(r.tid >> 6); r.bid = f.bid; return r; }
constexpr int G = 256;
template <int K> DI const float* inp() { const float* p; asm volatile("s_load_dwordx2 %0, %1, %2\n\ts_waitcnt lgkmcnt(0)" : "=s"(p) : "s"(__builtin_amdgcn_kernarg_segment_ptr()), "i"(K * 8)); return p; }
DI float* outp() { float* p; asm volatile("s_load_dwordx2 %0, %1, %2\n\ts_waitcnt lgkmcnt(0)" : "=s"(p) : "s"(__builtin_amdgcn_kernarg_segment_ptr()), "i"(23 * 8)); return p; }
DI unsigned char* wsp() { unsigned char* p; asm volatile("s_load_dwordx2 %0, %1, %2\n\ts_waitcnt lgkmcnt(0)" : "=s"(p) : "s"(__builtin_amdgcn_kernarg_segment_ptr()), "i"(24 * 8)); return p; }
enum { I_X = 0, I_POS = 1, I_LNING = 2, I_LNINB = 3, I_WIN = 4, I_BIN = 5, I_SINKS = 6, I_GNG = 7, I_GNB = 8, I_WS = 9, I_BS = 10, I_WOUT = 11, I_BOUT = 12, I_LN1G = 13, I_LN1B = 14,
       I_WR = 15, I_BR = 16, I_WGU = 17, I_BGU = 18, I_WD = 19, I_BD = 20, I_LN2G = 21, I_LN2B = 22 };

#define XB_TMO      128
#define XB_XCNT(j)  (256  + 64 * (j))
#define XB_XSUB(j)  (1280 + 64 * (j))
#define XB_XGEN(j)  (2304 + 64 * (j))
#define XB_TOP      3328
#define XB_TOPGEN   3392
#define XCD_BAR_WORDS 3456
#define XB_SPIN_CAP (1u << 18)
DI unsigned xb_ld(unsigned* p)              { return __hip_atomic_load(p, __ATOMIC_RELAXED, __HIP_MEMORY_SCOPE_AGENT); }
DI unsigned xb_add(unsigned* p, unsigned v) { return __hip_atomic_fetch_add(p, v, __ATOMIC_RELAXED, __HIP_MEMORY_SCOPE_AGENT); }
DI unsigned xb_xcc_id() { return (unsigned)__builtin_amdgcn_s_getreg((3 << 11) | 20) & 0xFu; }
#define XB_SPIN(cond, bar) do { unsigned _sp = 0; while (cond) { __builtin_amdgcn_s_sleep(1); \
    if ((++_sp & 255u) == 0u) { if (xb_ld(&(bar)[XB_TMO])) break; if (_sp > XB_SPIN_CAP) { atomicAdd(&(bar)[XB_TMO], 1u); break; } } } } while (0)
DI void xcd_barrier_post(unsigned* bar) { if (threadIdx.x == 0) (void)xb_add(&bar[XB_XCNT(xb_xcc_id())], 1u); }
DI void xcd_barrier_complete(unsigned* bar, unsigned x, unsigned& nloc, unsigned& nx) {
    unsigned sum, cnt, mine, sp = 0u;
    for (;;) {
        sum = 0u; cnt = 0u; mine = 0u;
#pragma unroll
        for (unsigned j = 0; j < 16; ++j) { const unsigned c = xb_ld(&bar[XB_XCNT(j)]); sum += c; cnt += (c > 0u) ? 1u : 0u; mine = (j == x) ? c : mine; }
        if (sum == (unsigned)G) break;
        __builtin_amdgcn_s_sleep(1);
        if ((++sp & 255u) == 0u) { if (xb_ld(&bar[XB_TMO])) break; if (sp > XB_SPIN_CAP) { atomicAdd(&bar[XB_TMO], 1u); break; } }
    }
    nloc = mine > 0u ? mine : 1u; nx = cnt > 0u ? cnt : 1u;
}
DI void xcd_barrier(volatile LAS unsigned* st) {
    asm volatile("s_waitcnt vmcnt(0)" ::: "memory");
    __syncthreads();
    if (threadIdx.x == 0) {
        unsigned* bar = (unsigned*)(wsp() + WS_CTL) + CW_BAR; const unsigned x = xb_xcc_id();
        __builtin_amdgcn_s_waitcnt(0);
        unsigned nloc = st[0], nx = st[1];
        if (nloc == 0u) { xcd_barrier_complete(bar, x, nloc, nx); st[0] = nloc; st[1] = nx; }
        const unsigned old = xb_add(&bar[XB_XSUB(x)], 1u);
        const unsigned gen = old / nloc;
        if (old + 1u == (gen + 1u) * nloc) {
            __builtin_amdgcn_fence(__ATOMIC_RELEASE, "agent");
            asm volatile("s_waitcnt vmcnt(0)" ::: "memory");
            const unsigned og = xb_add(&bar[XB_TOP], 1u);
            const unsigned tg = og / nx;
            if (og + 1u == (tg + 1u) * nx) xb_add(&bar[XB_TOPGEN], 1u);
            else XB_SPIN(xb_ld(&bar[XB_TOPGEN]) == tg, bar);
            __builtin_amdgcn_fence(__ATOMIC_ACQUIRE, "agent");
            xb_add(&bar[XB_XGEN(x)], 1u);
            asm volatile("s_waitcnt vmcnt(0)" ::: "memory");
        } else {
            XB_SPIN(xb_ld(&bar[XB_XGEN(x)]) == gen, bar);
            __builtin_amdgcn_fence(__ATOMIC_ACQUIRE, "agent");
            asm volatile("s_waitcnt vmcnt(0)" ::: "memory");
        }
    }
    __syncthreads();
}

namespace pg8 {
constexpr int BM = 256, HALF = 128, HTB = HALF * 128, NXCD = 8, WGM = 8, GK = 1024;
constexpr size_t KSTEP = 128;
DI int lds_byte(int r, int c) { const int st = (r >> 4) * 2 + (c >> 5), rr = r & 15, cc = c & 31, ob = rr * 64 + cc * 2; return st * 1024 + (ob ^ (((ob >> 9) & 1) << 5)); }
DI void stage_rc(int b, int& R, int& C) { const int st = b / 1024, sb = b % 1024, swz = sb ^ (((sb >> 9) & 1) << 5); R = (st >> 1) * 16 + swz / 64; C = (st & 1) * 32 + (swz % 64) / 2; }
DI int perm32(int rho) { const int n = rho >> 4, i = rho & 15; return 8 * (i >> 2) + 4 * n + (i & 3); }

struct Unit { int pm, pn, e; };

template <int M, int N> struct StaticOrder {
    int c;
    DI bool next(int i, Unit& u) const {
        constexpr int nM = M / BM, nN = N / BM, nwg = nM * nN;
        const int L = i * G + c; if (L >= nwg) return false;
        int wgid = L; { constexpr int q = nwg / NXCD, r = nwg % NXCD; const int xcd = wgid % NXCD, off = wgid / NXCD; wgid = (xcd < r ? xcd * (q + 1) : r * (q + 1) + (xcd - r) * q) + off; }
        constexpr int nig = WGM * nN; const int gid = wgid / nig, fm = gid * WGM, gsz = (nM - fm) < WGM ? (nM - fm) : WGM;
        u.pm = fm + ((wgid % nig) % gsz); u.pn = (wgid % nig) / gsz; u.e = 0; return true;
    }
};
template <int NPN> struct GroupOrder {
    int g0, g1, c;
    DI bool next(int i, Unit& u) const {
        constexpr int GPX = 32 / NPN;
        const int x = c & 7, j = c >> 3;
        const int g = g0 + i * (8 * GPX) + x * GPX + j / NPN;
        if (g >= g1) return false;
        u.pm = g; u.pn = j % NPN;
        u.e = __builtin_amdgcn_readfirstlane((int)__hip_atomic_load((unsigned*)(wsp() + WS_GRPE) + g, __ATOMIC_RELAXED, __HIP_MEMORY_SCOPE_AGENT));
        return true;
    }
};
DI void piece_rc(int i, int& R, int& C) { int t = threadIdx.x; asm volatile("" : "+v"(t)); stage_rc(t * 16 + i * 8192, R, C); }
DI unsigned tok_off(const LAS int* tb, int h, int i, unsigned pitch) { int R, C; piece_rc(i, R, C); int tok = tb[h * HALF + R]; tok = tok < 0 ? 0 : tok; return (unsigned)tok * pitch + (unsigned)C * 2u; }

struct FragBF { bf16x8 k0, k1; };
struct FragF8 { v8i v; };
DI void ldfrag(FragBF& f, const LAS unsigned char* p) { f.k0 = *(const LAS bf16x8*)p; f.k1 = *(const LAS bf16x8*)(p + 1024); }
typedef int v8i_a16 __attribute__((ext_vector_type(8), aligned(16)));
DI void ldfrag(FragF8& f, const LAS unsigned char* p) { f.v = *(const LAS v8i_a16*)p; }
DI void mma(f32x4& acc, const FragBF& w, const FragBF& a) { acc = __builtin_amdgcn_mfma_f32_16x16x32_bf16(w.k0, a.k0, acc, 0, 0, 0); acc = __builtin_amdgcn_mfma_f32_16x16x32_bf16(w.k1, a.k1, acc, 0, 0, 0); }
DI void mma(f32x4& acc, const FragF8& w, const FragF8& a) { acc = __builtin_amdgcn_mfma_scale_f32_16x16x128_f8f6f4(w.v, a.v, acc, 0, 0, 0, WQ_E8M0, 0, 127); }
template <class Cfg, class Epi, class Sched>
DI void gemm_phase(LAS unsigned char* lds, LAS unsigned char* tokbuf, const int pm_bias, const Sched& S, const Epi& E) {
    constexpr bool GATHER = Cfg::GATHER, FP8 = Cfg::FP8;
    constexpr int ROWB = FP8 ? GK : 2 * GK, NT = ROWB / 128;
    constexpr size_t HSTEP = (size_t)HALF * ROWB, TSTEP = 2 * HSTEP;
    using Frag = typename std::conditional<FP8, FragF8, FragBF>::type;
    int tid = threadIdx.x; asm volatile("" : "+v"(tid));
    const int wid = __builtin_amdgcn_readfirstlane(tid >> 6), lane = tid & 63, wr = wid >> 2, wc = wid & 3, fr = lane & 15, fq = lane >> 4;
    unsigned voffB[2], vaC[2][2];
#pragma unroll
    for (int i = 0; i < 2; ++i) { int R, C; stage_rc(tid * 16 + i * 8192, R, C); const int Rb = Epi::PERM ? ((R & ~31) + perm32(R & 31)) : R;
        voffB[i] = (unsigned)(Rb * ROWB + C * 2); vaC[0][i] = (unsigned)(R * ROWB + C * 2); vaC[1][i] = vaC[0][i]; }
    constexpr size_t AHSTEP = GATHER ? (size_t)0 : HSTEP;
    const unsigned ldsw = (unsigned)wid * 1024u;
    const int cfr = FP8 ? (fq >> 1) * 32 + (fq & 1) * 16 : fq * 8;
    const int aoff = lds_byte(wr * 64 + fr, cfr);
    int boff = lds_byte(wc * 32 + fr, cfr) + 4 * HTB; asm volatile("" : "+v"(boff));
#define PG8_SA(b, h) (((b) * 2 + (h)) * HTB)
#define PG8_SB(b, h) ((4 + (b) * 2 + (h)) * HTB)
    const __amdgpu_buffer_rsrc_t rs = __builtin_amdgcn_make_buffer_rsrc((void*)wsp(), 0, 0x40000000, 0x00020000);
#define PG8_STAGEB(bufoff, soff) do { _Pragma("unroll") for (int _i = 0; _i < 2; ++_i) \
        __builtin_amdgcn_raw_ptr_buffer_load_lds(rs, (LAS void*)(lds + (bufoff) + ldsw + _i * 8192), 16, voffB[_i], (int)(soff), 0, 0); } while (0)
#define PG8_STAGEA(bufoff, soff, o0, o1) do { \
        __builtin_amdgcn_raw_ptr_buffer_load_lds(rs, (LAS void*)(lds + (bufoff) + ldsw), 16, (o0), (int)(soff), 0, 0); \
        __builtin_amdgcn_raw_ptr_buffer_load_lds(rs, (LAS void*)(lds + (bufoff) + ldsw + 8192), 16, (o1), (int)(soff), 0, 0); } while (0)
#define PG8_LDA(dst, b, h) do { _Pragma("unroll") for (int m = 0; m < 4; ++m) ldfrag(dst[m], lds + PG8_SA(b, h) + aoff + m * 2048); } while (0)
#define PG8_LDB(dst, b, h) do { _Pragma("unroll") for (int n = 0; n < 2; ++n) ldfrag(dst[n], lds + ((b) * 2 + (h)) * HTB + boff + n * 2048); } while (0)
#define PG8_MMA(ai, bj, At, Bt) do { __builtin_amdgcn_s_setprio(1); _Pragma("unroll") for (int m = 0; m < 4; ++m) _Pragma("unroll") for (int n = 0; n < 2; ++n) \
        mma(acc[ai][bj][m][n], Bt[n], At[m]); __builtin_amdgcn_s_setprio(0); } while (0)
#define PG8_WAIT_V(n) asm volatile("s_waitcnt vmcnt(" #n ")" ::: "memory")
#define PG8_WAIT_L(n) asm volatile("s_waitcnt lgkmcnt(" #n ")" ::: "memory")
#define PG8_BAR __builtin_amdgcn_s_barrier()
#define PG8_SCHED __builtin_amdgcn_sched_barrier(0)
#define PG8_ABASE(u) (GATHER ? (unsigned)Cfg::A_OFF : (unsigned)(Cfg::A_OFF + (size_t)((u).pm - pm_bias) * TSTEP))
#define PG8_BBASE(u) ((unsigned)(Cfg::B_OFF + (size_t)(u).e * Cfg::B_E_BYTES + (size_t)(u).pn * TSTEP))
#define PG8_TOKDMA(u, dst) __builtin_amdgcn_raw_ptr_buffer_load_lds(rs, (LAS void*)(dst), 16, (unsigned)lane * 16u, (int)(WS_SLOTTOK + (size_t)(u).pm * 1024), 0, 0)
    Unit cur, nxt; int ui = 0;
    if (!S.next(0, cur)) return;
    if constexpr (GATHER) {
        if (wid == 0) PG8_TOKDMA(cur, tokbuf);
        PG8_WAIT_V(0); PG8_BAR;
#pragma unroll
        for (int h = 0; h < 2; ++h)
#pragma unroll
            for (int i = 0; i < 2; ++i) vaC[h][i] = tok_off((const LAS int*)tokbuf, h, i, Cfg::A_PITCH);
        PG8_WAIT_L(0); PG8_BAR;
    }
    f32x4 acc[2][2][4][2];
#pragma unroll
    for (int a = 0; a < 2; ++a)
#pragma unroll
        for (int b = 0; b < 2; ++b)
#pragma unroll
            for (int m = 0; m < 4; ++m)
#pragma unroll
                for (int n = 0; n < 2; ++n) acc[a][b][m][n] = (f32x4){0.f, 0.f, 0.f, 0.f};
    Frag At[4], B0[2], B1[2];
    unsigned cA = PG8_ABASE(cur);
    unsigned cB = PG8_BBASE(cur);
    PG8_STAGEB(PG8_SB(0, 0), cB); PG8_STAGEB(PG8_SB(0, 1), cB + (unsigned)HSTEP); PG8_STAGEA(PG8_SA(0, 0), cA, vaC[0][0], vaC[0][1]); PG8_STAGEA(PG8_SA(0, 1), cA + (unsigned)AHSTEP, vaC[1][0], vaC[1][1]);
    if (wr == 1) PG8_BAR;
    PG8_WAIT_V(2); PG8_BAR;
    PG8_STAGEB(PG8_SB(1, 0), cB + (unsigned)KSTEP); PG8_STAGEA(PG8_SA(1, 0), cA + (unsigned)KSTEP, vaC[0][0], vaC[0][1]); PG8_STAGEB(PG8_SB(1, 1), cB + (unsigned)(HSTEP + KSTEP));
    PG8_WAIT_V(6); PG8_BAR;
    for (;;) {
        const bool has_next = S.next(ui + 1, nxt);
        const LAS int* tbn = (const LAS int*)(tokbuf + ((ui + 1) & 1) * 1024);
        if constexpr (Epi::PREFETCH) E.prefetch(rs, lds, cur, ui, wid, lane);
        if constexpr (GATHER) {
            if (has_next && wid == 0) PG8_TOKDMA(nxt, tokbuf + ((ui + 1) & 1) * 1024);
        }
#pragma unroll 1
        for (int t = 0; t < NT; t += 2) {
            const bool last = (t == NT - 2);
            const unsigned a1 = cA + (unsigned)(t + 1) * (unsigned)KSTEP;
            unsigned a2 = cA + (unsigned)(t + 2) * (unsigned)KSTEP, b2 = cB + (unsigned)(t + 2) * (unsigned)KSTEP;
            if (last) {
                if (has_next) { a2 = PG8_ABASE(nxt); b2 = PG8_BBASE(nxt);
                    if constexpr (GATHER) { vaC[0][0] = tok_off(tbn, 0, 0, Cfg::A_PITCH); vaC[0][1] = tok_off(tbn, 0, 1, Cfg::A_PITCH); } }
                else { a2 = cA; b2 = cB; }
            }
            const unsigned a3 = a2 + (unsigned)KSTEP, b3 = b2 + (unsigned)KSTEP;
            PG8_LDB(B0, 0, 0); PG8_LDB(B1, 0, 1); PG8_SCHED; PG8_LDA(At, 0, 0); PG8_STAGEA(PG8_SA(1, 1), a1 + (unsigned)AHSTEP, vaC[1][0], vaC[1][1]);
            if constexpr (GATHER) { if (last && has_next) { vaC[1][0] = tok_off(tbn, 1, 0, Cfg::A_PITCH); vaC[1][1] = tok_off(tbn, 1, 1, Cfg::A_PITCH); } }
            PG8_WAIT_V(8); PG8_WAIT_L(0); PG8_BAR; PG8_MMA(0, 0, At, B0); PG8_MMA(0, 1, At, B1); PG8_BAR; PG8_SCHED;
            PG8_LDA(At, 0, 1); PG8_STAGEB(PG8_SB(0, 0), b2); PG8_STAGEB(PG8_SB(0, 1), b2 + (unsigned)HSTEP); PG8_STAGEA(PG8_SA(0, 0), a2, vaC[0][0], vaC[0][1]);
            PG8_WAIT_V(8); PG8_WAIT_L(0); PG8_BAR; PG8_MMA(1, 0, At, B0); PG8_MMA(1, 1, At, B1); PG8_BAR; PG8_SCHED;
            PG8_LDB(B0, 1, 0); PG8_LDB(B1, 1, 1); PG8_SCHED; PG8_LDA(At, 1, 0); PG8_STAGEA(PG8_SA(0, 1), a2 + (unsigned)AHSTEP, vaC[1][0], vaC[1][1]);
            PG8_WAIT_V(8); PG8_WAIT_L(0); PG8_BAR; PG8_MMA(0, 0, At, B0); PG8_MMA(0, 1, At, B1); PG8_BAR; PG8_SCHED;
            PG8_LDA(At, 1, 1); PG8_STAGEB(PG8_SB(1, 0), b3); PG8_STAGEB(PG8_SB(1, 1), b3 + (unsigned)HSTEP); PG8_STAGEA(PG8_SA(1, 0), a3, vaC[0][0], vaC[0][1]);
            PG8_WAIT_V(8); PG8_WAIT_L(0); PG8_BAR; PG8_MMA(1, 0, At, B0); PG8_MMA(1, 1, At, B1); PG8_BAR; PG8_SCHED;
        }
        if (wr == 0) PG8_BAR;
        E(acc, cur, wr, wc, fr, fq, lds, ui);
        if (!has_next) break;
#pragma unroll
        for (int a = 0; a < 2; ++a)
#pragma unroll
            for (int b = 0; b < 2; ++b)
#pragma unroll
                for (int m = 0; m < 4; ++m)
#pragma unroll
                    for (int n = 0; n < 2; ++n) acc[a][b][m][n] = (f32x4){0.f, 0.f, 0.f, 0.f};
        cur = nxt; cA = PG8_ABASE(cur); cB = PG8_BBASE(cur); ++ui;
        if (wr == 1) PG8_BAR;
    }
    PG8_WAIT_V(0);
    PG8_BAR;
#undef PG8_SA
#undef PG8_SB
#undef PG8_STAGEA
#undef PG8_STAGEB
#undef PG8_LDA
#undef PG8_LDB
#undef PG8_MMA
#undef PG8_WAIT_V
#undef PG8_WAIT_L
#undef PG8_BAR
#undef PG8_SCHED
#undef PG8_ABASE
#undef PG8_BBASE
#undef PG8_TOKDMA
}
}

struct EpiInProj {
    static constexpr bool PERM = true, PREFETCH = false;
    DI void operator()(f32x4 (&acc)[2][2][4][2], const pg8::Unit& u, int wr, int wc, int fr, int fq, LAS unsigned char* lds, int ui) const {
        const int pn = u.pn;
        int kind, head, ldc; size_t boff;
        if (pn < 2) { kind = 0; head = 4 * pn + wc; boff = WS_QB; ldc = 512; }
        else if (pn == 2) { if (wc < 2) { kind = 1; head = wc; boff = WS_KB; } else { kind = 2; head = wc - 2; boff = WS_VB; } ldc = 128; }
        else if (pn < 5) { kind = 3; head = 4 * (pn - 3) + wc; boff = WS_GUB; ldc = 512; }
        else { kind = 4; head = 4 * (pn - 5) + wc; boff = WS_GVB; ldc = 512; }
        unsigned char* ws = wsp();
        bf16_t* base = (bf16_t*)(ws + boff);
        const float* b_in = inp<I_BIN>();
        const int src0 = 256 * pn + 64 * wc + 8 * fq;
#pragma unroll
        for (int bj = 0; bj < 2; ++bj)
#pragma unroll
            for (int n = 0; n < 2; ++n) { const f32x4 bv = *(const f32x4*)(b_in + src0 + 32 * bj + 4 * n);
#pragma unroll
                for (int ai = 0; ai < 2; ++ai)
#pragma unroll
                    for (int m = 0; m < 4; ++m) acc[ai][bj][m][n] += bv; }
        const float* rope = (const float*)(ws + WS_ROPE);
        const float* gn_g = inp<I_GNG>(); const float* gn_b = inp<I_GNB>();
        const int row0 = u.pm * 256 + wr * 64 + fr;
#pragma unroll
        for (int ai = 0; ai < 2; ++ai)
#pragma unroll
            for (int m = 0; m < 4; ++m) {
                const int row = row0 + ai * 128 + m * 16;
                f32x4 v[2][2];
#pragma unroll
                for (int bj = 0; bj < 2; ++bj)
#pragma unroll
                    for (int n = 0; n < 2; ++n) v[bj][n] = acc[ai][bj][m][n];
                if (kind <= 1) {
                    const float* cs = rope + (size_t)row * 16;
#pragma unroll
                    for (int n = 0; n < 2; ++n) {
                        const f32x4 c4 = *(const f32x4*)(cs + 4 * n), s4 = *(const f32x4*)(cs + 8 + 4 * n);
                        f32x4 p4; p4[0] = __shfl_xor(v[0][n][0], 16); p4[1] = __shfl_xor(v[0][n][1], 16); p4[2] = __shfl_xor(v[0][n][2], 16); p4[3] = __shfl_xor(v[0][n][3], 16);
                        const f32x4 sg = (fq & 1) ? s4 : -s4;
                        const f32x4 rot = v[0][n] * c4 + p4 * sg;
                        if (fq < 2) v[0][n] = rot;
                    }
                    if (kind == 0) {
#pragma unroll
                        for (int bj = 0; bj < 2; ++bj)
#pragma unroll
                            for (int n = 0; n < 2; ++n) v[bj][n] = v[bj][n] * QSCALE;
                    }
                } else if (kind >= 3) {
#pragma unroll
                    for (int bj = 0; bj < 2; ++bj)
#pragma unroll
                        for (int n = 0; n < 2; ++n) v[bj][n] = gelu4(v[bj][n]);
                    if (kind == 4) {
                        float s = 0.f;
#pragma unroll
                        for (int bj = 0; bj < 2; ++bj)
#pragma unroll
                            for (int n = 0; n < 2; ++n) s += (v[bj][n][0] + v[bj][n][1]) + (v[bj][n][2] + v[bj][n][3]);
                        s += __shfl_xor(s, 16); s += __shfl_xor(s, 32);
                        const float mean = s * (1.0f / 64.0f); float q = 0.f;
#pragma unroll
                        for (int bj = 0; bj < 2; ++bj)
#pragma unroll
                            for (int n = 0; n < 2; ++n) { v[bj][n] = v[bj][n] - mean; const f32x4 d = v[bj][n]; q += (d[0] * d[0] + d[1] * d[1]) + (d[2] * d[2] + d[3] * d[3]); }
                        q += __shfl_xor(q, 16); q += __shfl_xor(q, 32);
                        const float rstd = 1.0f / sqrtf(q * (1.0f / 64.0f) + LN_EPS);
#pragma unroll
                        for (int bj = 0; bj < 2; ++bj)
#pragma unroll
                            for (int n = 0; n < 2; ++n) v[bj][n] = v[bj][n] * rstd * *(const f32x4*)(gn_g + 32 * bj + 8 * fq + 4 * n) + *(const f32x4*)(gn_b + 32 * bj + 8 * fq + 4 * n);
                    }
                }
                bf16_t* rowp = base + (size_t)row * ldc + head * 64 + 8 * fq;
#pragma unroll
                for (int bj = 0; bj < 2; ++bj) { u32x4 w; w.x = cvtpk(v[bj][0][0], v[bj][0][1]); w.y = cvtpk(v[bj][0][2], v[bj][0][3]); w.z = cvtpk(v[bj][1][0], v[bj][1][1]); w.w = cvtpk(v[bj][1][2], v[bj][1][3]);
                    *(u32x4*)(rowp + 32 * bj) = w; }
            }
    }
};
struct EpiOut {
    static constexpr bool PERM = false, PREFETCH = false;
    DI void operator()(f32x4 (&acc)[2][2][4][2], const pg8::Unit& u, int wr, int wc, int fr, int fq, LAS unsigned char* lds, int ui) const {
        const int col0 = u.pn * 256 + wc * 32 + 4 * fq;
        unsigned char* ws = wsp(); float* y1 = outp();
        const float* outc = (const float*)(ws + WS_OUTC); const float* stats0 = (const float*)(ws + WS_STATS0);
        const float* x = inp<I_X>();
        f32x4 ca[2][2];
#pragma unroll
        for (int bj = 0; bj < 2; ++bj)
#pragma unroll
            for (int n = 0; n < 2; ++n) { ca[bj][n] = *(const f32x4*)(outc + col0 + bj * 128 + n * 16); const f32x4 cb = *(const f32x4*)(outc + 1024 + col0 + bj * 128 + n * 16);
#pragma unroll
                for (int ai = 0; ai < 2; ++ai)
#pragma unroll
                    for (int m = 0; m < 4; ++m) acc[ai][bj][m][n] += cb; }
        const int row0 = u.pm * 256 + wr * 64 + fr;
#pragma unroll
        for (int ai = 0; ai < 2; ++ai)
#pragma unroll
            for (int m = 0; m < 4; ++m) {
                const int row = row0 + ai * 128 + m * 16;
                const f32x2 st = *(const f32x2*)(stats0 + (size_t)row * 2);
                const size_t off = (size_t)row * D + col0;
#pragma unroll
                for (int bj = 0; bj < 2; ++bj)
#pragma unroll
                    for (int n = 0; n < 2; ++n) { const f32x4 xv = *(const f32x4*)(x + off + bj * 128 + n * 16);
                        const f32x4 o = acc[ai][bj][m][n] + (xv - st.x) * st.y * ca[bj][n];
                        *(f32x4*)(y1 + off + bj * 128 + n * 16) = o; }
                if (m & 1) asm volatile("" ::: "memory");
            }
    }
};
struct EpiGateUp {
    static constexpr bool PERM = true, PREFETCH = false;
    DI void operator()(f32x4 (&acc)[2][2][4][2], const pg8::Unit& u, int wr, int wc, int fr, int fq, LAS unsigned char* lds, int ui) const {
        const int hcol0 = 128 * u.pn + 32 * wc + 8 * fq;
        const float* bias = inp<I_BGU>() + (size_t)u.e * 2048;
        unsigned char* hmid = wsp() + WS_HMID;
        f32x4 bg[2], bu[2];
#pragma unroll
        for (int n = 0; n < 2; ++n) { bg[n] = *(const f32x4*)(bias + hcol0 + 4 * n); bu[n] = *(const f32x4*)(bias + 1024 + hcol0 + 4 * n); }
        const size_t row0 = (size_t)u.pm * 256 + wr * 64 + fr;
#pragma unroll
        for (int ai = 0; ai < 2; ++ai)
#pragma unroll
            for (int m = 0; m < 4; ++m) {
                float h[2][4];
#pragma unroll
                for (int n = 0; n < 2; ++n) {
                    const f32x4 gt = acc[ai][0][m][n] + bg[n], up = acc[ai][1][m][n] + bu[n];
#pragma unroll
                    for (int j = 0; j < 4; ++j) {
                        const float gc = fminf(gt[j], 7.0f), uc = fminf(fmaxf(up[j], -7.0f), 7.0f);
                        const float sg = __builtin_amdgcn_rcpf(1.0f + __builtin_amdgcn_exp2f(gc * (-1.702f * LOG2E)));
                        h[n][j] = (uc + 1.0f) * (gc * sg);
                    }
                }
                u32x2 w; w.x = cvt4_fp8(h[0][0], h[0][1], h[0][2], h[0][3]); w.y = cvt4_fp8(h[1][0], h[1][1], h[1][2], h[1][3]);
                *(u32x2*)(hmid + (row0 + ai * 128 + m * 16) * 1024 + hcol0) = w;
            }
    }
};
struct EpiDown {
    static constexpr bool PERM = true, PREFETCH = true;
    DI void prefetch(const __amdgpu_buffer_rsrc_t rs, LAS unsigned char* lds, const pg8::Unit& u, int ui, int wid, int lane) const {
        LAS unsigned char* eb = lds + EPIBUF_OFF + (ui & 1) * 2048;
        if (wid == 1) __builtin_amdgcn_raw_ptr_buffer_load_lds(rs, (LAS void*)eb, 16, (unsigned)lane * 16u, (int)(WS_SLOTDEST + (size_t)u.pm * 1024), 0, 0);
        if (wid == 2) __builtin_amdgcn_raw_ptr_buffer_load_lds(rs, (LAS void*)(eb + 1024), 16, (unsigned)lane * 16u, (int)(WS_SLOTGATE + (size_t)u.pm * 1024), 0, 0);
    }
    DI void operator()(f32x4 (&acc)[2][2][4][2], const pg8::Unit& u, int wr, int wc, int fr, int fq, LAS unsigned char* lds, int ui) const {
        const int col0 = 256 * u.pn + 32 * wc + 8 * fq;
        const float* bias = inp<I_BD>() + (size_t)u.e * 1024;
        bf16_t* yslot = (bf16_t*)(wsp() + WS_YSLOT);
        const LAS int* dbuf = (const LAS int*)(lds + EPIBUF_OFF + (ui & 1) * 2048); const LAS float* gbuf = (const LAS float*)(lds + EPIBUF_OFF + (ui & 1) * 2048 + 1024);
        f32x4 bd[2][2];
#pragma unroll
        for (int bj = 0; bj < 2; ++bj)
#pragma unroll
            for (int n = 0; n < 2; ++n) bd[bj][n] = *(const f32x4*)(bias + col0 + 128 * bj + 4 * n);
        int dest[2][4]; float gt[2][4];
#pragma unroll
        for (int ai = 0; ai < 2; ++ai)
#pragma unroll
            for (int m = 0; m < 4; ++m) { const int r = wr * 64 + fr + ai * 128 + m * 16; dest[ai][m] = dbuf[r]; gt[ai][m] = gbuf[r]; }
#pragma unroll
        for (int ai = 0; ai < 2; ++ai)
#pragma unroll
            for (int m = 0; m < 4; ++m) {
                if (dest[ai][m] >= 0) {
                    bf16_t* rowp = yslot + (size_t)dest[ai][m] * 1024 + col0;
#pragma unroll
                    for (int bj = 0; bj < 2; ++bj) { const f32x4 v0 = (acc[ai][bj][m][0] + bd[bj][0]) * gt[ai][m], v1 = (acc[ai][bj][m][1] + bd[bj][1]) * gt[ai][m];
                        u32x4 w; w.x = cvtpk(v0[0], v0[1]); w.y = cvtpk(v0[2], v0[3]); w.z = cvtpk(v1[0], v1[1]); w.w = cvtpk(v1[2], v1[3]);
                        *(u32x4*)(rowp + 128 * bj) = w; }
                }
            }
    }
};

DI int rowmap(int kind, int n) {
    if (kind == 0) { const int pn = n >> 8, ch = n & 255, wc = ch >> 6, bj = (ch >> 5) & 1, w = ch & 31; return (pn << 8) + (bj << 7) + (wc << 5) + w; }
    if (kind == 2) { return n < 1024 ? ((n >> 7) << 8) + (n & 127) : (((n - 1024) >> 7) << 8) + 128 + ((n - 1024) & 127); }
    return n;
}
DI void p0_transpose_item(const float* W, int N, bf16_t* WT, int kind, LAS unsigned char* scr, int item, int lane) {
    const int nblk = N / 64, kb = item / nblk, nb = item % nblk, k0 = 64 * kb, n0 = 64 * nb;
    const int nq = lane >> 2, kr = lane & 3;
    f32x4 a[8], b[8];
#pragma unroll
    for (int i = 0; i < 8; ++i) { const float* p = W + (size_t)(k0 + 8 * i + 2 * kr) * N + n0 + 4 * nq; a[i] = *(const GAS f32x4*)p; b[i] = *(const GAS f32x4*)(p + N); }
#pragma unroll
    for (int i = 0; i < 8; ++i)
#pragma unroll
        for (int c = 0; c < 4; ++c) *(LAS unsigned*)(scr + (4 * nq + c) * 132 + (8 * i + 2 * kr) * 2) = cvtpk(a[i][c], b[i][c]);
    LDS_WAIT(); asm volatile("" ::: "memory");
    const int c8 = lane & 7;
#pragma unroll
    for (int j = 0; j < 8; ++j) { const int n = (lane >> 3) + 8 * j; const LAS unsigned* s = (const LAS unsigned*)(scr + n * 132 + 16 * c8);
        u32x4 o; o.x = s[0]; o.y = s[1]; o.z = s[2]; o.w = s[3];
        *(GAS u32x4*)(WT + (size_t)rowmap(kind, n0 + n) * 1024 + k0 + 8 * c8) = o; }
    LDS_WAIT(); asm volatile("" ::: "memory");
}
DI void p0_transpose_item_q(const float* W, int N, unsigned char* WT, int kind, LAS unsigned char* scr, int item, int lane) {
    const int nblk = N / 32, kb = item / nblk, nb = item % nblk, k0 = 128 * kb, n0 = 32 * nb;
    const int nq = lane >> 3, kr = lane & 7;
#pragma unroll
    for (int i = 0; i < 4; ++i) {
        const float* p = W + (size_t)(k0 + 32 * i + 4 * kr) * N + n0 + 4 * nq;
        const f32x4 a0 = *(const GAS f32x4*)p, a1 = *(const GAS f32x4*)(p + N), a2 = *(const GAS f32x4*)(p + 2 * (size_t)N), a3 = *(const GAS f32x4*)(p + 3 * (size_t)N);
#pragma unroll
        for (int c = 0; c < 4; ++c) *(LAS unsigned*)(scr + (4 * nq + c) * 136 + 32 * i + 4 * kr) = cvt4_fp8(a0[c] * WQ_SCALE, a1[c] * WQ_SCALE, a2[c] * WQ_SCALE, a3[c] * WQ_SCALE);
    }
    LDS_WAIT(); asm volatile("" ::: "memory");
    const int c8 = lane & 7;
#pragma unroll
    for (int j = 0; j < 4; ++j) { const int n = (lane >> 3) + 8 * j; const LAS u32x2* s = (const LAS u32x2*)(scr + n * 136 + 16 * c8);
        const u32x2 x = s[0], y = s[1]; u32x4 o; o.x = x.x; o.y = x.y; o.z = y.x; o.w = y.y;
        *(GAS u32x4*)(WT + (size_t)rowmap(kind, n0 + n) * 1024 + k0 + 16 * c8) = o; }
    LDS_WAIT(); asm volatile("" ::: "memory");
}
DI void p0_prologue(const Frame& F0, LAS unsigned char* lds) {
    const Frame F = opaque(F0);
    unsigned char* ws = wsp();
    LAS unsigned char* scr = lds + F.wave * 16384;
    const int gw = F.bid * NWAVES + F.wave, NGW = G * NWAVES;
    const int gt = F.bid * NTHREADS + F.tid, NGT = G * NTHREADS;
    constexpr int I_IN = (D / 64) * (INW / 64), I_OUT = (D / 64) * (D / 64), I_GU = (D / 128) * (2048 / 32), I_D = (D / 128) * (D / 32);
    constexpr int NITEMS = I_IN + I_OUT + NE * (I_GU + I_D);
    for (int it = gw; it < NITEMS; it += NGW) {
        int r = it;
        if (r < I_IN) { p0_transpose_item(inp<I_WIN>(), INW, (bf16_t*)(ws + WS_WIN), 0, scr, r, F.lane); continue; } r -= I_IN;
        if (r < I_OUT) { p0_transpose_item(inp<I_WOUT>(), D, (bf16_t*)(ws + WS_WOUT), 1, scr, r, F.lane); continue; } r -= I_OUT;
        if (r < NE * I_GU) { const int e = r / I_GU; p0_transpose_item_q(inp<I_WGU>() + (size_t)e * D * 2048, 2048, ws + WS_WGU + (size_t)e * 2048 * D, 2, scr, r % I_GU, F.lane); continue; } r -= NE * I_GU;
        { const int e = r / I_D; p0_transpose_item_q(inp<I_WD>() + (size_t)e * D * D, D, ws + WS_WD + (size_t)e * D * D, 1, scr, r % I_D, F.lane); }
    }
    bf16_t* h0b = (bf16_t*)(ws + WS_H0B); float* stats0 = (float*)(ws + WS_STATS0);
    const float* xin = inp<I_X>(); const float* lg = inp<I_LNING>(); const float* lb = inp<I_LNINB>();
    {
        f32x4 pf[4][4];
#pragma unroll
        for (int u = 0; u < 4; ++u)
#pragma unroll
            for (int j = 0; j < 4; ++j) pf[u][j] = ((const GAS f32x4*)(xin + (size_t)(gw + u * NGW) * D))[F.lane + 64 * j];
        f32x4 gg[4], bb[4];
#pragma unroll
        for (int j = 0; j < 4; ++j) { gg[j] = ((const f32x4*)lg)[F.lane + 64 * j]; bb[j] = ((const f32x4*)lb)[F.lane + 64 * j]; }
#pragma unroll 1
        for (int m0 = gw; m0 < T; m0 += 4 * NGW) {
#pragma unroll
            for (int u = 0; u < 4; ++u) {
                const int m = m0 + u * NGW;
                f32x4 v[4]; float s = 0.f;
#pragma unroll
                for (int j = 0; j < 4; ++j) { v[j] = pf[u][j]; s += (v[j].x + v[j].y) + (v[j].z + v[j].w); }
                { const int mn = (m + 4 * NGW < T) ? m + 4 * NGW : m;
#pragma unroll
                  for (int j = 0; j < 4; ++j) pf[u][j] = ((const GAS f32x4*)(xin + (size_t)mn * D))[F.lane + 64 * j]; }
                const float mean = wave_sum(s) * (1.f / D); float s2 = 0.f;
#pragma unroll
                for (int j = 0; j < 4; ++j) { v[j] = v[j] - mean; s2 += (v[j].x * v[j].x + v[j].y * v[j].y) + (v[j].z * v[j].z + v[j].w * v[j].w); }
                const float rstd = 1.f / sqrtf(wave_sum(s2) * (1.f / D) + LN_EPS);
                GAS u32x2* o8 = (GAS u32x2*)(h0b + (size_t)m * D) + F.lane;
#pragma unroll
                for (int j = 0; j < 4; ++j) { const f32x4 r = v[j] * rstd * gg[j] + bb[j]; u32x2 w; w.x = cvtpk(r.x, r.y); w.y = cvtpk(r.z, r.w); o8[64 * j] = w; }
                if (F.lane == 0) { stats0[2 * m] = mean; stats0[2 * m + 1] = rstd; }
            }
        }
    }
    float* rope = (float*)(ws + WS_ROPE); const int* positions = (const int*)inp<I_POS>();
    for (int i = gt; i < T * 8; i += NGT) {
        const int tok = i >> 3, j = i & 7;
        const float inv = powf(500000.0f, -(float)(2 * j) / 16.0f);
        const float ang = (float)positions[tok] * inv;
        rope[tok * 16 + j] = cosf(ang); rope[tok * 16 + 8 + j] = sinf(ang);
    }
    int* slot_tok = (int*)(ws + WS_SLOTTOK); int* slot_dest = (int*)(ws + WS_SLOTDEST);
    for (int i = gt; i < NSLOT; i += NGT) { slot_tok[i] = -1; slot_dest[i] = -1; }
    float* outc = (float*)(ws + WS_OUTC); const float* bo = inp<I_BOUT>();
    for (int i = gt; i < D; i += NGT) { outc[i] = ALPHA * lg[i]; outc[1024 + i] = bo[i] + ALPHA * lb[i]; }
    bf16_t* wsp = (bf16_t*)(ws + WS_WSP); const float* w_s = inp<I_WS>();
    for (int i = gt; i < 8 * 128 * 128; i += NGT) {
        const int j = i & 7, hi = (i >> 3) & 1, ks = (i >> 4) & 7, t = (i >> 7) & 127, h = i >> 14;
        const int s = 16 * ks + 8 * (j >> 2) + 4 * hi + (j & 3);
        const float w = (s <= t) ? w_s[((size_t)h * 128 + t) * 128 + s] : 0.f;
        wsp[i] = (bf16_t)(cvtpk(w, 0.f) & 0xffffu);
    }
}

#define MFMA32(a, b, c) __builtin_amdgcn_mfma_f32_32x32x16_bf16((a), (b), (c), 0, 0, 0)
DI int crow(int r, int hi) { return (r & 3) + 8 * (r >> 2) + 4 * hi; }
DI bf16x8 cat4(s16x4 lo, s16x4 hi) { return __builtin_shufflevector(lo, hi, 0, 1, 2, 3, 4, 5, 6, 7); }
DI void attn_unit(const Frame& F0, LAS unsigned char* lds, int u) {
    const Frame F = opaque(F0);
    unsigned char* ws = wsp();
    const int b = u >> 6, n = (u >> 1) & 31, kvh = u & 1;
    const int tok0 = b * SEQ + n * 128;
    const bf16_t* Qb = (const bf16_t*)(ws + WS_QB); const bf16_t* Kb = (const bf16_t*)(ws + WS_KB); const bf16_t* Vb = (const bf16_t*)(ws + WS_VB);
    bf16_t* Ob = (bf16_t*)(ws + WS_H0B);
    LAS unsigned char* Kl = lds;
    LAS unsigned char* Vt = lds + 36864;
#pragma unroll
    for (int rep = 0; rep < 4; ++rep) {
        const int c = F.tid + 512 * rep, kw = c >> 3, ch = c & 7;
        int tokk = tok0 - 128 + kw; if (n == 0 && kw < 128) tokk = tok0 + kw;
        const u32x4 kv = *(const u32x4*)(Kb + (size_t)tokk * 128 + kvh * 64 + ch * 8);
        *(LAS u32x4*)(Kl + kw * 144 + ch * 16) = kv;
        const u32x4 vv = *(const u32x4*)(Vb + (size_t)tokk * 128 + kvh * 64 + ch * 8);
        const unsigned wv[4] = {vv.x, vv.y, vv.z, vv.w};
#pragma unroll
        for (int e = 0; e < 8; ++e) { const int d = ch * 8 + e; const unsigned short val = (unsigned short)((e & 1) ? (wv[e >> 1] >> 16) : (wv[e >> 1] & 0xffffu));
            *(LAS unsigned short*)(Vt + d * 512 + ((((kw >> 2) ^ (d & 31))) << 3) + (kw & 3) * 2) = val; }
    }
    __syncthreads();
    const int g = F.wave >> 1, rh = F.wave & 1, hq = kvh * 4 + g;
    const int q = F.lane & 31, hi = F.lane >> 5;
    const float sink2 = inp<I_SINKS>()[hq] * LOG2E;
#pragma unroll 1
    for (int sb = 0; sb < 2; ++sb) {
        const int r0 = rh * 64 + sb * 32, kb0 = r0 >> 5;
        const bf16_t* qp = Qb + (size_t)(tok0 + r0 + q) * 512 + hq * 64 + hi * 8;
        bf16x8 qf[4];
#pragma unroll
        for (int ds = 0; ds < 4; ++ds) qf[ds] = *(const bf16x8*)(qp + ds * 16);
        f32x16 p[5];
#pragma unroll
        for (int kbi = 0; kbi < 5; ++kbi) {
            f32x16 a = {};
#pragma unroll
            for (int ds = 0; ds < 4; ++ds) { const bf16x8 kf = *(const LAS bf16x8*)(Kl + ((kb0 + kbi) * 32 + q) * 144 + (ds * 16 + hi * 8) * 2); a = MFMA32(kf, qf[ds], a); }
            p[kbi] = a;
        }
        const int qi = 128 + r0 + q;
        float mx = sink2;
#pragma unroll
        for (int kbi = 0; kbi < 5; ++kbi)
#pragma unroll
            for (int r = 0; r < 16; ++r) { const int kw = (kb0 + kbi) * 32 + crow(r, hi); const bool ok = (kw <= qi) && (qi - kw < 128) && (n > 0 || kw >= 128);
                const float s = ok ? p[kbi][r] : -1e30f; p[kbi][r] = s; mx = fmaxf(mx, s); }
        mx = fmaxf(mx, __shfl_xor(mx, 32));
        float l = 0.f;
#pragma unroll
        for (int kbi = 0; kbi < 5; ++kbi)
#pragma unroll
            for (int r = 0; r < 16; ++r) { const float e = __builtin_amdgcn_exp2f(p[kbi][r] - mx); p[kbi][r] = e; l += e; }
        l += __shfl_xor(l, 32); l += __builtin_amdgcn_exp2f(sink2 - mx);
        f32x16 o0 = {}, o1 = {};
#pragma unroll
        for (int kbi = 0; kbi < 5; ++kbi)
#pragma unroll
            for (int s2 = 0; s2 < 2; ++s2) {
                u32x4 pw; pw.x = cvtpk(p[kbi][8 * s2 + 0], p[kbi][8 * s2 + 1]); pw.y = cvtpk(p[kbi][8 * s2 + 2], p[kbi][8 * s2 + 3]);
                pw.z = cvtpk(p[kbi][8 * s2 + 4], p[kbi][8 * s2 + 5]); pw.w = cvtpk(p[kbi][8 * s2 + 6], p[kbi][8 * s2 + 7]);
                const bf16x8 pa = __builtin_bit_cast(bf16x8, pw);
                const int kc = ((kb0 + kbi) * 32 + 16 * s2 + 4 * hi) >> 2;
                { const int d = q; const s16x4 lo = *(const LAS s16x4*)(Vt + d * 512 + ((kc ^ (d & 31)) << 3)), hh = *(const LAS s16x4*)(Vt + d * 512 + (((kc + 2) ^ (d & 31)) << 3)); o0 = MFMA32(cat4(lo, hh), pa, o0); }
                { const int d = 32 + q; const s16x4 lo = *(const LAS s16x4*)(Vt + d * 512 + ((kc ^ (d & 31)) << 3)), hh = *(const LAS s16x4*)(Vt + d * 512 + (((kc + 2) ^ (d & 31)) << 3)); o1 = MFMA32(cat4(lo, hh), pa, o1); }
            }
        const float rl = __builtin_amdgcn_rcpf(l);
        bf16_t* op = Ob + (size_t)(tok0 + r0 + q) * D + hq * 64 + 4 * hi;
#pragma unroll
        for (int g4 = 0; g4 < 4; ++g4) {
            u32x2 w0, w1; w0.x = cvtpk(o0[4 * g4] * rl, o0[4 * g4 + 1] * rl); w0.y = cvtpk(o0[4 * g4 + 2] * rl, o0[4 * g4 + 3] * rl);
            w1.x = cvtpk(o1[4 * g4] * rl, o1[4 * g4 + 1] * rl); w1.y = cvtpk(o1[4 * g4 + 2] * rl, o1[4 * g4 + 3] * rl);
            *(u32x2*)(op + 8 * g4) = w0; *(u32x2*)(op + 32 + 8 * g4) = w1;
        }
    }
    __syncthreads();
}
DI void gmlp_unit(const Frame& F0, LAS unsigned char* lds, int chunk) {
    const Frame F = opaque(F0);
    unsigned char* ws = wsp();
    const int h = F.wave, tok0 = chunk * 128;
    const bf16_t* GUb = (const bf16_t*)(ws + WS_GUB); const bf16_t* GVb = (const bf16_t*)(ws + WS_GVB); const bf16_t* wsp = (const bf16_t*)(ws + WS_WSP);
    bf16_t* Ob = (bf16_t*)(ws + WS_H0B);
    LAS unsigned char* Vt = lds + F.wave * 16384;
#pragma unroll 4
    for (int rep = 0; rep < 16; ++rep) {
        const int c = F.lane + 64 * rep, s = c >> 3, ch = c & 7;
        const u32x4 vv = *(const u32x4*)(GVb + (size_t)(tok0 + s) * 512 + h * 64 + ch * 8);
        const unsigned wv[4] = {vv.x, vv.y, vv.z, vv.w};
#pragma unroll
        for (int e = 0; e < 8; ++e) { const int d = ch * 8 + e; const unsigned short val = (unsigned short)((e & 1) ? (wv[e >> 1] >> 16) : (wv[e >> 1] & 0xffffu));
            *(LAS unsigned short*)(Vt + d * 256 + (((s >> 2) ^ (d & 31)) << 3) + (s & 3) * 2) = val; }
    }
    LDS_WAIT();
    const int q = F.lane & 31, hi = F.lane >> 5;
    const float* b_s = inp<I_BS>();
#pragma unroll 1
    for (int tb = 0; tb < 4; ++tb) {
        f32x16 a0 = {}, a1 = {};
        const int t = tb * 32 + q;
        const bf16_t* gp = GUb + (size_t)(tok0 + t) * 512 + h * 64 + 4 * hi;
        u32x2 gu0[4], gu1[4];
#pragma unroll
        for (int g4 = 0; g4 < 4; ++g4) { gu0[g4] = *(const u32x2*)(gp + 8 * g4); gu1[g4] = *(const u32x2*)(gp + 32 + 8 * g4); }
        const float bias = b_s[h * 128 + t];
        const bf16_t* wp = wsp + ((size_t)(h * 128 + t) * 8) * 16 + hi * 8;
        for (int ks = 0; ks < 2 * tb + 2; ++ks) {
            const bf16x8 wa = *(const bf16x8*)(wp + ks * 16);
            const int kc = (16 * ks + 4 * hi) >> 2;
            { const int d = q; const s16x4 lo = *(const LAS s16x4*)(Vt + d * 256 + ((kc ^ (d & 31)) << 3)), hh = *(const LAS s16x4*)(Vt + d * 256 + (((kc + 2) ^ (d & 31)) << 3)); a0 = MFMA32(cat4(lo, hh), wa, a0); }
            { const int d = 32 + q; const s16x4 lo = *(const LAS s16x4*)(Vt + d * 256 + ((kc ^ (d & 31)) << 3)), hh = *(const LAS s16x4*)(Vt + d * 256 + (((kc + 2) ^ (d & 31)) << 3)); a1 = MFMA32(cat4(lo, hh), wa, a1); }
        }
        bf16_t* op = Ob + (size_t)(tok0 + t) * D + 512 + h * 64 + 4 * hi;
#pragma unroll
        for (int g4 = 0; g4 < 4; ++g4) {
            u32x2 w0, w1;
            w0.x = cvtpk(bflo(gu0[g4].x) * (a0[4 * g4] + bias), bfhi(gu0[g4].x) * (a0[4 * g4 + 1] + bias)); w0.y = cvtpk(bflo(gu0[g4].y) * (a0[4 * g4 + 2] + bias), bfhi(gu0[g4].y) * (a0[4 * g4 + 3] + bias));
            w1.x = cvtpk(bflo(gu1[g4].x) * (a1[4 * g4] + bias), bfhi(gu1[g4].x) * (a1[4 * g4 + 1] + bias)); w1.y = cvtpk(bflo(gu1[g4].y) * (a1[4 * g4 + 2] + bias), bfhi(gu1[g4].y) * (a1[4 * g4 + 3] + bias));
            *(u32x2*)(op + 8 * g4) = w0; *(u32x2*)(op + 32 + 8 * g4) = w1;
        }
    }
    LDS_WAIT();
}

DI void p4_router(const Frame& F0, LAS unsigned char* lds) {
    const Frame F = opaque(F0);
    unsigned char* ws = wsp(); float* out = outp();
    LAS unsigned char* Whi = lds;
    LAS unsigned char* Wlo = lds + 65536;
    LAS int* cnt = (LAS int*)(lds + MISC_OFF + 256);
    { const float* w_router = inp<I_WR>();
      for (int i = F.tid; i < D * NE; i += NTHREADS) { const int c = i >> 5, e = i & 31; const float w = w_router[i];
          const unsigned h = cvtpk(w, 0.f) & 0xffffu; const unsigned l = cvtpk(w - __uint_as_float(h << 16), 0.f) & 0xffffu;
          const int off = e * 2048 + (((c >> 3) ^ (e & 15)) << 4) + (c & 7) * 2;
          *(LAS unsigned short*)(Whi + off) = (unsigned short)h; *(LAS unsigned short*)(Wlo + off) = (unsigned short)l; } }
    if (F.tid < 32) cnt[F.tid] = 0;
    __syncthreads();
    constexpr int R = T / G, rpw = R / NWAVES;
    static_assert(rpw == 32, "one 32-token MFMA block per wave");
    int* tok_e = (int*)(ws + WS_TOKE); float* tok_g = (float*)(ws + WS_TOKG); int* tok_l = (int*)(ws + WS_TOKL);
    const int lane = F.lane;
    const int tokb = F.bid * R + F.wave * rpw;
    {
        f32x4 g1[4], b1[4];
#pragma unroll
        for (int j = 0; j < 4; ++j) { g1[j] = ((const f32x4*)inp<I_LN1G>())[lane + 64 * j]; b1[j] = ((const f32x4*)inp<I_LN1B>())[lane + 64 * j]; }
        f32x4 pf[4][4];
#pragma unroll
        for (int u = 0; u < 4; ++u)
#pragma unroll
            for (int j = 0; j < 4; ++j) pf[u][j] = ((const GAS f32x4*)(out + (size_t)(tokb + u) * D))[lane + 64 * j];
#pragma unroll 1
        for (int i = 0; i < rpw; i += 4) {
#pragma unroll
            for (int u = 0; u < 4; ++u) {
                const int tok = tokb + i + u;
                f32x4 v[4];
#pragma unroll
                for (int j = 0; j < 4; ++j) v[j] = pf[u][j];
                { const int tn = (i + u + 4 < rpw) ? tok + 4 : tok;
#pragma unroll
                  for (int j = 0; j < 4; ++j) pf[u][j] = ((const GAS f32x4*)(out + (size_t)tn * D))[lane + 64 * j]; }
                float s = 0.f;
#pragma unroll
                for (int j = 0; j < 4; ++j) s += (v[j].x + v[j].y) + (v[j].z + v[j].w);
                const float mean = wave_sum(s) * (1.f / D); float s2 = 0.f;
#pragma unroll
                for (int j = 0; j < 4; ++j) { v[j] = v[j] - mean; s2 += (v[j].x * v[j].x + v[j].y * v[j].y) + (v[j].z * v[j].z + v[j].w * v[j].w); }
                const float rstd = 1.f / sqrtf(wave_sum(s2) * (1.f / D) + LN_EPS);
                float* rowp = out + (size_t)tok * D;
                GAS u32x2* hp = (GAS u32x2*)rowp + lane; GAS u32x2* lp = (GAS u32x2*)(rowp + 512) + lane;
#pragma unroll
                for (int j = 0; j < 4; ++j) {
                    v[j] = v[j] * rstd * g1[j] + b1[j];
                    u32x2 wh; wh.x = cvtpk(v[j].x, v[j].y); wh.y = cvtpk(v[j].z, v[j].w);
                    u32x2 wl; wl.x = cvtpk(v[j].x - bflo(wh.x), v[j].y - bfhi(wh.x)); wl.y = cvtpk(v[j].z - bflo(wh.y), v[j].w - bfhi(wh.y));
                    hp[64 * j] = wh; lp[64 * j] = wl;
                    ((GAS unsigned*)(ws + WS_H1Q + (size_t)tok * 1024))[lane + 64 * j] = cvt4_fp8(v[j].x, v[j].y, v[j].z, v[j].w);
                }
            }
        }
    }
    VM_WAIT();
    __builtin_amdgcn_fence(__ATOMIC_ACQUIRE, "agent");
    VM_WAIT();
    const int q = lane & 31, hi = lane >> 5;
    f32x16 acc = {};
    {
        const unsigned char* hrow = (const unsigned char*)(out + (size_t)(tokb + q) * D) + hi * 16;
        const int wbase = q * 2048;
#pragma unroll 4
        for (int s = 0; s < 64; ++s) {
            const bf16x8 bh = *(const GAS bf16x8*)(hrow + 32 * s), bl = *(const GAS bf16x8*)(hrow + 2048 + 32 * s);
            const int off = wbase + (((2 * s + hi) ^ (q & 15)) << 4);
            const bf16x8 wh = *(const LAS bf16x8*)(Whi + off), wl = *(const LAS bf16x8*)(Wlo + off);
            acc = MFMA32(wh, bh, acc); acc = MFMA32(wl, bh, acc); acc = MFMA32(wh, bl, acc);
        }
    }
    const float* b_router = inp<I_BR>();
    float lg[16];
#pragma unroll
    for (int r = 0; r < 16; ++r) lg[r] = acc[r] + b_router[crow(r, hi)];
    float ov[4]; int oi[4];
#pragma unroll
    for (int k = 0; k < 4; ++k) {
        float best = -INFINITY; int bi = 64;
#pragma unroll
        for (int r = 0; r < 16; ++r) { const bool gt = lg[r] > best; best = gt ? lg[r] : best; bi = gt ? crow(r, hi) : bi; }
#pragma unroll
        for (int r = 0; r < 16; ++r) lg[r] = (crow(r, hi) == bi) ? -INFINITY : lg[r];
        ov[k] = best; oi[k] = bi;
    }
    float cv[8]; int ci[8];
#pragma unroll
    for (int k = 0; k < 4; ++k) { cv[k] = ov[k]; ci[k] = oi[k]; cv[4 + k] = partnerf<5>(ov[k], lane); ci[4 + k] = partneri<5>(oi[k], lane); }
    float tv[4]; int ti[4];
#pragma unroll
    for (int k = 0; k < 4; ++k) {
        float best = -INFINITY; int bi = 64;
#pragma unroll
        for (int c = 0; c < 8; ++c) { const bool gt = cv[c] > best || (cv[c] == best && ci[c] < bi); best = gt ? cv[c] : best; bi = gt ? ci[c] : bi; }
#pragma unroll
        for (int c = 0; c < 8; ++c) cv[c] = (ci[c] == bi) ? -INFINITY : cv[c];
        tv[k] = best; ti[k] = bi;
    }
    if (hi == 0) {
        const float e1 = __expf(tv[1] - tv[0]), e2 = __expf(tv[2] - tv[0]), e3 = __expf(tv[3] - tv[0]);
        const float inv = 1.0f / (1.0f + e1 + e2 + e3);
        const int tok = tokb + q;
        int lp4[4];
#pragma unroll
        for (int k = 0; k < 4; ++k) lp4[k] = atomicAdd((int*)(cnt + ti[k]), 1);
        *(int4*)(tok_e + tok * 4) = make_int4(ti[0], ti[1], ti[2], ti[3]);
        *(float4*)(tok_g + tok * 4) = make_float4(inv, e1 * inv, e2 * inv, e3 * inv);
        *(int4*)(tok_l + tok * 4) = make_int4(lp4[0], lp4[1], lp4[2], lp4[3]);
    }
    __syncthreads();
    if (F.tid < 32) ((int*)(ws + WS_WGCOUNT))[F.bid * 32 + F.tid] = cnt[F.tid];
}
DI int p4b_lists(const Frame& F0, LAS unsigned char* lds) {
    const Frame F = opaque(F0);
    unsigned char* ws = wsp();
    LAS int* tab = (LAS int*)lds;
    LAS int* pstart = (LAS int*)(lds + MISC_OFF + 256);
    LAS int* mybase = pstart + 64;
    const int* wgc = (const int*)(ws + WS_WGCOUNT);
    for (int i = F.tid; i < G * 32; i += NTHREADS) tab[i] = (int)__hip_atomic_load((unsigned*)wgc + i, __ATOMIC_RELAXED, __HIP_MEMORY_SCOPE_AGENT);
    __syncthreads();
    if (F.tid < 32) { int tot = 0, mb = 0; for (int w = 0; w < G; ++w) { const int c = tab[w * 32 + F.tid]; if (w < F.bid) mb += c; tot += c; } mybase[F.tid] = mb; pstart[32 + 32 + 32 + F.tid] = tot; }
    __syncthreads();
    if (F.tid == 0) { int off = 0; for (int e = 0; e < 32; ++e) { pstart[e] = off; off += ((pstart[96 + e] + 255) >> 8) << 8; } pstart[32] = off; }
    __syncthreads();
    const int ngroups = pstart[32] >> 8;
    if (F.bid == 0) {
        int* grp_e = (int*)(ws + WS_GRPE);
        for (int g = F.tid; g < NGRP_MAX; g += NTHREADS) { int e = 0; for (int k = 1; k < 32; ++k) if (pstart[k] <= g * 256) e = k; grp_e[g] = (g < ngroups) ? e : 0; }
    }
    const int R = T / G;
    const int* tok_e = (const int*)(ws + WS_TOKE); const float* tok_g = (const float*)(ws + WS_TOKG); const int* tok_l = (const int*)(ws + WS_TOKL);
    int* slot_tok = (int*)(ws + WS_SLOTTOK); float* slot_gate = (float*)(ws + WS_SLOTGATE); int* slot_dest = (int*)(ws + WS_SLOTDEST);
    for (int i = F.tid; i < R * 4; i += NTHREADS) {
        const int idx = F.bid * R * 4 + i; const int e = tok_e[idx];
        const int slot = pstart[e] + mybase[e] + tok_l[idx];
        slot_tok[slot] = idx >> 2; slot_gate[slot] = tok_g[idx]; slot_dest[slot] = idx;
    }
    return ngroups;
}
DI void p7_final(const Frame& F0) {
    const Frame F = opaque(F0);
    unsigned char* ws = wsp(); float* out = outp();
    const bf16_t* yslot = (const bf16_t*)(ws + WS_YSLOT);
    const int gw = F.bid * NWAVES + F.wave, NGW = G * NWAVES, lane = F.lane;
    const float* ln2_g = inp<I_LN2G>(); const float* ln2_b = inp<I_LN2B>();
    for (int tok = gw; tok < T; tok += NGW) {
        float* rowp = out + (size_t)tok * D;
        f32x4 v[4];
#pragma unroll
        for (int j = 0; j < 4; ++j) {
            const u32x2 wh = ((const GAS u32x2*)rowp)[lane + 64 * j];
            v[j] = (f32x4){bflo(wh.x), bfhi(wh.x), bflo(wh.y), bfhi(wh.y)} * ALPHA;
        }
#pragma unroll
        for (int k = 0; k < 4; ++k) {
            const GAS u32x2* yp = (const GAS u32x2*)(yslot + ((size_t)tok * 4 + k) * 1024) + lane;
#pragma unroll
            for (int j = 0; j < 4; ++j) { const u32x2 w = yp[64 * j]; v[j] = v[j] + (f32x4){bflo(w.x), bfhi(w.x), bflo(w.y), bfhi(w.y)}; }
        }
        float s = 0.f;
#pragma unroll
        for (int j = 0; j < 4; ++j) s += (v[j].x + v[j].y) + (v[j].z + v[j].w);
        const float mean = wave_sum(s) * (1.f / D); float s2 = 0.f;
#pragma unroll
        for (int j = 0; j < 4; ++j) { v[j] = v[j] - mean; s2 += (v[j].x * v[j].x + v[j].y * v[j].y) + (v[j].z * v[j].z + v[j].w * v[j].w); }
        const float rstd = 1.f / sqrtf(wave_sum(s2) * (1.f / D) + LN_EPS);
#pragma unroll
        for (int j = 0; j < 4; ++j) { const f32x4 gg = ((const f32x4*)ln2_g)[lane + 64 * j], bb = ((const f32x4*)ln2_b)[lane + 64 * j];
            ((GAS f32x4*)rowp)[lane + 64 * j] = v[j] * rstd * gg + bb; }
    }
}

struct CfgIn   { static constexpr bool FP8 = false, GATHER = false; static constexpr size_t A_OFF = WS_H0B,  B_OFF = WS_WIN,  B_E_BYTES = 0; static constexpr unsigned A_PITCH = 0; };
struct CfgOut  { static constexpr bool FP8 = false, GATHER = false; static constexpr size_t A_OFF = WS_H0B,  B_OFF = WS_WOUT, B_E_BYTES = 0; static constexpr unsigned A_PITCH = 0; };
struct CfgGU   { static constexpr bool FP8 = true,  GATHER = true;  static constexpr size_t A_OFF = WS_H1Q,  B_OFF = WS_WGU,  B_E_BYTES = (size_t)2048 * D; static constexpr unsigned A_PITCH = 1024u; };
struct CfgDown { static constexpr bool FP8 = true,  GATHER = false; static constexpr size_t A_OFF = WS_HMID, B_OFF = WS_WD,   B_E_BYTES = (size_t)D * D; static constexpr unsigned A_PITCH = 0; };
#ifndef PHASE_MASK
#define PHASE_MASK 0xFFFF
#endif
struct Args { const void* in[23]; float* out; unsigned char* ws; };
__global__ void __launch_bounds__(NTHREADS, 2) mk_fwd(Args args) {
    __shared__ __attribute__((aligned(16))) unsigned char lds_raw[LDS_BYTES];
    LAS unsigned char* lds = (LAS unsigned char*)lds_raw;
    Frame F;
    F.tid = threadIdx.x; F.lane = F.tid & 63; F.wave = __builtin_amdgcn_readfirstlane(F.tid >> 6); F.bid = blockIdx.x;
    volatile LAS unsigned* MISC = (volatile LAS unsigned*)(lds + MISC_OFF);
    if (F.tid < 64) MISC[F.tid] = 0u;
    __syncthreads();
    xcd_barrier_post((unsigned*)(wsp() + WS_CTL) + CW_BAR);
    volatile LAS unsigned* bst = MISC + 8;
#ifdef PROBE_A
    int n_stamp = 0;
#define STAMP() do { if (F.bid == 0 && F.tid == 0) { __hip_atomic_store((unsigned long long*)(wsp() + WS_CTL + 32768) + n_stamp, (unsigned long long)__builtin_amdgcn_s_memrealtime(), __ATOMIC_RELAXED, __HIP_MEMORY_SCOPE_AGENT); } ++n_stamp; } while (0)
#else
#define STAMP() do {} while (0)
#endif
    STAMP();
    LAS unsigned char* tokbuf = lds + TOKBUF_OFF;

    if (PHASE_MASK & 1) p0_prologue(F, lds);
    xcd_barrier(bst); STAMP();
    if (PHASE_MASK & 2) { pg8::StaticOrder<T, INW> S{F.bid}; EpiInProj E; pg8::gemm_phase<CfgIn>(lds, tokbuf, 0, S, E); }
    xcd_barrier(bst); STAMP();
    if (PHASE_MASK & 4) for (int u = F.bid; u < NBATCH * 32 * 2; u += G) attn_unit(F, lds, u);
    if (PHASE_MASK & 8) for (int c = F.bid; c < T / 128; c += G) gmlp_unit(F, lds, c);
    xcd_barrier(bst); STAMP();
    if (PHASE_MASK & 16) { pg8::StaticOrder<T, D> S{F.bid}; EpiOut E; pg8::gemm_phase<CfgOut>(lds, tokbuf, 0, S, E); }
    xcd_barrier(bst); STAMP();
    if (PHASE_MASK & 32) p4_router(F, lds);
    xcd_barrier(bst); STAMP();
    int ngroups = 1040; if (PHASE_MASK & 64) ngroups = p4b_lists(F, lds);
    xcd_barrier(bst); STAMP();
    if (PHASE_MASK & 128) { pg8::GroupOrder<8> S{0, ngroups, F.bid}; EpiGateUp E; pg8::gemm_phase<CfgGU>(lds, tokbuf, 0, S, E); }
    xcd_barrier(bst); STAMP();
    if (PHASE_MASK & 256) { pg8::GroupOrder<4> S{0, ngroups, F.bid}; EpiDown E; pg8::gemm_phase<CfgDown>(lds, tokbuf, 0, S, E); }
    xcd_barrier(bst); STAMP();
    if (PHASE_MASK & 512) p7_final(F);
#ifdef PROBE_A
    STAMP();
    if (F.bid == 0 && F.tid == 0) {
        unsigned long long* ts = (unsigned long long*)(wsp() + WS_CTL + 32768);
        unsigned long long extra = 0ull;
        for (int k = 1; k < 12; ++k) if ((PROBE_A >> k) & 1) extra += __hip_atomic_load(ts + k, __ATOMIC_RELAXED, __HIP_MEMORY_SCOPE_AGENT) - __hip_atomic_load(ts + k - 1, __ATOMIC_RELAXED, __HIP_MEMORY_SCOPE_AGENT);
        const unsigned long long t0 = __builtin_amdgcn_s_memrealtime();
        while (__builtin_amdgcn_s_memrealtime() - t0 < extra) __builtin_amdgcn_s_sleep(8);
    }
#endif
}

extern "C" void kernel_launch(void* const* d_in, const int* in_sizes, int n_in, void* d_out, int out_size, void* d_ws, size_t ws_size, hipStream_t stream) {
    static int grid = 0;
    if (grid == 0) {
        if (n_in != 23 || in_sizes[0] != T * D || out_size != T * D || ws_size < WS_END) {
            fprintf(stderr, "kernel_launch: unexpected shapes/workspace (n_in %d, in0 %d, out %d, ws %zu, need %zu); nothing launched\n", n_in, n_in > 0 ? in_sizes[0] : -1, out_size, ws_size, (size_t)WS_END);
            grid = -1; return;
        }
        int dev = 0, cus = 0, per_cu = 0;
        if (hipGetDevice(&dev) != hipSuccess || hipDeviceGetAttribute(&cus, hipDeviceAttributeMultiprocessorCount, dev) != hipSuccess) { grid = -1; return; }
        if (hipOccupancyMaxActiveBlocksPerMultiprocessor(&per_cu, (const void*)mk_fwd, NTHREADS, 0) != hipSuccess || per_cu < 1) {
            fprintf(stderr, "kernel_launch: occupancy query says %d blocks per CU; nothing launched\n", per_cu); (void)hipGetLastError(); grid = -1; return;
        }
        grid = cus;
        if (grid != G) { fprintf(stderr, "kernel_launch: built for a 256-CU device, found %d; nothing launched\n", cus); grid = -1; return; }
    }
    if (grid < 0) return;
    if (hipMemsetAsync((char*)d_ws + WS_CTL, 0, CTL_ZERO_BYTES, stream) != hipSuccess) return;
    Args a{};
    for (int i = 0; i < 23; ++i) a.in[i] = d_in[i];
    a.out = (float*)d_out; a.ws = (unsigned char*)d_ws;
    hipLaunchKernelGGL(mk_fwd, dim3(grid), dim3(NTHREADS), 0, stream, a);
}
```

```cpp
#include <hip/hip_runtime.h>
#include <cstdio>
#include <cstdint>
#include <type_traits>

#define DI __device__ __forceinline__
#define LAS __attribute__((address_space(3)))
#define GAS __attribute__((address_space(1)))
typedef unsigned short bf16_t;
typedef short bf16x8 __attribute__((ext_vector_type(8)));
typedef short s16x4 __attribute__((ext_vector_type(4)));
typedef float f32x2 __attribute__((ext_vector_type(2)));
typedef float f32x4 __attribute__((ext_vector_type(4)));
typedef float f32x16 __attribute__((ext_vector_type(16)));
typedef unsigned u32x2 __attribute__((ext_vector_type(2)));
typedef unsigned u32x4 __attribute__((ext_vector_type(4)));
typedef __bf16 bf16x2_t __attribute__((ext_vector_type(2)));
typedef GAS unsigned gu32;
typedef int v8i __attribute__((ext_vector_type(8)));

constexpr int D = 1024, SEQ = 4096, NBATCH = 16, T = NBATCH * SEQ;
constexpr int INW = 1792, NE = 32;
constexpr int NSLOT = T * 4 + NE * 256;
constexpr int NGRP_MAX = NSLOT / 256;
constexpr float LN_EPS = 1e-5f;
constexpr float ALPHA = 1.189207115002721f;
constexpr float LOG2E = 1.4426950408889634f;
constexpr float QSCALE = 0.125f * LOG2E;
constexpr float WQ_SCALE = 64.0f;
constexpr int WQ_E8M0 = 127 - 6;
constexpr int NWAVES = 8, NTHREADS = 512;

constexpr size_t MiB = 1u << 20;
constexpr size_t WS_CTL = 0, CTL_ZERO_BYTES = 65536;
constexpr size_t WS_WGCOUNT = 1 * MiB;
constexpr size_t WS_GRPE = 1 * MiB + 65536;
constexpr size_t WS_OUTC = 1 * MiB + 131072;
constexpr size_t WS_WIN = 2 * MiB;
constexpr size_t WS_WOUT = 6 * MiB;
constexpr size_t WS_WSP = 8 * MiB;
constexpr size_t WS_STATS0 = 9 * MiB;
constexpr size_t WS_ROPE = 10 * MiB;
constexpr size_t WS_WGU = 16 * MiB;
constexpr size_t WS_WD = 80 * MiB;
constexpr size_t WS_H1Q = 112 * MiB;
constexpr size_t WS_TOKE = 208 * MiB;
constexpr size_t WS_TOKG = 209 * MiB;
constexpr size_t WS_TOKL = 210 * MiB;
constexpr size_t WS_SLOTTOK = 211 * MiB;
constexpr size_t WS_SLOTGATE = 212 * MiB + 512 * 1024;
constexpr size_t WS_SLOTDEST = 214 * MiB;
constexpr size_t WS_H0B = 216 * MiB;
constexpr size_t WS_QB = 344 * MiB;
constexpr size_t WS_KB = 408 * MiB;
constexpr size_t WS_VB = 424 * MiB;
constexpr size_t WS_GUB = 440 * MiB;
constexpr size_t WS_GVB = 504 * MiB;
constexpr size_t WS_YSLOT = 216 * MiB;
constexpr size_t WS_HMID = 728 * MiB;
constexpr size_t WS_END = 1024 * MiB;
static_assert(WS_HMID + (size_t)NSLOT * 1024 <= WS_END && WS_H1Q + (size_t)T * 1024 <= 208 * MiB, "ws map");
static_assert(WS_YSLOT + (size_t)T * 4 * 1024 * 2 <= WS_HMID, "ws map");
constexpr int CW_BAR = 4096;

constexpr int RING_BYTES = 131072;
constexpr int MISC_OFF = RING_BYTES;
constexpr int TOKBUF_OFF = MISC_OFF + 1024;
constexpr int EPIBUF_OFF = MISC_OFF + 4096;
constexpr int LDS_BYTES = 147456;

DI unsigned cvtpk(float lo, float hi) { f32x2 v = {lo, hi}; bf16x2_t b = __builtin_convertvector(v, bf16x2_t); return __builtin_bit_cast(unsigned, b); }
DI unsigned cvt4_fp8(float a, float b, float c, float d) { int p = __builtin_amdgcn_cvt_pk_fp8_f32(a, b, 0, false); p = __builtin_amdgcn_cvt_pk_fp8_f32(c, d, p, true); return (unsigned)p; }
DI float bf2f(unsigned short h) { return __uint_as_float((unsigned)h << 16); }
DI float bflo(unsigned w) { return __uint_as_float(w << 16); }
DI float bfhi(unsigned w) { return __uint_as_float(w & 0xffff0000u); }
template <int CTRL> DI float dppf(float v) { return __builtin_bit_cast(float, __builtin_amdgcn_update_dpp(0, __builtin_bit_cast(int, v), CTRL, 0xf, 0xf, false)); }
DI void swap32(float& a, float& b) { asm("s_nop 1\n\tv_permlane32_swap_b32 %0, %1" : "+v"(a), "+v"(b)); }
DI void swap16(float& a, float& b) { asm("s_nop 1\n\tv_permlane16_swap_b32 %0, %1" : "+v"(a), "+v"(b)); }
template <int CTRL> DI int dppi(int v) { return __builtin_amdgcn_update_dpp(0, v, CTRL, 0xf, 0xf, false); }
constexpr int DPP_XOR1 = 0xB1, DPP_XOR2 = 0x4E, DPP_HMIRROR = 0x141, DPP_MIRROR = 0x140;
template <int LV> DI float partnerf(float v, int lane) {
    if constexpr (LV == 0) return dppf<DPP_XOR1>(v);
    else if constexpr (LV == 1) return dppf<DPP_XOR2>(v);
    else if constexpr (LV == 2) return dppf<DPP_HMIRROR>(v);
    else if constexpr (LV == 3) return dppf<DPP_MIRROR>(v);
    else if constexpr (LV == 4) { float a = v, b = v; swap16(a, b); return (lane & 16) ? a : b; }
    else { float a = v, b = v; swap32(a, b); return (lane & 32) ? a : b; }
}
template <int LV> DI int partneri(int v, int lane) { return __builtin_bit_cast(int, partnerf<LV>(__builtin_bit_cast(float, v), lane)); }
DI float wave_sum(float v) {
    v += dppf<DPP_XOR1>(v); v += dppf<DPP_XOR2>(v); v += dppf<DPP_HMIRROR>(v); v += dppf<DPP_MIRROR>(v);
    { float a = v, b = v; swap16(a, b); v = a + b; }
    { float a = v, b = v; swap32(a, b); v = a + b; }
    return v;
}
#define LDS_WAIT() asm volatile("s_waitcnt lgkmcnt(0)" ::: "memory")
#define VM_WAIT() asm volatile("s_waitcnt vmcnt(0)" ::: "memory")

DI f32x2 gelu_pk(f32x2 v) {
    const f32x2 av = __builtin_elementwise_abs(v), d = av * 0.2316418882f + 1.0f;
    f32x2 t; t.x = __builtin_amdgcn_rcpf(d.x); t.y = __builtin_amdgcn_rcpf(d.y);
    f32x2 q = t * 0.5307027145f + (-0.7265760135f); q = q * t + 0.7107068705f; q = q * t + (-0.142248368f); q = q * t + 0.127414796f; q = q * t;
    const f32x2 s = (v * v) * (-0.72134752044f);
    f32x2 e; e.x = __builtin_amdgcn_exp2f(s.x); e.y = __builtin_amdgcn_exp2f(s.y);
    const f32x2 m = v * (q * e), r = v - m;
    f32x2 o; o.x = v.x < 0.f ? m.x : r.x; o.y = v.y < 0.f ? m.y : r.y; return o;
}
DI f32x4 gelu4(f32x4 v) { f32x2 a = gelu_pk((f32x2){v[0], v[1]}), b = gelu_pk((f32x2){v[2], v[3]}); return (f32x4){a.x, a.y, b.x, b.y}; }


struct Frame { int tid, lane, wave, bid; };
DI Frame opaque(const Frame& f) { Frame r; r.tid = threadIdx.x; asm volatile("" : "+v"(r.tid)); r.lane = r.tid & 63; r.wave = __builtin_amdgcn_readfirstlane(r.tid >> 6); r.bid = f.bid; return r; }
constexpr int G = 256;
template <int K> DI const float* inp() { const float* p; asm volatile("s_load_dwordx2 %0, %1, %2\n\ts_waitcnt lgkmcnt(0)" : "=s"(p) : "s"(__builtin_amdgcn_kernarg_segment_ptr()), "i"(K * 8)); return p; }
DI float* outp() { float* p; asm volatile("s_load_dwordx2 %0, %1, %2\n\ts_waitcnt lgkmcnt(0)" : "=s"(p) : "s"(__builtin_amdgcn_kernarg_segment_ptr()), "i"(23 * 8)); return p; }
DI unsigned char* wsp() { unsigned char* p; asm volatile("s_load_dwordx2 %0, %1, %2\n\ts_waitcnt lgkmcnt(0)" : "=s"(p) : "s"(__builtin_amdgcn_kernarg_segment_ptr()), "i"(24 * 8)); return p; }
enum { I_X = 0, I_POS = 1, I_LNING = 2, I_LNINB = 3, I_WIN = 4, I_BIN = 5, I_SINKS = 6, I_GNG = 7, I_GNB = 8, I_WS = 9, I_BS = 10, I_WOUT = 11, I_BOUT = 12, I_LN1G = 13, I_LN1B = 14,
       I_WR = 15, I_BR = 16, I_WGU = 17, I_BGU = 18, I_WD = 19, I_BD = 20, I_LN2G = 21, I_LN2B = 22 };

#define XB_TMO      128
#define XB_XCNT(j)  (256  + 64 * (j))
#define XB_XSUB(j)  (1280 + 64 * (j))
#define XB_XGEN(j)  (2304 + 64 * (j))
#define XB_TOP      3328
#define XB_TOPGEN   3392
#define XCD_BAR_WORDS 3456
#define XB_SPIN_CAP (1u << 18)
DI unsigned xb_ld(unsigned* p)              { return __hip_atomic_load(p, __ATOMIC_RELAXED, __HIP_MEMORY_SCOPE_AGENT); }
DI unsigned xb_add(unsigned* p, unsigned v) { return __hip_atomic_fetch_add(p, v, __ATOMIC_RELAXED, __HIP_MEMORY_SCOPE_AGENT); }
DI unsigned xb_xcc_id() { return (unsigned)__builtin_amdgcn_s_getreg((3 << 11) | 20) & 0xFu; }
#define XB_SPIN(cond, bar) do { unsigned _sp = 0; while (cond) { __builtin_amdgcn_s_sleep(1); \
    if ((++_sp & 255u) == 0u) { if (xb_ld(&(bar)[XB_TMO])) break; if (_sp > XB_SPIN_CAP) { atomicAdd(&(bar)[XB_TMO], 1u); break; } } } } while (0)
DI void xcd_barrier_post(unsigned* bar) { if (threadIdx.x == 0) (void)xb_add(&bar[XB_XCNT(xb_xcc_id())], 1u); }
DI void xcd_barrier_complete(unsigned* bar, unsigned x, unsigned& nloc, unsigned& nx) {
    unsigned sum, cnt, mine, sp = 0u;
    for (;;) {
        sum = 0u; cnt = 0u; mine = 0u;
#pragma unroll
        for (unsigned j = 0; j < 16; ++j) { const unsigned c = xb_ld(&bar[XB_XCNT(j)]); sum += c; cnt += (c > 0u) ? 1u : 0u; mine = (j == x) ? c : mine; }
        if (sum == (unsigned)G) break;
        __builtin_amdgcn_s_sleep(1);
        if ((++sp & 255u) == 0u) { if (xb_ld(&bar[XB_TMO])) break; if (sp > XB_SPIN_CAP) { atomicAdd(&bar[XB_TMO], 1u); break; } }
    }
    nloc = mine > 0u ? mine : 1u; nx = cnt > 0u ? cnt : 1u;
}
DI void xcd_barrier(volatile LAS unsigned* st) {
    asm volatile("s_waitcnt vmcnt(0)" ::: "memory");
    __syncthreads();
    if (threadIdx.x == 0) {
        unsigned* bar = (unsigned*)(wsp() + WS_CTL) + CW_BAR; const unsigned x = xb_xcc_id();
        __builtin_amdgcn_s_waitcnt(0);
        unsigned nloc = st[0], nx = st[1];
        if (nloc == 0u) { xcd_barrier_complete(bar, x, nloc, nx); st[0] = nloc; st[1] = nx; }
        const unsigned old = xb_add(&bar[XB_XSUB(x)], 1u);
        const unsigned gen = old / nloc;
        if (old + 1u == (gen + 1u) * nloc) {
            __builtin_amdgcn_fence(__ATOMIC_RELEASE, "agent");
            asm volatile("s_waitcnt vmcnt(0)" ::: "memory");
            const unsigned og = xb_add(&bar[XB_TOP], 1u);
            const unsigned tg = og / nx;
            if (og + 1u == (tg + 1u) * nx) xb_add(&bar[XB_TOPGEN], 1u);
            else XB_SPIN(xb_ld(&bar[XB_TOPGEN]) == tg, bar);
            __builtin_amdgcn_fence(__ATOMIC_ACQUIRE, "agent");
            xb_add(&bar[XB_XGEN(x)], 1u);
            asm volatile("s_waitcnt vmcnt(0)" ::: "memory");
        } else {
            XB_SPIN(xb_ld(&bar[XB_XGEN(x)]) == gen, bar);
            __builtin_amdgcn_fence(__ATOMIC_ACQUIRE, "agent");
            asm volatile("s_waitcnt vmcnt(0)" ::: "memory");
        }
    }
    __syncthreads();
}

namespace pg8 {
constexpr int BM = 256, HALF = 128, HTB = HALF * 128, NXCD = 8, WGM = 8, GK = 1024;
constexpr size_t KSTEP = 128;
DI int lds_byte(int r, int c) { const int st = (r >> 4) * 2 + (c >> 5), rr = r & 15, cc = c & 31, ob = rr * 64 + cc * 2; return st * 1024 + (ob ^ (((ob >> 9) & 1) << 5)); }
DI void stage_rc(int b, int& R, int& C) { const int st = b / 1024, sb = b % 1024, swz = sb ^ (((sb >> 9) & 1) << 5); R = (st >> 1) * 16 + swz / 64; C = (st & 1) * 32 + (swz % 64) / 2; }
DI int perm32(int rho) { const int n = rho >> 4, i = rho & 15; return 8 * (i >> 2) + 4 * n + (i & 3); }

struct Unit { int pm, pn, e; };

template <int M, int N> struct StaticOrder {
    int c;
    DI bool next(int i, Unit& u) const {
        constexpr int nM = M / BM, nN = N / BM, nwg = nM * nN;
        const int L = i * G + c; if (L >= nwg) return false;
        int wgid = L; { constexpr int q = nwg / NXCD, r = nwg % NXCD; const int xcd = wgid % NXCD, off = wgid / NXCD; wgid = (xcd < r ? xcd * (q + 1) : r * (q + 1) + (xcd - r) * q) + off; }
        constexpr int nig = WGM * nN; const int gid = wgid / nig, fm = gid * WGM, gsz = (nM - fm) < WGM ? (nM - fm) : WGM;
        u.pm = fm + ((wgid % nig) % gsz); u.pn = (wgid % nig) / gsz; u.e = 0; return true;
    }
};
template <int NPN> struct GroupOrder {
    int g0, g1, c;
    DI bool next(int i, Unit& u) const {
        constexpr int GPX = 32 / NPN;
        const int x = c & 7, j = c >> 3;
        const int g = g0 + i * (8 * GPX) + x * GPX + j / NPN;
        if (g >= g1) return false;
        u.pm = g; u.pn = j % NPN;
        u.e = __builtin_amdgcn_readfirstlane((int)__hip_atomic_load((unsigned*)(wsp() + WS_GRPE) + g, __ATOMIC_RELAXED, __HIP_MEMORY_SCOPE_AGENT));
        return true;
    }
};
DI void piece_rc(int i, int& R, int& C) { int t = threadIdx.x; asm volatile("" : "+v"(t)); stage_rc(t * 16 + i * 8192, R, C); }
DI unsigned tok_off(const LAS int* tb, int h, int i, unsigned pitch) { int R, C; piece_rc(i, R, C); int tok = tb[h * HALF + R]; tok = tok < 0 ? 0 : tok; return (unsigned)tok * pitch + (unsigned)C * 2u; }

struct FragBF { bf16x8 k0, k1; };
struct FragF8 { v8i v; };
DI void ldfrag(FragBF& f, const LAS unsigned char* p) { f.k0 = *(const LAS bf16x8*)p; f.k1 = *(const LAS bf16x8*)(p + 1024); }
typedef int v8i_a16 __attribute__((ext_vector_type(8), aligned(16)));
DI void ldfrag(FragF8& f, const LAS unsigned char* p) { f.v = *(const LAS v8i_a16*)p; }
DI void mma(f32x4& acc, const FragBF& w, const FragBF& a) { acc = __builtin_amdgcn_mfma_f32_16x16x32_bf16(w.k0, a.k0, acc, 0, 0, 0); acc = __builtin_amdgcn_mfma_f32_16x16x32_bf16(w.k1, a.k1, acc, 0, 0, 0); }
DI void mma(f32x4& acc, const FragF8& w, const FragF8& a) { acc = __builtin_amdgcn_mfma_scale_f32_16x16x128_f8f6f4(w.v, a.v, acc, 0, 0, 0, WQ_E8M0, 0, 127); }
template <class Cfg, class Epi, class Sched>
DI void gemm_phase(LAS unsigned char* lds, LAS unsigned char* tokbuf, const int pm_bias, const Sched& S, const Epi& E) {
    constexpr bool GATHER = Cfg::GATHER, FP8 = Cfg::FP8;
    constexpr int ROWB = FP8 ? GK : 2 * GK, NT = ROWB / 128;
    constexpr size_t HSTEP = (size_t)HALF * ROWB, TSTEP = 2 * HSTEP;
    using Frag = typename std::conditional<FP8, FragF8, FragBF>::type;
    int tid = threadIdx.x; asm volatile("" : "+v"(tid));
    const int wid = __builtin_amdgcn_readfirstlane(tid >> 6), lane = tid & 63, wr = wid >> 2, wc = wid & 3, fr = lane & 15, fq = lane >> 4;
    unsigned voffB[2], vaC[2][2];
#pragma unroll
    for (int i = 0; i < 2; ++i) { int R, C; stage_rc(tid * 16 + i * 8192, R, C); const int Rb = Epi::PERM ? ((R & ~31) + perm32(R & 31)) : R;
        voffB[i] = (unsigned)(Rb * ROWB + C * 2); vaC[0][i] = (unsigned)(R * ROWB + C * 2); vaC[1][i] = vaC[0][i]; }
    constexpr size_t AHSTEP = GATHER ? (size_t)0 : HSTEP;
    const unsigned ldsw = (unsigned)wid * 1024u;
    const int cfr = FP8 ? (fq >> 1) * 32 + (fq & 1) * 16 : fq * 8;
    const int aoff = lds_byte(wr * 64 + fr, cfr);
    int boff = lds_byte(wc * 32 + fr, cfr) + 4 * HTB; asm volatile("" : "+v"(boff));
#define PG8_SA(b, h) (((b) * 2 + (h)) * HTB)
#define PG8_SB(b, h) ((4 + (b) * 2 + (h)) * HTB)
    const __amdgpu_buffer_rsrc_t rs = __builtin_amdgcn_make_buffer_rsrc((void*)wsp(), 0, 0x40000000, 0x00020000);
#define PG8_STAGEB(bufoff, soff) do { _Pragma("unroll") for (int _i = 0; _i < 2; ++_i) \
        __builtin_amdgcn_raw_ptr_buffer_load_lds(rs, (LAS void*)(lds + (bufoff) + ldsw + _i * 8192), 16, voffB[_i], (int)(soff), 0, 0); } while (0)
#define PG8_STAGEA(bufoff, soff, o0, o1) do { \
        __builtin_amdgcn_raw_ptr_buffer_load_lds(rs, (LAS void*)(lds + (bufoff) + ldsw), 16, (o0), (int)(soff), 0, 0); \
        __builtin_amdgcn_raw_ptr_buffer_load_lds(rs, (LAS void*)(lds + (bufoff) + ldsw + 8192), 16, (o1), (int)(soff), 0, 0); } while (0)
#define PG8_LDA(dst, b, h) do { _Pragma("unroll") for (int m = 0; m < 4; ++m) ldfrag(dst[m], lds + PG8_SA(b, h) + aoff + m * 2048); } while (0)
#define PG8_LDB(dst, b, h) do { _Pragma("unroll") for (int n = 0; n < 2; ++n) ldfrag(dst[n], lds + ((b) * 2 + (h)) * HTB + boff + n * 2048); } while (0)
#define PG8_MMA(ai, bj, At, Bt) do { __builtin_amdgcn_s_setprio(1); _Pragma("unroll") for (int m = 0; m < 4; ++m) _Pragma("unroll") for (int n = 0; n < 2; ++n) \
        mma(acc[ai][bj][m][n], Bt[n], At[m]); __builtin_amdgcn_s_setprio(0); } while (0)
#define PG8_WAIT_V(n) asm volatile("s_waitcnt vmcnt(" #n ")" ::: "memory")
#define PG8_WAIT_L(n) asm volatile("s_waitcnt lgkmcnt(" #n ")" ::: "memory")
#define PG8_BAR __builtin_amdgcn_s_barrier()
#define PG8_SCHED __builtin_amdgcn_sched_barrier(0)
#define PG8_ABASE(u) (GATHER ? (unsigned)Cfg::A_OFF : (unsigned)(Cfg::A_OFF + (size_t)((u).pm - pm_bias) * TSTEP))
#define PG8_BBASE(u) ((unsigned)(Cfg::B_OFF + (size_t)(u).e * Cfg::B_E_BYTES + (size_t)(u).pn * TSTEP))
#define PG8_TOKDMA(u, dst) __builtin_amdgcn_raw_ptr_buffer_load_lds(rs, (LAS void*)(dst), 16, (unsigned)lane * 16u, (int)(WS_SLOTTOK + (size_t)(u).pm * 1024), 0, 0)
    Unit cur, nxt; int ui = 0;
    if (!S.next(0, cur)) return;
    if constexpr (GATHER) {
        if (wid == 0) PG8_TOKDMA(cur, tokbuf);
        PG8_WAIT_V(0); PG8_BAR;
#pragma unroll
        for (int h = 0; h < 2; ++h)
#pragma unroll
            for (int i = 0; i < 2; ++i) vaC[h][i] = tok_off((const LAS int*)tokbuf, h, i, Cfg::A_PITCH);
        PG8_WAIT_L(0); PG8_BAR;
    }
    f32x4 acc[2][2][4][2];
#pragma unroll
    for (int a = 0; a < 2; ++a)
#pragma unroll
        for (int b = 0; b < 2; ++b)
#pragma unroll
            for (int m = 0; m < 4; ++m)
#pragma unroll
                for (int n = 0; n < 2; ++n) acc[a][b][m][n] = (f32x4){0.f, 0.f, 0.f, 0.f};
    Frag At[4], B0[2], B1[2];
    unsigned cA = PG8_ABASE(cur);
    unsigned cB = PG8_BBASE(cur);
    PG8_STAGEB(PG8_SB(0, 0), cB); PG8_STAGEB(PG8_SB(0, 1), cB + (unsigned)HSTEP); PG8_STAGEA(PG8_SA(0, 0), cA, vaC[0][0], vaC[0][1]); PG8_STAGEA(PG8_SA(0, 1), cA + (unsigned)AHSTEP, vaC[1][0], vaC[1][1]);
    if (wr == 1) PG8_BAR;
    PG8_WAIT_V(2); PG8_BAR;
    PG8_STAGEB(PG8_SB(1, 0), cB + (unsigned)KSTEP); PG8_STAGEA(PG8_SA(1, 0), cA + (unsigned)KSTEP, vaC[0][0], vaC[0][1]); PG8_STAGEB(PG8_SB(1, 1), cB + (unsigned)(HSTEP + KSTEP));
    PG8_WAIT_V(6); PG8_BAR;
    for (;;) {
        const bool has_next = S.next(ui + 1, nxt);
        const LAS int* tbn = (const LAS int*)(tokbuf + ((ui + 1) & 1) * 1024);
        if constexpr (Epi::PREFETCH) E.prefetch(rs, lds, cur, ui, wid, lane);
        if constexpr (GATHER) {
            if (has_next && wid == 0) PG8_TOKDMA(nxt, tokbuf + ((ui + 1) & 1) * 1024);
        }
        asm volatile(".p2align 8" ::: "memory");
#pragma unroll 1
        for (int t = 0; t < NT; t += 2) {
            const bool last = (t == NT - 2);
            const unsigned a1 = cA + (unsigned)(t + 1) * (unsigned)KSTEP;
            unsigned a2 = cA + (unsigned)(t + 2) * (unsigned)KSTEP, b2 = cB + (unsigned)(t + 2) * (unsigned)KSTEP;
            if (last) {
                if (has_next) { a2 = PG8_ABASE(nxt); b2 = PG8_BBASE(nxt);
                    if constexpr (GATHER) { vaC[0][0] = tok_off(tbn, 0, 0, Cfg::A_PITCH); vaC[0][1] = tok_off(tbn, 0, 1, Cfg::A_PITCH); } }
                else { a2 = cA; b2 = cB; }
            }
            const unsigned a3 = a2 + (unsigned)KSTEP, b3 = b2 + (unsigned)KSTEP;
            PG8_LDB(B0, 0, 0); PG8_LDB(B1, 0, 1); PG8_SCHED; PG8_LDA(At, 0, 0); PG8_STAGEA(PG8_SA(1, 1), a1 + (unsigned)AHSTEP, vaC[1][0], vaC[1][1]);
            if constexpr (GATHER) { if (last && has_next) { vaC[1][0] = tok_off(tbn, 1, 0, Cfg::A_PITCH); vaC[1][1] = tok_off(tbn, 1, 1, Cfg::A_PITCH); } }
            PG8_WAIT_V(8); PG8_WAIT_L(0); PG8_BAR; PG8_MMA(0, 0, At, B0); PG8_MMA(0, 1, At, B1); PG8_BAR; PG8_SCHED;
            PG8_LDA(At, 0, 1); PG8_STAGEB(PG8_SB(0, 0), b2); PG8_STAGEB(PG8_SB(0, 1), b2 + (unsigned)HSTEP); PG8_STAGEA(PG8_SA(0, 0), a2, vaC[0][0], vaC[0][1]);
            PG8_WAIT_V(8); PG8_WAIT_L(0); PG8_BAR; PG8_MMA(1, 0, At, B0); PG8_MMA(1, 1, At, B1); PG8_BAR; PG8_SCHED;
            PG8_LDB(B0, 1, 0); PG8_LDB(B1, 1, 1); PG8_SCHED; PG8_LDA(At, 1, 0); PG8_STAGEA(PG8_SA(0, 1), a2 + (unsigned)AHSTEP, vaC[1][0], vaC[1][1]);
            PG8_WAIT_V(8); PG8_WAIT_L(0); PG8_BAR; PG8_MMA(0, 0, At, B0); PG8_MMA(0, 1, At, B1); PG8_BAR; PG8_SCHED;
            PG8_LDA(At, 1, 1); PG8_STAGEB(PG8_SB(1, 0), b3); PG8_STAGEB(PG8_SB(1, 1), b3 + (unsigned)HSTEP); PG8_STAGEA(PG8_SA(1, 0), a3, vaC[0][0], vaC[0][1]);
            PG8_WAIT_V(8); PG8_WAIT_L(0); PG8_BAR; PG8_MMA(1, 0, At, B0); PG8_MMA(1, 1, At, B1); PG8_BAR; PG8_SCHED;
        }
        if (wr == 0) PG8_BAR;
        E(acc, cur, wr, wc, fr, fq, lds, ui);
        if (!has_next) break;
#pragma unroll
        for (int a = 0; a < 2; ++a)
#pragma unroll
            for (int b = 0; b < 2; ++b)
#pragma unroll
                for (int m = 0; m < 4; ++m)
#pragma unroll
                    for (int n = 0; n < 2; ++n) acc[a][b][m][n] = (f32x4){0.f, 0.f, 0.f, 0.f};
        cur = nxt; cA = PG8_ABASE(cur); cB = PG8_BBASE(cur); ++ui;
        if (wr == 1) PG8_BAR;
    }
    PG8_WAIT_V(0);
    PG8_BAR;
#undef PG8_SA
#undef PG8_SB
#undef PG8_STAGEA
#undef PG8_STAGEB
#undef PG8_LDA
#undef PG8_LDB
#undef PG8_MMA
#undef PG8_WAIT_V
#undef PG8_WAIT_L
#undef PG8_BAR
#undef PG8_SCHED
#undef PG8_ABASE
#undef PG8_BBASE
#undef PG8_TOKDMA
}
}

struct EpiInProj {
    static constexpr bool PERM = true, PREFETCH = false;
    DI void operator()(f32x4 (&acc)[2][2][4][2], const pg8::Unit& u, int wr, int wc, int fr, int fq, LAS unsigned char* lds, int ui) const {
        const int pn = u.pn;
        int kind, head, ldc; size_t boff;
        if (pn < 2) { kind = 0; head = 4 * pn + wc; boff = WS_QB; ldc = 512; }
        else if (pn == 2) { if (wc < 2) { kind = 1; head = wc; boff = WS_KB; } else { kind = 2; head = wc - 2; boff = WS_VB; } ldc = 128; }
        else if (pn < 5) { kind = 3; head = 4 * (pn - 3) + wc; boff = WS_GUB; ldc = 512; }
        else { kind = 4; head = 4 * (pn - 5) + wc; boff = WS_GVB; ldc = 512; }
        unsigned char* ws = wsp();
        bf16_t* base = (bf16_t*)(ws + boff);
        const float* b_in = inp<I_BIN>();
        const int src0 = 256 * pn + 64 * wc + 8 * fq;
#pragma unroll
        for (int bj = 0; bj < 2; ++bj)
#pragma unroll
            for (int n = 0; n < 2; ++n) { const f32x4 bv = *(const f32x4*)(b_in + src0 + 32 * bj + 4 * n);
#pragma unroll
                for (int ai = 0; ai < 2; ++ai)
#pragma unroll
                    for (int m = 0; m < 4; ++m) acc[ai][bj][m][n] += bv; }
        const float* rope = (const float*)(ws + WS_ROPE);
        const float* gn_g = inp<I_GNG>(); const float* gn_b = inp<I_GNB>();
        const int row0 = u.pm * 256 + wr * 64 + fr;
#pragma unroll
        for (int ai = 0; ai < 2; ++ai)
#pragma unroll
            for (int m = 0; m < 4; ++m) {
                const int row = row0 + ai * 128 + m * 16;
                f32x4 v[2][2];
#pragma unroll
                for (int bj = 0; bj < 2; ++bj)
#pragma unroll
                    for (int n = 0; n < 2; ++n) v[bj][n] = acc[ai][bj][m][n];
                if (kind <= 1) {
                    const float* cs = rope + (size_t)row * 16;
#pragma unroll
                    for (int n = 0; n < 2; ++n) {
                        const f32x4 c4 = *(const f32x4*)(cs + 4 * n), s4 = *(const f32x4*)(cs + 8 + 4 * n);
                        f32x4 p4; p4[0] = __shfl_xor(v[0][n][0], 16); p4[1] = __shfl_xor(v[0][n][1], 16); p4[2] = __shfl_xor(v[0][n][2], 16); p4[3] = __shfl_xor(v[0][n][3], 16);
                        const f32x4 sg = (fq & 1) ? s4 : -s4;
                        const f32x4 rot = v[0][n] * c4 + p4 * sg;
                        if (fq < 2) v[0][n] = rot;
                    }
                    if (kind == 0) {
#pragma unroll
                        for (int bj = 0; bj < 2; ++bj)
#pragma unroll
                            for (int n = 0; n < 2; ++n) v[bj][n] = v[bj][n] * QSCALE;
                    }
                } else if (kind >= 3) {
#pragma unroll
                    for (int bj = 0; bj < 2; ++bj)
#pragma unroll
                        for (int n = 0; n < 2; ++n) v[bj][n] = gelu4(v[bj][n]);
                    if (kind == 4) {
                        float s = 0.f;
#pragma unroll
                        for (int bj = 0; bj < 2; ++bj)
#pragma unroll
                            for (int n = 0; n < 2; ++n) s += (v[bj][n][0] + v[bj][n][1]) + (v[bj][n][2] + v[bj][n][3]);
                        s += __shfl_xor(s, 16); s += __shfl_xor(s, 32);
                        const float mean = s * (1.0f / 64.0f); float q = 0.f;
#pragma unroll
                        for (int bj = 0; bj < 2; ++bj)
#pragma unroll
                            for (int n = 0; n < 2; ++n) { v[bj][n] = v[bj][n] - mean; const f32x4 d = v[bj][n]; q += (d[0] * d[0] + d[1] * d[1]) + (d[2] * d[2] + d[3] * d[3]); }
                        q += __shfl_xor(q, 16); q += __shfl_xor(q, 32);
                        const float rstd = 1.0f / sqrtf(q * (1.0f / 64.0f) + LN_EPS);
#pragma unroll
                        for (int bj = 0; bj < 2; ++bj)
#pragma unroll
                            for (int n = 0; n < 2; ++n) v[bj][n] = v[bj][n] * rstd * *(const f32x4*)(gn_g + 32 * bj + 8 * fq + 4 * n) + *(const f32x4*)(gn_b + 32 * bj + 8 * fq + 4 * n);
                    }
                }
                bf16_t* rowp = base + (size_t)row * ldc + head * 64 + 8 * fq;
#pragma unroll
                for (int bj = 0; bj < 2; ++bj) { u32x4 w; w.x = cvtpk(v[bj][0][0], v[bj][0][1]); w.y = cvtpk(v[bj][0][2], v[bj][0][3]); w.z = cvtpk(v[bj][1][0], v[bj][1][1]); w.w = cvtpk(v[bj][1][2], v[bj][1][3]);
                    *(u32x4*)(rowp + 32 * bj) = w; }
            }
    }
};
struct EpiOut {
    static constexpr bool PERM = false, PREFETCH = false;
    DI void operator()(f32x4 (&acc)[2][2][4][2], const pg8::Unit& u, int wr, int wc, int fr, int fq, LAS unsigned char* lds, int ui) const {
        const int col0 = u.pn * 256 + wc * 32 + 4 * fq;
        unsigned char* ws = wsp(); float* y1 = outp();
        const float* outc = (const float*)(ws + WS_OUTC); const float* stats0 = (const float*)(ws + WS_STATS0);
        const float* x = inp<I_X>();
        f32x4 ca[2][2];
#pragma unroll
        for (int bj = 0; bj < 2; ++bj)
#pragma unroll
            for (int n = 0; n < 2; ++n) { ca[bj][n] = *(const f32x4*)(outc + col0 + bj * 128 + n * 16); const f32x4 cb = *(const f32x4*)(outc + 1024 + col0 + bj * 128 + n * 16);
#pragma unroll
                for (int ai = 0; ai < 2; ++ai)
#pragma unroll
                    for (int m = 0; m < 4; ++m) acc[ai][bj][m][n] += cb; }
        const int row0 = u.pm * 256 + wr * 64 + fr;
#pragma unroll
        for (int ai = 0; ai < 2; ++ai)
#pragma unroll
            for (int m = 0; m < 4; ++m) {
                const int row = row0 + ai * 128 + m * 16;
                const f32x2 st = *(const f32x2*)(stats0 + (size_t)row * 2);
                const size_t off = (size_t)row * D + col0;
#pragma unroll
                for (int bj = 0; bj < 2; ++bj)
#pragma unroll
                    for (int n = 0; n < 2; ++n) { const f32x4 xv = *(const f32x4*)(x + off + bj * 128 + n * 16);
                        const f32x4 o = acc[ai][bj][m][n] + (xv - st.x) * st.y * ca[bj][n];
                        *(f32x4*)(y1 + off + bj * 128 + n * 16) = o; }
                if (m & 1) asm volatile("" ::: "memory");
            }
    }
};
struct EpiGateUp {
    static constexpr bool PERM = true, PREFETCH = false;
    DI void operator()(f32x4 (&acc)[2][2][4][2], const pg8::Unit& u, int wr, int wc, int fr, int fq, LAS unsigned char* lds, int ui) const {
        const int hcol0 = 128 * u.pn + 32 * wc + 8 * fq;
        const float* bias = inp<I_BGU>() + (size_t)u.e * 2048;
        unsigned char* hmid = wsp() + WS_HMID;
        f32x4 bg[2], bu[2];
#pragma unroll
        for (int n = 0; n < 2; ++n) { bg[n] = *(const f32x4*)(bias + hcol0 + 4 * n); bu[n] = *(const f32x4*)(bias + 1024 + hcol0 + 4 * n); }
        const size_t row0 = (size_t)u.pm * 256 + wr * 64 + fr;
#pragma unroll
        for (int ai = 0; ai < 2; ++ai)
#pragma unroll
            for (int m = 0; m < 4; ++m) {
                float h[2][4];
#pragma unroll
                for (int n = 0; n < 2; ++n) {
                    const f32x4 gt = acc[ai][0][m][n] + bg[n], up = acc[ai][1][m][n] + bu[n];
#pragma unroll
                    for (int j = 0; j < 4; ++j) {
                        const float gc = fminf(gt[j], 7.0f), uc = fminf(fmaxf(up[j], -7.0f), 7.0f);
                        const float sg = __builtin_amdgcn_rcpf(1.0f + __builtin_amdgcn_exp2f(gc * (-1.702f * LOG2E)));
                        h[n][j] = (uc + 1.0f) * (gc * sg);
                    }
                }
                u32x2 w; w.x = cvt4_fp8(h[0][0], h[0][1], h[0][2], h[0][3]); w.y = cvt4_fp8(h[1][0], h[1][1], h[1][2], h[1][3]);
                *(u32x2*)(hmid + (row0 + ai * 128 + m * 16) * 1024 + hcol0) = w;
            }
    }
};
struct EpiDown {
    static constexpr bool PERM = true, PREFETCH = true;
    DI void prefetch(const __amdgpu_buffer_rsrc_t rs, LAS unsigned char* lds, const pg8::Unit& u, int ui, int wid, int lane) const {
        LAS unsigned char* eb = lds + EPIBUF_OFF + (ui & 1) * 2048;
        if (wid == 1) __builtin_amdgcn_raw_ptr_buffer_load_lds(rs, (LAS void*)eb, 16, (unsigned)lane * 16u, (int)(WS_SLOTDEST + (size_t)u.pm * 1024), 0, 0);
        if (wid == 2) __builtin_amdgcn_raw_ptr_buffer_load_lds(rs, (LAS void*)(eb + 1024), 16, (unsigned)lane * 16u, (int)(WS_SLOTGATE + (size_t)u.pm * 1024), 0, 0);
    }
    DI void operator()(f32x4 (&acc)[2][2][4][2], const pg8::Unit& u, int wr, int wc, int fr, int fq, LAS unsigned char* lds, int ui) const {
        const int col0 = 256 * u.pn + 32 * wc + 8 * fq;
        const float* bias = inp<I_BD>() + (size_t)u.e * 1024;
        bf16_t* yslot = (bf16_t*)(wsp() + WS_YSLOT);
        const LAS int* dbuf = (const LAS int*)(lds + EPIBUF_OFF + (ui & 1) * 2048); const LAS float* gbuf = (const LAS float*)(lds + EPIBUF_OFF + (ui & 1) * 2048 + 1024);
        f32x4 bd[2][2];
#pragma unroll
        for (int bj = 0; bj < 2; ++bj)
#pragma unroll
            for (int n = 0; n < 2; ++n) bd[bj][n] = *(const f32x4*)(bias + col0 + 128 * bj + 4 * n);
        int dest[2][4]; float gt[2][4];
#pragma unroll
        for (int ai = 0; ai < 2; ++ai)
#pragma unroll
            for (int m = 0; m < 4; ++m) { const int r = wr * 64 + fr + ai * 128 + m * 16; dest[ai][m] = dbuf[r]; gt[ai][m] = gbuf[r]; }
#pragma unroll
        for (int ai = 0; ai < 2; ++ai)
#pragma unroll
            for (int m = 0; m < 4; ++m) {
                if (dest[ai][m] >= 0) {
                    bf16_t* rowp = yslot + (size_t)dest[ai][m] * 1024 + col0;
#pragma unroll
                    for (int bj = 0; bj < 2; ++bj) { const f32x4 v0 = (acc[ai][bj][m][0] + bd[bj][0]) * gt[ai][m], v1 = (acc[ai][bj][m][1] + bd[bj][1]) * gt[ai][m];
                        u32x4 w; w.x = cvtpk(v0[0], v0[1]); w.y = cvtpk(v0[2], v0[3]); w.z = cvtpk(v1[0], v1[1]); w.w = cvtpk(v1[2], v1[3]);
                        *(u32x4*)(rowp + 128 * bj) = w; }
                }
            }
    }
};

DI int rowmap(int kind, int n) {
    if (kind == 0) { const int pn = n >> 8, ch = n & 255, wc = ch >> 6, bj = (ch >> 5) & 1, w = ch & 31; return (pn << 8) + (bj << 7) + (wc << 5) + w; }
    if (kind == 2) { return n < 1024 ? ((n >> 7) << 8) + (n & 127) : (((n - 1024) >> 7) << 8) + 128 + ((n - 1024) & 127); }
    return n;
}
DI void p0_transpose_item(const float* W, int N, bf16_t* WT, int kind, LAS unsigned char* scr, int item, int lane) {
    const int nblk = N / 64, kb = item / nblk, nb = item % nblk, k0 = 64 * kb, n0 = 64 * nb;
    const int nq = lane >> 2, kr = lane & 3;
    f32x4 a[8], b[8];
#pragma unroll
    for (int i = 0; i < 8; ++i) { const float* p = W + (size_t)(k0 + 8 * i + 2 * kr) * N + n0 + 4 * nq; a[i] = *(const GAS f32x4*)p; b[i] = *(const GAS f32x4*)(p + N); }
#pragma unroll
    for (int i = 0; i < 8; ++i)
#pragma unroll
        for (int c = 0; c < 4; ++c) *(LAS unsigned*)(scr + (4 * nq + c) * 132 + (8 * i + 2 * kr) * 2) = cvtpk(a[i][c], b[i][c]);
    LDS_WAIT(); asm volatile("" ::: "memory");
    const int c8 = lane & 7;
#pragma unroll
    for (int j = 0; j < 8; ++j) { const int n = (lane >> 3) + 8 * j; const LAS unsigned* s = (const LAS unsigned*)(scr + n * 132 + 16 * c8);
        u32x4 o; o.x = s[0]; o.y = s[1]; o.z = s[2]; o.w = s[3];
        *(GAS u32x4*)(WT + (size_t)rowmap(kind, n0 + n) * 1024 + k0 + 8 * c8) = o; }
    LDS_WAIT(); asm volatile("" ::: "memory");
}
struct QItem { const float* W; unsigned char* WT; int N, kind, k0, n0; };
DI QItem p0_qitem(int r, const float* wgu, const float* wd, unsigned char* ws) {
    constexpr int I_GU = (D / 128) * (2048 / 32), I_D = (D / 128) * (D / 32);
    QItem q;
    if (r < NE * I_GU) { const int e = r / I_GU, it = r % I_GU; q.W = wgu + (size_t)e * D * 2048; q.WT = ws + WS_WGU + (size_t)e * 2048 * D; q.N = 2048; q.kind = 2; q.k0 = 128 * (it / 64); q.n0 = 32 * (it % 64); }
    else { r -= NE * I_GU; const int e = r / I_D, it = r % I_D; q.W = wd + (size_t)e * D * D; q.WT = ws + WS_WD + (size_t)e * D * D; q.N = D; q.kind = 1; q.k0 = 128 * (it / 32); q.n0 = 32 * (it % 32); }
    return q;
}
DI void p0_qload(const QItem& q, f32x4 (&a)[4][4], int lane) {
    const int nq = lane >> 3, kr = lane & 7;
#pragma unroll
    for (int i = 0; i < 4; ++i) { const float* p = q.W + (size_t)(q.k0 + 32 * i + 4 * kr) * q.N + q.n0 + 4 * nq;
#pragma unroll
        for (int u = 0; u < 4; ++u) a[i][u] = *(const GAS f32x4*)(p + (size_t)u * q.N); }
}
DI void p0_qfinish(const QItem& q, const f32x4 (&a)[4][4], LAS unsigned char* scr, int lane) {
    const int nq = lane >> 3, kr = lane & 7;
#pragma unroll
    for (int i = 0; i < 4; ++i)
#pragma unroll
        for (int c = 0; c < 4; ++c) *(LAS unsigned*)(scr + (4 * nq + c) * 136 + 32 * i + 4 * kr) = cvt4_fp8(a[i][0][c] * WQ_SCALE, a[i][1][c] * WQ_SCALE, a[i][2][c] * WQ_SCALE, a[i][3][c] * WQ_SCALE);
    LDS_WAIT(); asm volatile("" ::: "memory");
    const int c8 = lane & 7;
#pragma unroll
    for (int j = 0; j < 4; ++j) { const int n = (lane >> 3) + 8 * j; const LAS u32x2* s = (const LAS u32x2*)(scr + n * 136 + 16 * c8);
        const u32x2 x = s[0], y = s[1]; u32x4 o; o.x = x.x; o.y = x.y; o.z = y.x; o.w = y.y;
        *(GAS u32x4*)(q.WT + (size_t)rowmap(q.kind, q.n0 + n) * 1024 + q.k0 + 16 * c8) = o; }
    LDS_WAIT(); asm volatile("" ::: "memory");
}
DI void p0_prologue(const Frame& F0, LAS unsigned char* lds) {
    const Frame F = opaque(F0);
    unsigned char* ws = wsp();
    LAS unsigned char* scr = lds + F.wave * 16384;
    const int gw = F.bid * NWAVES + F.wave, NGW = G * NWAVES;
    const int gt = F.bid * NTHREADS + F.tid, NGT = G * NTHREADS;
    constexpr int I_IN = (D / 64) * (INW / 64), I_OUT = (D / 64) * (D / 64), I_GU = (D / 128) * (2048 / 32), I_D = (D / 128) * (D / 32);
    for (int it = gw; it < I_IN + I_OUT; it += NGW) {
        if (it < I_IN) p0_transpose_item(inp<I_WIN>(), INW, (bf16_t*)(ws + WS_WIN), 0, scr, it, F.lane);
        else p0_transpose_item(inp<I_WOUT>(), D, (bf16_t*)(ws + WS_WOUT), 1, scr, it - I_IN, F.lane);
    }
    {
        constexpr int NQ = NE * (I_GU + I_D);
        const float* wgu = inp<I_WGU>(); const float* wd = inp<I_WD>();
        f32x4 ra[4][4], rb[4][4];
        QItem qa = p0_qitem(gw < NQ ? gw : 0, wgu, wd, ws), qb = qa;
        if (gw < NQ) p0_qload(qa, ra, F.lane);
#pragma unroll 1
        for (int it = gw; it < NQ; it += 2 * NGW) {
            const bool hb = it + NGW < NQ;
            if (hb) { qb = p0_qitem(it + NGW, wgu, wd, ws); p0_qload(qb, rb, F.lane); }
            p0_qfinish(qa, ra, scr, F.lane);
            if (it + 2 * NGW < NQ) { qa = p0_qitem(it + 2 * NGW, wgu, wd, ws); p0_qload(qa, ra, F.lane); }
            if (hb) p0_qfinish(qb, rb, scr, F.lane);
        }
    }
    bf16_t* h0b = (bf16_t*)(ws + WS_H0B); float* stats0 = (float*)(ws + WS_STATS0);
    const float* xin = inp<I_X>(); const float* lg = inp<I_LNING>(); const float* lb = inp<I_LNINB>();
    {
        f32x4 pf[4][4];
#pragma unroll
        for (int u = 0; u < 4; ++u)
#pragma unroll
            for (int j = 0; j < 4; ++j) pf[u][j] = ((const GAS f32x4*)(xin + (size_t)(gw + u * NGW) * D))[F.lane + 64 * j];
        f32x4 gg[4], bb[4];
#pragma unroll
        for (int j = 0; j < 4; ++j) { gg[j] = ((const f32x4*)lg)[F.lane + 64 * j]; bb[j] = ((const f32x4*)lb)[F.lane + 64 * j]; }
#pragma unroll 1
        for (int m0 = gw; m0 < T; m0 += 4 * NGW) {
#pragma unroll
            for (int u = 0; u < 4; ++u) {
                const int m = m0 + u * NGW;
                f32x4 v[4]; float s = 0.f;
#pragma unroll
                for (int j = 0; j < 4; ++j) { v[j] = pf[u][j]; s += (v[j].x + v[j].y) + (v[j].z + v[j].w); }
                { const int mn = (m + 4 * NGW < T) ? m + 4 * NGW : m;
#pragma unroll
                  for (int j = 0; j < 4; ++j) pf[u][j] = ((const GAS f32x4*)(xin + (size_t)mn * D))[F.lane + 64 * j]; }
                const float mean = wave_sum(s) * (1.f / D); float s2 = 0.f;
#pragma unroll
                for (int j = 0; j < 4; ++j) { v[j] = v[j] - mean; s2 += (v[j].x * v[j].x + v[j].y * v[j].y) + (v[j].z * v[j].z + v[j].w * v[j].w); }
                const float rstd = 1.f / sqrtf(wave_sum(s2) * (1.f / D) + LN_EPS);
                GAS u32x2* o8 = (GAS u32x2*)(h0b + (size_t)m * D) + F.lane;
#pragma unroll
                for (int j = 0; j < 4; ++j) { const f32x4 r = v[j] * rstd * gg[j] + bb[j]; u32x2 w; w.x = cvtpk(r.x, r.y); w.y = cvtpk(r.z, r.w); o8[64 * j] = w; }
                if (F.lane == 0) { stats0[2 * m] = mean; stats0[2 * m + 1] = rstd; }
            }
        }
    }
    float* rope = (float*)(ws + WS_ROPE); const int* positions = (const int*)inp<I_POS>();
    for (int i = gt; i < T * 8; i += NGT) {
        const int tok = i >> 3, j = i & 7;
        const float invr = j == 0 ? 1.5915494309189535e-01f : j == 1 ? 3.086376340470123e-02f : j == 2 ? 5.985185712713705e-03f : j == 3 ? 1.160663641240061e-03f : j == 4 ? 2.2507907903927653e-04f : j == 5 ? 4.364795279280289e-05f : j == 6 ? 8.464330808241401e-06f : 1.6414262627950345e-06f;
        float rev = (float)positions[tok] * invr; rev -= floorf(rev);
        rope[tok * 16 + j] = __builtin_amdgcn_cosf(rev); rope[tok * 16 + 8 + j] = __builtin_amdgcn_sinf(rev);
    }
    int* slot_tok = (int*)(ws + WS_SLOTTOK); int* slot_dest = (int*)(ws + WS_SLOTDEST);
    for (int i = gt; i < NSLOT; i += NGT) { slot_tok[i] = -1; slot_dest[i] = -1; }
    float* outc = (float*)(ws + WS_OUTC); const float* bo = inp<I_BOUT>();
    for (int i = gt; i < D; i += NGT) { outc[i] = ALPHA * lg[i]; outc[1024 + i] = bo[i] + ALPHA * lb[i]; }
    bf16_t* wsp = (bf16_t*)(ws + WS_WSP); const float* w_s = inp<I_WS>();
    for (int i = gt; i < 8 * 128 * 128; i += NGT) {
        const int j = i & 7, hi = (i >> 3) & 1, ks = (i >> 4) & 7, t = (i >> 7) & 127, h = i >> 14;
        const int s = 16 * ks + 8 * (j >> 2) + 4 * hi + (j & 3);
        const float w = (s <= t) ? w_s[((size_t)h * 128 + t) * 128 + s] : 0.f;
        wsp[i] = (bf16_t)(cvtpk(w, 0.f) & 0xffffu);
    }
}

#define MFMA32(a, b, c) __builtin_amdgcn_mfma_f32_32x32x16_bf16((a), (b), (c), 0, 0, 0)
DI int crow(int r, int hi) { return (r & 3) + 8 * (r >> 2) + 4 * hi; }
DI bf16x8 cat4(s16x4 lo, s16x4 hi) { return __builtin_shufflevector(lo, hi, 0, 1, 2, 3, 4, 5, 6, 7); }
#define ATT_ISSUE_Q(uu, sb) do { const int b_ = (uu) >> 6, n_ = ((uu) >> 1) & 31, kvh_ = (uu) & 1, tok0_ = b_ * SEQ + n_ * 128, hq_ = kvh_ * 4 + g; \
    const bf16_t* qp = Qb + (size_t)(tok0_ + rh * 64 + (sb) * 32 + q) * 512 + hq_ * 64 + hi * 8; \
    _Pragma("unroll") for (int ds = 0; ds < 4; ++ds) qf[sb][ds] = *(const bf16x8*)(qp + ds * 16); } while (0)
#define ATT_ISSUE_KV(uu) do { const int b_ = (uu) >> 6, n_ = ((uu) >> 1) & 31, kvh_ = (uu) & 1, tok0_ = b_ * SEQ + n_ * 128; \
    _Pragma("unroll") for (int rep = 0; rep < 4; ++rep) { const int c = F.tid + 512 * rep, kw = c >> 3, ch = c & 7; \
        int tokk = tok0_ - 128 + kw; if (n_ == 0 && kw < 128) tokk = tok0_ + kw;       \
        kreg[rep] = *(const u32x4*)(Kb + (size_t)tokk * 128 + kvh_ * 64 + ch * 8); vreg[rep] = *(const u32x4*)(Vb + (size_t)tokk * 128 + kvh_ * 64 + ch * 8); } } while (0)
DI void attn_phase(const Frame& F0, LAS unsigned char* lds) {
    const Frame F = opaque(F0);
    unsigned char* ws = wsp();
    const bf16_t* Qb = (const bf16_t*)(ws + WS_QB); const bf16_t* Kb = (const bf16_t*)(ws + WS_KB); const bf16_t* Vb = (const bf16_t*)(ws + WS_VB);
    bf16_t* Ob = (bf16_t*)(ws + WS_H0B);
    LAS unsigned char* Kl = lds;
    LAS unsigned char* Vt = lds + 36864;
    const int g = F.wave >> 1, rh = F.wave & 1;
    const float* sinks = inp<I_SINKS>();
    u32x4 kreg[4], vreg[4]; bf16x8 qf[2][4];
    constexpr int NU = NBATCH * 32 * 2;
    if (F.bid < NU) { const int q = F.lane & 31, hi = F.lane >> 5; ATT_ISSUE_KV(F.bid); ATT_ISSUE_Q(F.bid, 0); ATT_ISSUE_Q(F.bid, 1); }
#pragma unroll 1
    for (int u = F.bid; u < NU; u += G) {
        const int b = u >> 6, n = (u >> 1) & 31, kvh = u & 1, tok0 = b * SEQ + n * 128, hq = kvh * 4 + g;
        int tid2 = F.tid; asm volatile("" : "+v"(tid2));
        const int q = tid2 & 31, hi = (tid2 >> 5) & 1;
#pragma unroll
        for (int rep = 0; rep < 4; ++rep) {
            const int c = tid2 + 512 * rep, kw = c >> 3, ch = c & 7;
            *(LAS u32x4*)(Kl + kw * 144 + ch * 16) = kreg[rep];
            const unsigned wv[4] = {vreg[rep].x, vreg[rep].y, vreg[rep].z, vreg[rep].w};
#pragma unroll
            for (int e = 0; e < 8; ++e) { const int d = ch * 8 + e; const unsigned short val = (unsigned short)((e & 1) ? (wv[e >> 1] >> 16) : (wv[e >> 1] & 0xffffu));
                *(LAS unsigned short*)(Vt + d * 512 + ((((kw >> 2) ^ (d & 31))) << 3) + (kw & 3) * 2) = val; }
        }
        __syncthreads();
        if (u + G < NU) ATT_ISSUE_KV(u + G);
        const float sink2 = sinks[hq] * LOG2E;
#pragma unroll
        for (int sb = 0; sb < 2; ++sb) {
            const int r0 = rh * 64 + sb * 32, kb0 = r0 >> 5;
            f32x16 p[5];
#pragma unroll
            for (int kbi = 0; kbi < 5; ++kbi) {
                f32x16 a = {};
#pragma unroll
                for (int ds = 0; ds < 4; ++ds) { const bf16x8 kf = *(const LAS bf16x8*)(Kl + ((kb0 + kbi) * 32 + q) * 144 + (ds * 16 + hi * 8) * 2); a = MFMA32(kf, qf[sb][ds], a); }
                p[kbi] = a;
            }
            if (u + G < NU) ATT_ISSUE_Q(u + G, sb);
            float mx = sink2;
#pragma unroll
            for (int kbi = 0; kbi < 5; ++kbi) {
                const bool blk_ok = (n > 0) || (kb0 + kbi >= 4);
#pragma unroll
                for (int r = 0; r < 16; ++r) { const int c = crow(r, hi); const bool ok = blk_ok && (kbi == 0 ? c > q : kbi == 4 ? c <= q : true);
                    const float s = ok ? p[kbi][r] : -1e30f; p[kbi][r] = s; mx = fmaxf(mx, s); }
            }
            mx = fmaxf(mx, partnerf<5>(mx, F.lane));
            float l = 0.f;
#pragma unroll
            for (int kbi = 0; kbi < 5; ++kbi)
#pragma unroll
                for (int r = 0; r < 16; ++r) { const float e = __builtin_amdgcn_exp2f(p[kbi][r] - mx); p[kbi][r] = e; l += e; }
            l += partnerf<5>(l, F.lane); l += __builtin_amdgcn_exp2f(sink2 - mx);
            f32x16 o0 = {}, o1 = {};
#pragma unroll
            for (int kbi = 0; kbi < 5; ++kbi)
#pragma unroll
                for (int s2 = 0; s2 < 2; ++s2) {
                    u32x4 pw; pw.x = cvtpk(p[kbi][8 * s2 + 0], p[kbi][8 * s2 + 1]); pw.y = cvtpk(p[kbi][8 * s2 + 2], p[kbi][8 * s2 + 3]);
                    pw.z = cvtpk(p[kbi][8 * s2 + 4], p[kbi][8 * s2 + 5]); pw.w = cvtpk(p[kbi][8 * s2 + 6], p[kbi][8 * s2 + 7]);
                    const bf16x8 pa = __builtin_bit_cast(bf16x8, pw);
                    const int kc = ((kb0 + kbi) * 32 + 16 * s2 + 4 * hi) >> 2;
                    { const int d = q; const s16x4 lo = *(const LAS s16x4*)(Vt + d * 512 + ((kc ^ (d & 31)) << 3)), hh = *(const LAS s16x4*)(Vt + d * 512 + (((kc + 2) ^ (d & 31)) << 3)); o0 = MFMA32(cat4(lo, hh), pa, o0); }
                    { const int d = 32 + q; const s16x4 lo = *(const LAS s16x4*)(Vt + d * 512 + ((kc ^ (d & 31)) << 3)), hh = *(const LAS s16x4*)(Vt + d * 512 + (((kc + 2) ^ (d & 31)) << 3)); o1 = MFMA32(cat4(lo, hh), pa, o1); }
                }
            const float rl = __builtin_amdgcn_rcpf(l);
            bf16_t* op = Ob + (size_t)(tok0 + r0 + q) * D + hq * 64 + 4 * hi;
#pragma unroll
            for (int g4 = 0; g4 < 4; ++g4) {
                u32x2 w0, w1; w0.x = cvtpk(o0[4 * g4] * rl, o0[4 * g4 + 1] * rl); w0.y = cvtpk(o0[4 * g4 + 2] * rl, o0[4 * g4 + 3] * rl);
                w1.x = cvtpk(o1[4 * g4] * rl, o1[4 * g4 + 1] * rl); w1.y = cvtpk(o1[4 * g4 + 2] * rl, o1[4 * g4 + 3] * rl);
                *(u32x2*)(op + 8 * g4) = w0; *(u32x2*)(op + 32 + 8 * g4) = w1;
            }
        }
        __syncthreads();
    }
}
#undef ATT_ISSUE_Q
#undef ATT_ISSUE_KV
template <int TB> DI void gmlp_tb(const bf16_t* GUb, const bf16_t* wsp, bf16_t* Ob, const float* b_s, LAS unsigned char* Vt, int h, int tok0, int q, int hi) {
    constexpr int NKS = 2 * TB + 2;
    const int t = TB * 32 + q;
    const bf16_t* gp = GUb + (size_t)(tok0 + t) * 512 + h * 64 + 4 * hi;
    const bf16_t* wp = wsp + ((size_t)(h * 128 + t) * 8) * 16 + hi * 8;
    bf16x8 wa[NKS];
#pragma unroll
    for (int ks = 0; ks < NKS; ++ks) wa[ks] = *(const bf16x8*)(wp + ks * 16);
    u32x2 gu0[4], gu1[4];
#pragma unroll
    for (int g4 = 0; g4 < 4; ++g4) { gu0[g4] = *(const u32x2*)(gp + 8 * g4); gu1[g4] = *(const u32x2*)(gp + 32 + 8 * g4); }
    const float bias = b_s[h * 128 + t];
    f32x16 a0 = {}, a1 = {};
#pragma unroll
    for (int ks = 0; ks < NKS; ++ks) {
        const int kc = (16 * ks + 4 * hi) >> 2;
        { const int d = q; const s16x4 lo = *(const LAS s16x4*)(Vt + d * 256 + ((kc ^ (d & 31)) << 3)), hh = *(const LAS s16x4*)(Vt + d * 256 + (((kc + 2) ^ (d & 31)) << 3)); a0 = MFMA32(cat4(lo, hh), wa[ks], a0); }
        { const int d = 32 + q; const s16x4 lo = *(const LAS s16x4*)(Vt + d * 256 + ((kc ^ (d & 31)) << 3)), hh = *(const LAS s16x4*)(Vt + d * 256 + (((kc + 2) ^ (d & 31)) << 3)); a1 = MFMA32(cat4(lo, hh), wa[ks], a1); }
    }
    bf16_t* op = Ob + (size_t)(tok0 + t) * D + 512 + h * 64 + 4 * hi;
#pragma unroll
    for (int g4 = 0; g4 < 4; ++g4) {
        u32x2 w0, w1;
        w0.x = cvtpk(bflo(gu0[g4].x) * (a0[4 * g4] + bias), bfhi(gu0[g4].x) * (a0[4 * g4 + 1] + bias)); w0.y = cvtpk(bflo(gu0[g4].y) * (a0[4 * g4 + 2] + bias), bfhi(gu0[g4].y) * (a0[4 * g4 + 3] + bias));
        w1.x = cvtpk(bflo(gu1[g4].x) * (a1[4 * g4] + bias), bfhi(gu1[g4].x) * (a1[4 * g4 + 1] + bias)); w1.y = cvtpk(bflo(gu1[g4].y) * (a1[4 * g4 + 2] + bias), bfhi(gu1[g4].y) * (a1[4 * g4 + 3] + bias));
        *(u32x2*)(op + 8 * g4) = w0; *(u32x2*)(op + 32 + 8 * g4) = w1;
    }
}
DI void gmlp_phase(const Frame& F0, LAS unsigned char* lds) {
    const Frame F = opaque(F0);
    unsigned char* ws = wsp();
    const int h = F.wave;
    const bf16_t* GUb = (const bf16_t*)(ws + WS_GUB); const bf16_t* GVb = (const bf16_t*)(ws + WS_GVB); const bf16_t* wsp = (const bf16_t*)(ws + WS_WSP);
    bf16_t* Ob = (bf16_t*)(ws + WS_H0B);
    const float* b_s = inp<I_BS>();
    LAS unsigned char* Vt = lds + F.wave * 16384;
    const int q = F.lane & 31, hi = F.lane >> 5;
    u32x4 gv[16];
#pragma unroll
    for (int rep = 0; rep < 16; ++rep) { const int c = F.lane + 64 * rep, s = c >> 3, ch = c & 7; gv[rep] = *(const u32x4*)(GVb + (size_t)(F.bid * 128 + s) * 512 + h * 64 + ch * 8); }
#pragma unroll 1
    for (int chunk = F.bid; chunk < T / 128; chunk += G) {
        const int tok0 = chunk * 128;
        int ln = F.lane; asm volatile("" : "+v"(ln));
#pragma unroll
        for (int rep = 0; rep < 16; ++rep) {
            const int c = ln + 64 * rep, s = c >> 3, ch = c & 7;
            const unsigned wv[4] = {gv[rep].x, gv[rep].y, gv[rep].z, gv[rep].w};
#pragma unroll
            for (int e = 0; e < 8; ++e) { const int d = ch * 8 + e; const unsigned short val = (unsigned short)((e & 1) ? (wv[e >> 1] >> 16) : (wv[e >> 1] & 0xffffu));
                *(LAS unsigned short*)(Vt + d * 256 + (((s >> 2) ^ (d & 31)) << 3) + (s & 3) * 2) = val; }
        }
        if (chunk + G < T / 128) {
#pragma unroll
            for (int rep = 0; rep < 16; ++rep) { const int c = F.lane + 64 * rep, s = c >> 3, ch = c & 7; gv[rep] = *(const u32x4*)(GVb + (size_t)((chunk + G) * 128 + s) * 512 + h * 64 + ch * 8); }
        }
        LDS_WAIT();
        gmlp_tb<0>(GUb, wsp, Ob, b_s, Vt, h, tok0, q, hi);
        gmlp_tb<1>(GUb, wsp, Ob, b_s, Vt, h, tok0, q, hi);
        gmlp_tb<2>(GUb, wsp, Ob, b_s, Vt, h, tok0, q, hi);
        gmlp_tb<3>(GUb, wsp, Ob, b_s, Vt, h, tok0, q, hi);
        LDS_WAIT();
    }
}

DI void p4_router(const Frame& F0, LAS unsigned char* lds) {
    const Frame F = opaque(F0);
    unsigned char* ws = wsp(); float* out = outp();
    LAS unsigned char* Whi = lds;
    LAS unsigned char* Wlo = lds + 65536;
    LAS int* cnt = (LAS int*)(lds + MISC_OFF + 256);
    { const float* w_router = inp<I_WR>();
      for (int i = F.tid; i < D * NE; i += NTHREADS) { const int c = i >> 5, e = i & 31; const float w = w_router[i];
          const unsigned h = cvtpk(w, 0.f) & 0xffffu; const unsigned l = cvtpk(w - __uint_as_float(h << 16), 0.f) & 0xffffu;
          const int off = e * 2048 + (((c >> 3) ^ (e & 15)) << 4) + (c & 7) * 2;
          *(LAS unsigned short*)(Whi + off) = (unsigned short)h; *(LAS unsigned short*)(Wlo + off) = (unsigned short)l; } }
    if (F.tid < 32) cnt[F.tid] = 0;
    __syncthreads();
    constexpr int R = T / G, rpw = R / NWAVES;
    static_assert(rpw == 32, "one 32-token MFMA block per wave");
    int* tok_e = (int*)(ws + WS_TOKE); float* tok_g = (float*)(ws + WS_TOKG); int* tok_l = (int*)(ws + WS_TOKL);
    const int lane = F.lane;
    const int tokb = F.bid * R + F.wave * rpw;
    {
        f32x4 g1[4], b1[4];
#pragma unroll
        for (int j = 0; j < 4; ++j) { g1[j] = ((const f32x4*)inp<I_LN1G>())[lane + 64 * j]; b1[j] = ((const f32x4*)inp<I_LN1B>())[lane + 64 * j]; }
        f32x4 pf[4][4];
#pragma unroll
        for (int u = 0; u < 4; ++u)
#pragma unroll
            for (int j = 0; j < 4; ++j) pf[u][j] = ((const GAS f32x4*)(out + (size_t)(tokb + u) * D))[lane + 64 * j];
#pragma unroll 1
        for (int i = 0; i < rpw; i += 4) {
#pragma unroll
            for (int u = 0; u < 4; ++u) {
                const int tok = tokb + i + u;
                f32x4 v[4];
#pragma unroll
                for (int j = 0; j < 4; ++j) v[j] = pf[u][j];
                { const int tn = (i + u + 4 < rpw) ? tok + 4 : tok;
#pragma unroll
                  for (int j = 0; j < 4; ++j) pf[u][j] = ((const GAS f32x4*)(out + (size_t)tn * D))[lane + 64 * j]; }
                float s = 0.f;
#pragma unroll
                for (int j = 0; j < 4; ++j) s += (v[j].x + v[j].y) + (v[j].z + v[j].w);
                const float mean = wave_sum(s) * (1.f / D); float s2 = 0.f;
#pragma unroll
                for (int j = 0; j < 4; ++j) { v[j] = v[j] - mean; s2 += (v[j].x * v[j].x + v[j].y * v[j].y) + (v[j].z * v[j].z + v[j].w * v[j].w); }
                const float rstd = 1.f / sqrtf(wave_sum(s2) * (1.f / D) + LN_EPS);
                float* rowp = out + (size_t)tok * D;
                GAS u32x2* hp = (GAS u32x2*)rowp + lane; GAS u32x2* lp = (GAS u32x2*)(rowp + 512) + lane;
#pragma unroll
                for (int j = 0; j < 4; ++j) {
                    v[j] = v[j] * rstd * g1[j] + b1[j];
                    u32x2 wh; wh.x = cvtpk(v[j].x, v[j].y); wh.y = cvtpk(v[j].z, v[j].w);
                    u32x2 wl; wl.x = cvtpk(v[j].x - bflo(wh.x), v[j].y - bfhi(wh.x)); wl.y = cvtpk(v[j].z - bflo(wh.y), v[j].w - bfhi(wh.y));
                    hp[64 * j] = wh; lp[64 * j] = wl;
                    ((GAS unsigned*)(ws + WS_H1Q + (size_t)tok * 1024))[lane + 64 * j] = cvt4_fp8(v[j].x, v[j].y, v[j].z, v[j].w);
                }
            }
        }
    }
    VM_WAIT();
    __builtin_amdgcn_fence(__ATOMIC_ACQUIRE, "agent");
    VM_WAIT();
    const int q = lane & 31, hi = lane >> 5;
    f32x16 acc = {};
    {
        const unsigned char* hrow = (const unsigned char*)(out + (size_t)(tokb + q) * D) + hi * 16;
        const int wbase = q * 2048;
#pragma unroll 4
        for (int s = 0; s < 64; ++s) {
            const bf16x8 bh = *(const GAS bf16x8*)(hrow + 32 * s), bl = *(const GAS bf16x8*)(hrow + 2048 + 32 * s);
            const int off = wbase + (((2 * s + hi) ^ (q & 15)) << 4);
            const bf16x8 wh = *(const LAS bf16x8*)(Whi + off), wl = *(const LAS bf16x8*)(Wlo + off);
            acc = MFMA32(wh, bh, acc); acc = MFMA32(wl, bh, acc); acc = MFMA32(wh, bl, acc);
        }
    }
    const float* b_router = inp<I_BR>();
    float lg[16];
#pragma unroll
    for (int r = 0; r < 16; ++r) lg[r] = acc[r] + b_router[crow(r, hi)];
    float ov[4]; int oi[4];
#pragma unroll
    for (int k = 0; k < 4; ++k) {
        float best = -INFINITY; int bi = 64;
#pragma unroll
        for (int r = 0; r < 16; ++r) { const bool gt = lg[r] > best; best = gt ? lg[r] : best; bi = gt ? crow(r, hi) : bi; }
#pragma unroll
        for (int r = 0; r < 16; ++r) lg[r] = (crow(r, hi) == bi) ? -INFINITY : lg[r];
        ov[k] = best; oi[k] = bi;
    }
    float cv[8]; int ci[8];
#pragma unroll
    for (int k = 0; k < 4; ++k) { cv[k] = ov[k]; ci[k] = oi[k]; cv[4 + k] = partnerf<5>(ov[k], lane); ci[4 + k] = partneri<5>(oi[k], lane); }
    float tv[4]; int ti[4];
#pragma unroll
    for (int k = 0; k < 4; ++k) {
        float best = -INFINITY; int bi = 64;
#pragma unroll
        for (int c = 0; c < 8; ++c) { const bool gt = cv[c] > best || (cv[c] == best && ci[c] < bi); best = gt ? cv[c] : best; bi = gt ? ci[c] : bi; }
#pragma unroll
        for (int c = 0; c < 8; ++c) cv[c] = (ci[c] == bi) ? -INFINITY : cv[c];
        tv[k] = best; ti[k] = bi;
    }
    if (hi == 0) {
        const float e1 = __expf(tv[1] - tv[0]), e2 = __expf(tv[2] - tv[0]), e3 = __expf(tv[3] - tv[0]);
        const float inv = 1.0f / (1.0f + e1 + e2 + e3);
        const int tok = tokb + q;
        int lp4[4];
#pragma unroll
        for (int k = 0; k < 4; ++k) lp4[k] = atomicAdd((int*)(cnt + ti[k]), 1);
        *(int4*)(tok_e + tok * 4) = make_int4(ti[0], ti[1], ti[2], ti[3]);
        *(float4*)(tok_g + tok * 4) = make_float4(inv, e1 * inv, e2 * inv, e3 * inv);
        *(int4*)(tok_l + tok * 4) = make_int4(lp4[0], lp4[1], lp4[2], lp4[3]);
    }
    __syncthreads();
    if (F.tid < 32) ((int*)(ws + WS_WGCOUNT))[F.bid * 32 + F.tid] = cnt[F.tid];
}
DI int p4b_lists(const Frame& F0, LAS unsigned char* lds) {
    const Frame F = opaque(F0);
    unsigned char* ws = wsp();
    LAS int* tab = (LAS int*)lds;
    LAS int* pstart = (LAS int*)(lds + MISC_OFF + 256);
    LAS int* mybase = pstart + 64;
    const int* wgc = (const int*)(ws + WS_WGCOUNT);
    for (int i = F.tid; i < G * 32; i += NTHREADS) tab[i] = (int)__hip_atomic_load((unsigned*)wgc + i, __ATOMIC_RELAXED, __HIP_MEMORY_SCOPE_AGENT);
    __syncthreads();
    if (F.tid < 32) { int tot = 0, mb = 0; for (int w = 0; w < G; ++w) { const int c = tab[w * 32 + F.tid]; if (w < F.bid) mb += c; tot += c; } mybase[F.tid] = mb; pstart[32 + 32 + 32 + F.tid] = tot; }
    __syncthreads();
    if (F.tid == 0) { int off = 0; for (int e = 0; e < 32; ++e) { pstart[e] = off; off += ((pstart[96 + e] + 255) >> 8) << 8; } pstart[32] = off; }
    __syncthreads();
    const int ngroups = pstart[32] >> 8;
    if (F.bid == 0) {
        int* grp_e = (int*)(ws + WS_GRPE);
        for (int g = F.tid; g < NGRP_MAX; g += NTHREADS) { int e = 0; for (int k = 1; k < 32; ++k) if (pstart[k] <= g * 256) e = k; grp_e[g] = (g < ngroups) ? e : 0; }
    }
    const int R = T / G;
    const int* tok_e = (const int*)(ws + WS_TOKE); const float* tok_g = (const float*)(ws + WS_TOKG); const int* tok_l = (const int*)(ws + WS_TOKL);
    int* slot_tok = (int*)(ws + WS_SLOTTOK); float* slot_gate = (float*)(ws + WS_SLOTGATE); int* slot_dest = (int*)(ws + WS_SLOTDEST);
    for (int i = F.tid; i < R * 4; i += NTHREADS) {
        const int idx = F.bid * R * 4 + i; const int e = tok_e[idx];
        const int slot = pstart[e] + mybase[e] + tok_l[idx];
        slot_tok[slot] = idx >> 2; slot_gate[slot] = tok_g[idx]; slot_dest[slot] = idx;
    }
    return ngroups;
}
DI void p7_final(const Frame& F0) {
    const Frame F = opaque(F0);
    unsigned char* ws = wsp(); float* out = outp();
    const bf16_t* yslot = (const bf16_t*)(ws + WS_YSLOT);
    const int gw = F.bid * NWAVES + F.wave, NGW = G * NWAVES, lane = F.lane;
    const float* ln2_g = inp<I_LN2G>(); const float* ln2_b = inp<I_LN2B>();
    for (int tok = gw; tok < T; tok += NGW) {
        float* rowp = out + (size_t)tok * D;
        f32x4 v[4];
#pragma unroll
        for (int j = 0; j < 4; ++j) {
            const u32x2 wh = ((const GAS u32x2*)rowp)[lane + 64 * j];
            v[j] = (f32x4){bflo(wh.x), bfhi(wh.x), bflo(wh.y), bfhi(wh.y)} * ALPHA;
        }
#pragma unroll
        for (int k = 0; k < 4; ++k) {
            const GAS u32x2* yp = (const GAS u32x2*)(yslot + ((size_t)tok * 4 + k) * 1024) + lane;
#pragma unroll
            for (int j = 0; j < 4; ++j) { const u32x2 w = yp[64 * j]; v[j] = v[j] + (f32x4){bflo(w.x), bfhi(w.x), bflo(w.y), bfhi(w.y)}; }
        }
        float s = 0.f;
#pragma unroll
        for (int j = 0; j < 4; ++j) s += (v[j].x + v[j].y) + (v[j].z + v[j].w);
        const float mean = wave_sum(s) * (1.f / D); float s2 = 0.f;
#pragma unroll
        for (int j = 0; j < 4; ++j) { v[j] = v[j] - mean; s2 += (v[j].x * v[j].x + v[j].y * v[j].y) + (v[j].z * v[j].z + v[j].w * v[j].w); }
        const float rstd = 1.f / sqrtf(wave_sum(s2) * (1.f / D) + LN_EPS);
#pragma unroll
        for (int j = 0; j < 4; ++j) { const f32x4 gg = ((const f32x4*)ln2_g)[lane + 64 * j], bb = ((const f32x4*)ln2_b)[lane + 64 * j];
            ((GAS f32x4*)rowp)[lane + 64 * j] = v[j] * rstd * gg + bb; }
    }
}

struct CfgIn   { static constexpr bool FP8 = false, GATHER = false; static constexpr size_t A_OFF = WS_H0B,  B_OFF = WS_WIN,  B_E_BYTES = 0; static constexpr unsigned A_PITCH = 0; };
struct CfgOut  { static constexpr bool FP8 = false, GATHER = false; static constexpr size_t A_OFF = WS_H0B,  B_OFF = WS_WOUT, B_E_BYTES = 0; static constexpr unsigned A_PITCH = 0; };
struct CfgGU   { static constexpr bool FP8 = true,  GATHER = true;  static constexpr size_t A_OFF = WS_H1Q,  B_OFF = WS_WGU,  B_E_BYTES = (size_t)2048 * D; static constexpr unsigned A_PITCH = 1024u; };
struct CfgDown { static constexpr bool FP8 = true,  GATHER = false; static constexpr size_t A_OFF = WS_HMID, B_OFF = WS_WD,   B_E_BYTES = (size_t)D * D; static constexpr unsigned A_PITCH = 0; };
#ifndef PHASE_MASK
#define PHASE_MASK 0xFFFF
#endif
struct Args { const void* in[23]; float* out; unsigned char* ws; };
__global__ void __launch_bounds__(NTHREADS, 2) mk_fwd(Args args) {
    __shared__ __attribute__((aligned(16))) unsigned char lds_raw[LDS_BYTES];
    LAS unsigned char* lds = (LAS unsigned char*)lds_raw;
    Frame F;
    F.tid = threadIdx.x; F.lane = F.tid & 63; F.wave = __builtin_amdgcn_readfirstlane(F.tid >> 6); F.bid = blockIdx.x;
    volatile LAS unsigned* MISC = (volatile LAS unsigned*)(lds + MISC_OFF);
    if (F.tid < 64) MISC[F.tid] = 0u;
    __syncthreads();
    xcd_barrier_post((unsigned*)(wsp() + WS_CTL) + CW_BAR);
    volatile LAS unsigned* bst = MISC + 8;
#ifdef PROBE_A
    int n_stamp = 0;
#define STAMP() do { if (F.bid == 0 && F.tid == 0) { __hip_atomic_store((unsigned long long*)(wsp() + WS_CTL + 32768) + n_stamp, (unsigned long long)__builtin_amdgcn_s_memrealtime(), __ATOMIC_RELAXED, __HIP_MEMORY_SCOPE_AGENT); } ++n_stamp; } while (0)
#else
#define STAMP() do {} while (0)
#endif
    STAMP();
    LAS unsigned char* tokbuf = lds + TOKBUF_OFF;

    if (PHASE_MASK & 1) p0_prologue(F, lds);
    xcd_barrier(bst); STAMP();
    if (PHASE_MASK & 2) { pg8::StaticOrder<T, INW> S{F.bid}; EpiInProj E; pg8::gemm_phase<CfgIn>(lds, tokbuf, 0, S, E); }
    xcd_barrier(bst); STAMP();
    if (PHASE_MASK & 4) attn_phase(F, lds);
    if (PHASE_MASK & 8) gmlp_phase(F, lds);
    xcd_barrier(bst); STAMP();
    if (PHASE_MASK & 16) { pg8::StaticOrder<T, D> S{F.bid}; EpiOut E; pg8::gemm_phase<CfgOut>(lds, tokbuf, 0, S, E); }
    xcd_barrier(bst); STAMP();
    if (PHASE_MASK & 32) p4_router(F, lds);
    xcd_barrier(bst); STAMP();
    int ngroups = 1040; if (PHASE_MASK & 64) ngroups = p4b_lists(F, lds);
    xcd_barrier(bst); STAMP();
    if (PHASE_MASK & 128) { pg8::GroupOrder<8> S{0, ngroups, F.bid}; EpiGateUp E; pg8::gemm_phase<CfgGU>(lds, tokbuf, 0, S, E); }
    xcd_barrier(bst); STAMP();
    if (PHASE_MASK & 256) { pg8::GroupOrder<4> S{0, ngroups, F.bid}; EpiDown E; pg8::gemm_phase<CfgDown>(lds, tokbuf, 0, S, E); }
    xcd_barrier(bst); STAMP();
    if (PHASE_MASK & 512) p7_final(F);
#ifdef PROBE_A
    STAMP();
    if (F.bid == 0 && F.tid == 0) {
        unsigned long long* ts = (unsigned long long*)(wsp() + WS_CTL + 32768);
        unsigned long long extra = 0ull;
        for (int k = 1; k < 12; ++k) if ((PROBE_A >> k) & 1) extra += __hip_atomic_load(ts + k, __ATOMIC_RELAXED, __HIP_MEMORY_SCOPE_AGENT) - __hip_atomic_load(ts + k - 1, __ATOMIC_RELAXED, __HIP_MEMORY_SCOPE_AGENT);
        const unsigned long long t0 = __builtin_amdgcn_s_memrealtime();
        while (__builtin_amdgcn_s_memrealtime() - t0 < extra) __builtin_amdgcn_s_sleep(8);
    }
#endif
}

extern "C" void kernel_launch(void* const* d_in, const int* in_sizes, int n_in, void* d_out, int out_size, void* d_ws, size_t ws_size, hipStream_t stream) {
    static int grid = 0;
    if (grid == 0) {
        if (n_in != 23 || in_sizes[0] != T * D || out_size != T * D || ws_size < WS_END) {
            fprintf(stderr, "kernel_launch: unexpected shapes/workspace (n_in %d, in0 %d, out %d, ws %zu, need %zu); nothing launched\n", n_in, n_in > 0 ? in_sizes[0] : -1, out_size, ws_size, (size_t)WS_END);
            grid = -1; return;
        }
        int dev = 0, cus = 0, per_cu = 0;
        if (hipGetDevice(&dev) != hipSuccess || hipDeviceGetAttribute(&cus, hipDeviceAttributeMultiprocessorCount, dev) != hipSuccess) { grid = -1; return; }
        if (hipOccupancyMaxActiveBlocksPerMultiprocessor(&per_cu, (const void*)mk_fwd, NTHREADS, 0) != hipSuccess || per_cu < 1) {
            fprintf(stderr, "kernel_launch: occupancy query says %d blocks per CU; nothing launched\n", per_cu); (void)hipGetLastError(); grid = -1; return;
        }
        grid = cus;
        if (grid != G) { fprintf(stderr, "kernel_launch: built for a 256-CU device, found %d; nothing launched\n", cus); grid = -1; return; }
    }
    if (grid < 0) return;
    if (hipMemsetAsync((char*)d_ws + WS_CTL, 0, CTL_ZERO_BYTES, stream) != hipSuccess) return;
    Args a{};
    for (int i = 0; i < 23; ++i) a.in[i] = d_in[i];
    a.out = (float*)d_out; a.ws = (unsigned char*)d_ws;
    hipLaunchKernelGGL(mk_fwd, dim3(grid), dim3(NTHREADS), 0, stream, a);
}
```

```cpp
#include <hip/hip_runtime.h>
#include <cstdio>
#include <cstdint>
#include <type_traits>

#define DI __device__ __forceinline__
#define LAS __attribute__((address_space(3)))
#define GAS __attribute__((address_space(1)))
typedef unsigned short bf16_t;
typedef short bf16x8 __attribute__((ext_vector_type(8)));
typedef short s16x4 __attribute__((ext_vector_type(4)));
typedef float f32x2 __attribute__((ext_vector_type(2)));
typedef float f32x4 __attribute__((ext_vector_type(4)));
typedef float f32x16 __attribute__((ext_vector_type(16)));
typedef unsigned u32x2 __attribute__((ext_vector_type(2)));
typedef unsigned u32x4 __attribute__((ext_vector_type(4)));
typedef __bf16 bf16x2_t __attribute__((ext_vector_type(2)));
typedef GAS unsigned gu32;
typedef int v8i __attribute__((ext_vector_type(8)));

constexpr int D = 1024, SEQ = 4096, NBATCH = 16, T = NBATCH * SEQ;
constexpr int INW = 1792, NE = 32;
constexpr int NSLOT = T * 4 + NE * 256;
constexpr int NGRP_MAX = NSLOT / 256;
constexpr float LN_EPS = 1e-5f;
constexpr float ALPHA = 1.189207115002721f;
constexpr float LOG2E = 1.4426950408889634f;
constexpr float QSCALE = 0.125f * LOG2E;
constexpr float WQ_SCALE = 64.0f;
constexpr int WQ_E8M0 = 127 - 6;
constexpr int NWAVES = 8, NTHREADS = 512;

constexpr size_t MiB = 1u << 20;
constexpr size_t WS_CTL = 0, CTL_ZERO_BYTES = 65536;
constexpr size_t WS_WGCOUNT = 1 * MiB;
constexpr size_t WS_GRPE = 1 * MiB + 65536;
constexpr size_t WS_OUTC = 1 * MiB + 131072;
constexpr size_t WS_WIN = 2 * MiB;
constexpr size_t WS_WOUT = 6 * MiB;
constexpr size_t WS_WSP = 8 * MiB;
constexpr size_t WS_STATS0 = 9 * MiB;
constexpr size_t WS_BINP = 10 * MiB;
constexpr size_t WS_POSF = 10 * MiB + 65536;
constexpr size_t WS_BGU = 11 * MiB;
constexpr size_t WS_BD = 12 * MiB;
constexpr size_t WS_WGU = 16 * MiB;
constexpr size_t WS_WD = 80 * MiB;
constexpr size_t WS_H1Q = 112 * MiB;
constexpr size_t WS_TOKE = 208 * MiB;
constexpr size_t WS_TOKG = 209 * MiB;
constexpr size_t WS_TOKL = 210 * MiB;
constexpr size_t WS_SLOTTOK = 211 * MiB;
constexpr size_t WS_SLOTGATE = 212 * MiB + 512 * 1024;
constexpr size_t WS_SLOTDEST = 214 * MiB;
constexpr size_t WS_H0B = 216 * MiB;
constexpr size_t WS_QB = 344 * MiB;
constexpr size_t WS_KB = 408 * MiB;
constexpr size_t WS_VB = 424 * MiB;
constexpr size_t WS_GUB = 440 * MiB;
constexpr size_t WS_GVB = 504 * MiB;
constexpr size_t WS_YSLOT = 216 * MiB;
constexpr size_t WS_HMID = 728 * MiB;
constexpr size_t WS_END = 1024 * MiB;
static_assert(WS_HMID + (size_t)NSLOT * 1024 <= WS_END && WS_H1Q + (size_t)T * 1024 <= 208 * MiB, "ws map");
static_assert(WS_YSLOT + (size_t)T * 4 * 1024 * 2 <= WS_HMID, "ws map");
constexpr int CW_BAR = 4096;

constexpr int RING_BYTES = 131072;
constexpr int MISC_OFF = RING_BYTES;
constexpr int TOKBUF_OFF = MISC_OFF + 1024;
constexpr int EPIBUF_OFF = MISC_OFF + 4096, EPIBUF_SZ = 4096;
constexpr int LDS_BYTES = 147456;

DI unsigned cvtpk(float lo, float hi) { f32x2 v = {lo, hi}; bf16x2_t b = __builtin_convertvector(v, bf16x2_t); return __builtin_bit_cast(unsigned, b); }
DI unsigned cvt4_fp8(float a, float b, float c, float d) { int p = __builtin_amdgcn_cvt_pk_fp8_f32(a, b, 0, false); p = __builtin_amdgcn_cvt_pk_fp8_f32(c, d, p, true); return (unsigned)p; }
DI float bf2f(unsigned short h) { return __uint_as_float((unsigned)h << 16); }
DI float bflo(unsigned w) { return __uint_as_float(w << 16); }
DI float bfhi(unsigned w) { return __uint_as_float(w & 0xffff0000u); }
template <int CTRL> DI float dppf(float v) { return __builtin_bit_cast(float, __builtin_amdgcn_update_dpp(0, __builtin_bit_cast(int, v), CTRL, 0xf, 0xf, false)); }
DI void swap32(float& a, float& b) { asm("s_nop 1\n\tv_permlane32_swap_b32 %0, %1" : "+v"(a), "+v"(b)); }
DI void swap16(float& a, float& b) { asm("s_nop 1\n\tv_permlane16_swap_b32 %0, %1" : "+v"(a), "+v"(b)); }
template <int CTRL> DI int dppi(int v) { return __builtin_amdgcn_update_dpp(0, v, CTRL, 0xf, 0xf, false); }
constexpr int DPP_XOR1 = 0xB1, DPP_XOR2 = 0x4E, DPP_HMIRROR = 0x141, DPP_MIRROR = 0x140;
template <int LV> DI float partnerf(float v, int lane) {
    if constexpr (LV == 0) return dppf<DPP_XOR1>(v);
    else if constexpr (LV == 1) return dppf<DPP_XOR2>(v);
    else if constexpr (LV == 2) return dppf<DPP_HMIRROR>(v);
    else if constexpr (LV == 3) return dppf<DPP_MIRROR>(v);
    else if constexpr (LV == 4) { float a = v, b = v; swap16(a, b); return (lane & 16) ? a : b; }
    else { float a = v, b = v; swap32(a, b); return (lane & 32) ? a : b; }
}
template <int LV> DI int partneri(int v, int lane) { return __builtin_bit_cast(int, partnerf<LV>(__builtin_bit_cast(float, v), lane)); }
DI float wave_sum(float v) {
    v += dppf<DPP_XOR1>(v); v += dppf<DPP_XOR2>(v); v += dppf<DPP_HMIRROR>(v); v += dppf<DPP_MIRROR>(v);
    { float a = v, b = v; swap16(a, b); v = a + b; }
    { float a = v, b = v; swap32(a, b); v = a + b; }
    return v;
}
#define LDS_WAIT() asm volatile("s_waitcnt lgkmcnt(0)" ::: "memory")
#define VM_WAIT() asm volatile("s_waitcnt vmcnt(0)" ::: "memory")

DI f32x2 gelu_pk(f32x2 v) {
    const f32x2 av = __builtin_elementwise_abs(v), d = av * 0.2316418882f + 1.0f;
    f32x2 t; t.x = __builtin_amdgcn_rcpf(d.x); t.y = __builtin_amdgcn_rcpf(d.y);
    f32x2 q = t * 0.5307027145f + (-0.7265760135f); q = q * t + 0.7107068705f; q = q * t + (-0.142248368f); q = q * t + 0.127414796f; q = q * t;
    const f32x2 s = (v * v) * (-0.72134752044f);
    f32x2 e; e.x = __builtin_amdgcn_exp2f(s.x); e.y = __builtin_amdgcn_exp2f(s.y);
    const f32x2 m = v * (q * e), r = v - m;
    f32x2 o; o.x = v.x < 0.f ? m.x : r.x; o.y = v.y < 0.f ? m.y : r.y; return o;
}
DI f32x4 gelu4(f32x4 v) { f32x2 a = gelu_pk((f32x2){v[0], v[1]}), b = gelu_pk((f32x2){v[2], v[3]}); return (f32x4){a.x, a.y, b.x, b.y}; }


struct Frame { int tid, lane, wave, bid; };
DI Frame opaque(const Frame& f) { Frame r; r.tid = threadIdx.x; asm volatile("" : "+v"(r.tid)); r.lane = r.tid & 63; r.wave = __builtin_amdgcn_readfirstlane(r.tid >> 6); r.bid = f.bid; return r; }
constexpr int G = 256;
template <int K> DI const float* inp() { const float* p; asm volatile("s_load_dwordx2 %0, %1, %2\n\ts_waitcnt lgkmcnt(0)" : "=s"(p) : "s"(__builtin_amdgcn_kernarg_segment_ptr()), "i"(K * 8)); return p; }
DI float* outp() { float* p; asm volatile("s_load_dwordx2 %0, %1, %2\n\ts_waitcnt lgkmcnt(0)" : "=s"(p) : "s"(__builtin_amdgcn_kernarg_segment_ptr()), "i"(23 * 8)); return p; }
DI unsigned char* wsp() { unsigned char* p; asm volatile("s_load_dwordx2 %0, %1, %2\n\ts_waitcnt lgkmcnt(0)" : "=s"(p) : "s"(__builtin_amdgcn_kernarg_segment_ptr()), "i"(24 * 8)); return p; }
enum { I_X = 0, I_POS = 1, I_LNING = 2, I_LNINB = 3, I_WIN = 4, I_BIN = 5, I_SINKS = 6, I_GNG = 7, I_GNB = 8, I_WS = 9, I_BS = 10, I_WOUT = 11, I_BOUT = 12, I_LN1G = 13, I_LN1B = 14,
       I_WR = 15, I_BR = 16, I_WGU = 17, I_BGU = 18, I_WD = 19, I_BD = 20, I_LN2G = 21, I_LN2B = 22 };

#define XB_TMO      128
#define XB_XCNT(j)  (256  + 64 * (j))
#define XB_XSUB(j)  (1280 + 64 * (j))
#define XB_XGEN(j)  (2304 + 64 * (j))
#define XB_TOP      3328
#define XB_TOPGEN   3392
#define XCD_BAR_WORDS 3456
#define XB_SPIN_CAP (1u << 18)
DI unsigned xb_ld(unsigned* p)              { return __hip_atomic_load(p, __ATOMIC_RELAXED, __HIP_MEMORY_SCOPE_AGENT); }
DI unsigned xb_add(unsigned* p, unsigned v) { return __hip_atomic_fetch_add(p, v, __ATOMIC_RELAXED, __HIP_MEMORY_SCOPE_AGENT); }
DI unsigned xb_xcc_id() { return (unsigned)__builtin_amdgcn_s_getreg((3 << 11) | 20) & 0xFu; }
#define XB_SPIN(cond, bar) do { unsigned _sp = 0; while (cond) { __builtin_amdgcn_s_sleep(1); \
    if ((++_sp & 255u) == 0u) { if (xb_ld(&(bar)[XB_TMO])) break; if (_sp > XB_SPIN_CAP) { atomicAdd(&(bar)[XB_TMO], 1u); break; } } } } while (0)
DI void xcd_barrier_post(unsigned* bar) { if (threadIdx.x == 0) (void)xb_add(&bar[XB_XCNT(xb_xcc_id())], 1u); }
DI void xcd_barrier_complete(unsigned* bar, unsigned x, unsigned& nloc, unsigned& nx) {
    unsigned sum, cnt, mine, sp = 0u;
    for (;;) {
        sum = 0u; cnt = 0u; mine = 0u;
#pragma unroll
        for (unsigned j = 0; j < 16; ++j) { const unsigned c = xb_ld(&bar[XB_XCNT(j)]); sum += c; cnt += (c > 0u) ? 1u : 0u; mine = (j == x) ? c : mine; }
        if (sum == (unsigned)G) break;
        __builtin_amdgcn_s_sleep(1);
        if ((++sp & 255u) == 0u) { if (xb_ld(&bar[XB_TMO])) break; if (sp > XB_SPIN_CAP) { atomicAdd(&bar[XB_TMO], 1u); break; } }
    }
    nloc = mine > 0u ? mine : 1u; nx = cnt > 0u ? cnt : 1u;
}
DI void xcd_barrier(volatile LAS unsigned* st) {
    asm volatile("s_waitcnt vmcnt(0)" ::: "memory");
    __syncthreads();
    if (threadIdx.x == 0) {
        unsigned* bar = (unsigned*)(wsp() + WS_CTL) + CW_BAR; const unsigned x = xb_xcc_id();
        __builtin_amdgcn_s_waitcnt(0);
        unsigned nloc = st[0], nx = st[1];
        if (nloc == 0u) { xcd_barrier_complete(bar, x, nloc, nx); st[0] = nloc; st[1] = nx; }
        const unsigned old = xb_add(&bar[XB_XSUB(x)], 1u);
        const unsigned gen = old / nloc;
        if (old + 1u == (gen + 1u) * nloc) {
            __builtin_amdgcn_fence(__ATOMIC_RELEASE, "agent");
            asm volatile("s_waitcnt vmcnt(0)" ::: "memory");
            const unsigned og = xb_add(&bar[XB_TOP], 1u);
            const unsigned tg = og / nx;
            if (og + 1u == (tg + 1u) * nx) xb_add(&bar[XB_TOPGEN], 1u);
            else XB_SPIN(xb_ld(&bar[XB_TOPGEN]) == tg, bar);
            __builtin_amdgcn_fence(__ATOMIC_ACQUIRE, "agent");
            xb_add(&bar[XB_XGEN(x)], 1u);
            asm volatile("s_waitcnt vmcnt(0)" ::: "memory");
        } else {
            XB_SPIN(xb_ld(&bar[XB_XGEN(x)]) == gen, bar);
            __builtin_amdgcn_fence(__ATOMIC_ACQUIRE, "agent");
            asm volatile("s_waitcnt vmcnt(0)" ::: "memory");
        }
    }
    __syncthreads();
}

namespace pg8 {
constexpr int BM = 256, HALF = 128, HTB = HALF * 128, NXCD = 8, WGM = 8, GK = 1024;
constexpr size_t KSTEP = 128;
DI int lds_byte(int r, int c) { const int st = (r >> 4) * 2 + (c >> 5), rr = r & 15, cc = c & 31, ob = rr * 64 + cc * 2; return st * 1024 + (ob ^ (((ob >> 9) & 1) << 5)); }
DI void stage_rc(int b, int& R, int& C) { const int st = b / 1024, sb = b % 1024, swz = sb ^ (((sb >> 9) & 1) << 5); R = (st >> 1) * 16 + swz / 64; C = (st & 1) * 32 + (swz % 64) / 2; }
DI int perm32(int rho) { const int n = rho >> 4, i = rho & 15; return 8 * (i >> 2) + 4 * n + (i & 3); }

struct Unit { int pm, pn, e; };

template <int M, int N> struct StaticOrder {
    int c;
    DI bool next(int i, Unit& u) const {
        constexpr int nM = M / BM, nN = N / BM, nwg = nM * nN;
        const int L = i * G + c; if (L >= nwg) return false;
        int wgid = L; { constexpr int q = nwg / NXCD, r = nwg % NXCD; const int xcd = wgid % NXCD, off = wgid / NXCD; wgid = (xcd < r ? xcd * (q + 1) : r * (q + 1) + (xcd - r) * q) + off; }
        constexpr int nig = WGM * nN; const int gid = wgid / nig, fm = gid * WGM, gsz = (nM - fm) < WGM ? (nM - fm) : WGM;
        u.pm = fm + ((wgid % nig) % gsz); u.pn = (wgid % nig) / gsz; u.e = 0; return true;
    }
};
template <int NPN> struct GroupOrder {
    int g0, g1, c;
    DI bool next(int i, Unit& u) const {
        constexpr int GPX = 32 / NPN;
        const int x = c & 7, j = c >> 3;
        const int g = g0 + i * (8 * GPX) + x * GPX + j / NPN;
        if (g >= g1) return false;
        u.pm = g; u.pn = j % NPN;
        u.e = __builtin_amdgcn_readfirstlane((int)__hip_atomic_load((unsigned*)(wsp() + WS_GRPE) + g, __ATOMIC_RELAXED, __HIP_MEMORY_SCOPE_AGENT));
        return true;
    }
};
DI void piece_rc(int i, int& R, int& C) { int t = threadIdx.x; asm volatile("" : "+v"(t)); stage_rc(t * 16 + i * 8192, R, C); }
DI unsigned tok_off(const LAS int* tb, int h, int i, unsigned pitch) { int R, C; piece_rc(i, R, C); int tok = tb[h * HALF + R]; tok = tok < 0 ? 0 : tok; return (unsigned)tok * pitch + (unsigned)C * 2u; }

struct FragBF { bf16x8 k0, k1; };
struct FragF8 { v8i v; };
DI void ldfrag(FragBF& f, const LAS unsigned char* p) { f.k0 = *(const LAS bf16x8*)p; f.k1 = *(const LAS bf16x8*)(p + 1024); }
typedef int v8i_a16 __attribute__((ext_vector_type(8), aligned(16)));
DI void ldfrag(FragF8& f, const LAS unsigned char* p) { f.v = *(const LAS v8i_a16*)p; }
DI void mma(f32x4& acc, const FragBF& w, const FragBF& a) { acc = __builtin_amdgcn_mfma_f32_16x16x32_bf16(w.k0, a.k0, acc, 0, 0, 0); acc = __builtin_amdgcn_mfma_f32_16x16x32_bf16(w.k1, a.k1, acc, 0, 0, 0); }
DI void mma(f32x4& acc, const FragF8& w, const FragF8& a) { acc = __builtin_amdgcn_mfma_scale_f32_16x16x128_f8f6f4(w.v, a.v, acc, 0, 0, 0, WQ_E8M0, 0, 127); }
template <class Cfg, class Epi, class Sched>
DI void gemm_phase(LAS unsigned char* lds, LAS unsigned char* tokbuf, const int pm_bias, const Sched& S, const Epi& E) {
    constexpr bool GATHER = Cfg::GATHER, FP8 = Cfg::FP8;
    constexpr int ROWB = FP8 ? GK : 2 * GK, NT = ROWB / 128;
    constexpr size_t HSTEP = (size_t)HALF * ROWB, TSTEP = 2 * HSTEP;
    using Frag = typename std::conditional<FP8, FragF8, FragBF>::type;
    int tid = threadIdx.x; asm volatile("" : "+v"(tid));
    const int wid = __builtin_amdgcn_readfirstlane(tid >> 6), lane = tid & 63, wr = wid >> 2, wc = wid & 3, fr = lane & 15, fq = lane >> 4;
    unsigned voffB[2], vaC[2][2];
#pragma unroll
    for (int i = 0; i < 2; ++i) { int R, C; stage_rc(tid * 16 + i * 8192, R, C); const int Rb = Epi::PERM ? ((R & ~31) + perm32(R & 31)) : R;
        voffB[i] = (unsigned)(Rb * ROWB + C * 2); vaC[0][i] = (unsigned)(R * ROWB + C * 2); vaC[1][i] = vaC[0][i]; }
    constexpr size_t AHSTEP = GATHER ? (size_t)0 : HSTEP;
    const unsigned ldsw = (unsigned)wid * 1024u;
    const int cfr = FP8 ? (fq >> 1) * 32 + (fq & 1) * 16 : fq * 8;
    const int aoff = lds_byte(wr * 64 + fr, cfr);
    int boff = lds_byte(wc * 32 + fr, cfr) + 4 * HTB; asm volatile("" : "+v"(boff));
#define PG8_SA(b, h) (((b) * 2 + (h)) * HTB)
#define PG8_SB(b, h) ((4 + (b) * 2 + (h)) * HTB)
    const __amdgpu_buffer_rsrc_t rs = __builtin_amdgcn_make_buffer_rsrc((void*)wsp(), 0, 0x40000000, 0x00020000);
#define PG8_STAGEB(bufoff, soff) do { _Pragma("unroll") for (int _i = 0; _i < 2; ++_i) \
        __builtin_amdgcn_raw_ptr_buffer_load_lds(rs, (LAS void*)(lds + (bufoff) + ldsw + _i * 8192), 16, voffB[_i], (int)(soff), 0, 0); } while (0)
#define PG8_STAGEA(bufoff, soff, o0, o1) do { \
        __builtin_amdgcn_raw_ptr_buffer_load_lds(rs, (LAS void*)(lds + (bufoff) + ldsw), 16, (o0), (int)(soff), 0, 0); \
        __builtin_amdgcn_raw_ptr_buffer_load_lds(rs, (LAS void*)(lds + (bufoff) + ldsw + 8192), 16, (o1), (int)(soff), 0, 0); } while (0)
#define PG8_LDA(dst, b, h) do { _Pragma("unroll") for (int m = 0; m < 4; ++m) ldfrag(dst[m], lds + PG8_SA(b, h) + aoff + m * 2048); } while (0)
#define PG8_LDB(dst, b, h) do { _Pragma("unroll") for (int n = 0; n < 2; ++n) ldfrag(dst[n], lds + ((b) * 2 + (h)) * HTB + boff + n * 2048); } while (0)
#define PG8_MMA(ai, bj, At, Bt) do { __builtin_amdgcn_s_setprio(1); _Pragma("unroll") for (int m = 0; m < 4; ++m) _Pragma("unroll") for (int n = 0; n < 2; ++n) \
        mma(acc[ai][bj][m][n], Bt[n], At[m]); __builtin_amdgcn_s_setprio(0); } while (0)
#define PG8_WAIT_V(n) asm volatile("s_waitcnt vmcnt(" #n ")" ::: "memory")
#define PG8_WAIT_L(n) asm volatile("s_waitcnt lgkmcnt(" #n ")" ::: "memory")
#define PG8_BAR __builtin_amdgcn_s_barrier()
#define PG8_SCHED __builtin_amdgcn_sched_barrier(0)
#define PG8_ABASE(u) (GATHER ? (unsigned)Cfg::A_OFF : (unsigned)(Cfg::A_OFF + (size_t)((u).pm - pm_bias) * TSTEP))
#define PG8_BBASE(u) ((unsigned)(Cfg::B_OFF + (size_t)(u).e * Cfg::B_E_BYTES + (size_t)(u).pn * TSTEP))
#define PG8_TOKDMA(u, dst) __builtin_amdgcn_raw_ptr_buffer_load_lds(rs, (LAS void*)(dst), 16, (unsigned)lane * 16u, (int)(WS_SLOTTOK + (size_t)(u).pm * 1024), 0, 0)
    Unit cur, nxt; int ui = 0;
    if (!S.next(0, cur)) return;
    if constexpr (GATHER) {
        if (wid == 0) PG8_TOKDMA(cur, tokbuf);
        PG8_WAIT_V(0); PG8_BAR;
#pragma unroll
        for (int h = 0; h < 2; ++h)
#pragma unroll
            for (int i = 0; i < 2; ++i) vaC[h][i] = tok_off((const LAS int*)tokbuf, h, i, Cfg::A_PITCH);
        PG8_WAIT_L(0); PG8_BAR;
    }
    f32x4 acc[2][2][4][2];
#pragma unroll
    for (int a = 0; a < 2; ++a)
#pragma unroll
        for (int b = 0; b < 2; ++b)
#pragma unroll
            for (int m = 0; m < 4; ++m)
#pragma unroll
                for (int n = 0; n < 2; ++n) acc[a][b][m][n] = (f32x4){0.f, 0.f, 0.f, 0.f};
    Frag At[4], B0[2], B1[2];
    unsigned cA = PG8_ABASE(cur);
    unsigned cB = PG8_BBASE(cur);
    PG8_STAGEB(PG8_SB(0, 0), cB); PG8_STAGEB(PG8_SB(0, 1), cB + (unsigned)HSTEP); PG8_STAGEA(PG8_SA(0, 0), cA, vaC[0][0], vaC[0][1]); PG8_STAGEA(PG8_SA(0, 1), cA + (unsigned)AHSTEP, vaC[1][0], vaC[1][1]);
    if (wr == 1) PG8_BAR;
    PG8_WAIT_V(2); PG8_BAR;
    PG8_STAGEB(PG8_SB(1, 0), cB + (unsigned)KSTEP); PG8_STAGEA(PG8_SA(1, 0), cA + (unsigned)KSTEP, vaC[0][0], vaC[0][1]); PG8_STAGEB(PG8_SB(1, 1), cB + (unsigned)(HSTEP + KSTEP));
    PG8_WAIT_V(6); PG8_BAR;
    for (;;) {
        const bool has_next = S.next(ui + 1, nxt);
        const LAS int* tbn = (const LAS int*)(tokbuf + ((ui + 1) & 1) * 1024);
        if constexpr (Epi::PREFETCH) E.prefetch(rs, lds, cur, ui, wid, lane);
        if constexpr (GATHER) {
            if (has_next && wid == 0) PG8_TOKDMA(nxt, tokbuf + ((ui + 1) & 1) * 1024);
        }
        asm volatile(".p2align 8" ::: "memory");
#pragma unroll 1
        for (int t = 0; t < NT; t += 2) {
            const bool last = (t == NT - 2);
            const unsigned a1 = cA + (unsigned)(t + 1) * (unsigned)KSTEP;
            unsigned a2 = cA + (unsigned)(t + 2) * (unsigned)KSTEP, b2 = cB + (unsigned)(t + 2) * (unsigned)KSTEP;
            if (last) {
                if (has_next) { a2 = PG8_ABASE(nxt); b2 = PG8_BBASE(nxt);
                    if constexpr (GATHER) { vaC[0][0] = tok_off(tbn, 0, 0, Cfg::A_PITCH); vaC[0][1] = tok_off(tbn, 0, 1, Cfg::A_PITCH); } }
                else { a2 = cA; b2 = cB; }
            }
            const unsigned a3 = a2 + (unsigned)KSTEP, b3 = b2 + (unsigned)KSTEP;
            PG8_LDB(B0, 0, 0); PG8_LDB(B1, 0, 1); PG8_SCHED; PG8_LDA(At, 0, 0); PG8_STAGEA(PG8_SA(1, 1), a1 + (unsigned)AHSTEP, vaC[1][0], vaC[1][1]);
            if constexpr (GATHER) { if (last && has_next) { vaC[1][0] = tok_off(tbn, 1, 0, Cfg::A_PITCH); vaC[1][1] = tok_off(tbn, 1, 1, Cfg::A_PITCH); } }
            PG8_WAIT_V(8); PG8_WAIT_L(0); PG8_BAR; PG8_MMA(0, 0, At, B0); PG8_MMA(0, 1, At, B1); PG8_BAR; PG8_SCHED;
            PG8_LDA(At, 0, 1); PG8_STAGEB(PG8_SB(0, 0), b2); PG8_STAGEB(PG8_SB(0, 1), b2 + (unsigned)HSTEP); PG8_STAGEA(PG8_SA(0, 0), a2, vaC[0][0], vaC[0][1]);
            PG8_WAIT_V(8); PG8_WAIT_L(0); PG8_BAR; PG8_MMA(1, 0, At, B0); PG8_MMA(1, 1, At, B1); PG8_BAR; PG8_SCHED;
            PG8_LDB(B0, 1, 0); PG8_LDB(B1, 1, 1); PG8_SCHED; PG8_LDA(At, 1, 0); PG8_STAGEA(PG8_SA(0, 1), a2 + (unsigned)AHSTEP, vaC[1][0], vaC[1][1]);
            PG8_WAIT_V(8); PG8_WAIT_L(0); PG8_BAR; PG8_MMA(0, 0, At, B0); PG8_MMA(0, 1, At, B1); PG8_BAR; PG8_SCHED;
            PG8_LDA(At, 1, 1); PG8_STAGEB(PG8_SB(1, 0), b3); PG8_STAGEB(PG8_SB(1, 1), b3 + (unsigned)HSTEP); PG8_STAGEA(PG8_SA(1, 0), a3, vaC[0][0], vaC[0][1]);
            PG8_WAIT_V(8); PG8_WAIT_L(0); PG8_BAR; PG8_MMA(1, 0, At, B0); PG8_MMA(1, 1, At, B1); PG8_BAR; PG8_SCHED;
        }
        if (wr == 0) PG8_BAR;
        E(acc, cur, wr, wc, fr, fq, lds, ui);
        if (!has_next) break;
#pragma unroll
        for (int a = 0; a < 2; ++a)
#pragma unroll
            for (int b = 0; b < 2; ++b)
#pragma unroll
                for (int m = 0; m < 4; ++m)
#pragma unroll
                    for (int n = 0; n < 2; ++n) acc[a][b][m][n] = (f32x4){0.f, 0.f, 0.f, 0.f};
        cur = nxt; cA = PG8_ABASE(cur); cB = PG8_BBASE(cur); ++ui;
        if (wr == 1) PG8_BAR;
    }
    PG8_WAIT_V(0);
    PG8_BAR;
#undef PG8_SA
#undef PG8_SB
#undef PG8_STAGEA
#undef PG8_STAGEB
#undef PG8_LDA
#undef PG8_LDB
#undef PG8_MMA
#undef PG8_WAIT_V
#undef PG8_WAIT_L
#undef PG8_BAR
#undef PG8_SCHED
#undef PG8_ABASE
#undef PG8_BBASE
#undef PG8_TOKDMA
}
}

#define EPI_DMA(w, dstoff, wsoff) do { if (wid == (w)) __builtin_amdgcn_raw_ptr_buffer_load_lds(rs, (LAS void*)(eb + (dstoff)), 16, (unsigned)lane * 16u, (int)(wsoff), 0, 0); } while (0)
struct EpiInProj {
    static constexpr bool PERM = true, PREFETCH = true;
    DI void prefetch(const __amdgpu_buffer_rsrc_t rs, LAS unsigned char* lds, const pg8::Unit& u, int ui, int wid, int lane) const {
        LAS unsigned char* eb = lds + EPIBUF_OFF + (ui & 1) * EPIBUF_SZ;
        EPI_DMA(1, 0, WS_BINP + (size_t)u.pn * 1024); EPI_DMA(2, 1024, WS_POSF + (size_t)u.pm * 1024);
    }
    DI void operator()(f32x4 (&acc)[2][2][4][2], const pg8::Unit& u, int wr, int wc, int fr, int fq, LAS unsigned char* lds, int ui) const {
        const int pn = u.pn;
        int kind, head, ldc; size_t boff;
        if (pn < 2) { kind = 0; head = 4 * pn + wc; boff = WS_QB; ldc = 512; }
        else if (pn == 2) { if (wc < 2) { kind = 1; head = wc; boff = WS_KB; } else { kind = 2; head = wc - 2; boff = WS_VB; } ldc = 128; }
        else if (pn < 5) { kind = 3; head = 4 * (pn - 3) + wc; boff = WS_GUB; ldc = 512; }
        else { kind = 4; head = 4 * (pn - 5) + wc; boff = WS_GVB; ldc = 512; }
        bf16_t* base = (bf16_t*)(wsp() + boff);
        const LAS float* bbuf = (const LAS float*)(lds + EPIBUF_OFF + (ui & 1) * EPIBUF_SZ); const LAS float* pbuf = bbuf + 256;
#pragma unroll
        for (int bj = 0; bj < 2; ++bj)
#pragma unroll
            for (int n = 0; n < 2; ++n) { const f32x4 bv = *(const LAS f32x4*)(bbuf + 128 * bj + 32 * wc + 8 * fq + 4 * n);
#pragma unroll
                for (int ai = 0; ai < 2; ++ai)
#pragma unroll
                    for (int m = 0; m < 4; ++m) acc[ai][bj][m][n] += bv; }
        const float* gn_g = inp<I_GNG>(); const float* gn_b = inp<I_GNB>();
        const int row0 = u.pm * 256 + wr * 64 + fr;
#pragma unroll
        for (int ai = 0; ai < 2; ++ai)
#pragma unroll
            for (int m = 0; m < 4; ++m) {
                const int row = row0 + ai * 128 + m * 16;
                f32x4 v[2][2];
#pragma unroll
                for (int bj = 0; bj < 2; ++bj)
#pragma unroll
                    for (int n = 0; n < 2; ++n) v[bj][n] = acc[ai][bj][m][n];
                if (kind <= 1) {
                    const float pos = pbuf[wr * 64 + fr + ai * 128 + m * 16];
#pragma unroll
                    for (int n = 0; n < 2; ++n) {
                        f32x4 c4, s4;
#pragma unroll
                        for (int j = 0; j < 4; ++j) { const int i = 4 * n + j;
                            const float invr = i == 0 ? 1.5915494309189535e-01f : i == 1 ? 3.086376340470123e-02f : i == 2 ? 5.985185712713705e-03f : i == 3 ? 1.160663641240061e-03f : i == 4 ? 2.2507907903927653e-04f : i == 5 ? 4.364795279280289e-05f : i == 6 ? 8.464330808241401e-06f : 1.6414262627950345e-06f;
                            float rev = pos * invr; rev -= floorf(rev); c4[j] = __builtin_amdgcn_cosf(rev); s4[j] = __builtin_amdgcn_sinf(rev); }
                        f32x4 p4;
#pragma unroll
                        for (int j = 0; j < 4; ++j) { float a_ = v[0][n][j], b_ = a_; swap16(a_, b_); p4[j] = (fq & 1) ? a_ : b_; }
                        const f32x4 sg = (fq & 1) ? s4 : -s4;
                        const f32x4 rot = v[0][n] * c4 + p4 * sg;
                        if (fq < 2) v[0][n] = rot;
                    }
                    if (kind == 0) {
#pragma unroll
                        for (int bj = 0; bj < 2; ++bj)
#pragma unroll
                            for (int n = 0; n < 2; ++n) v[bj][n] = v[bj][n] * QSCALE;
                    }
                } else if (kind >= 3) {
#pragma unroll
                    for (int bj = 0; bj < 2; ++bj)
#pragma unroll
                        for (int n = 0; n < 2; ++n) v[bj][n] = gelu4(v[bj][n]);
                    if (kind == 4) {
                        float s = 0.f;
#pragma unroll
                        for (int bj = 0; bj < 2; ++bj)
#pragma unroll
                            for (int n = 0; n < 2; ++n) s += (v[bj][n][0] + v[bj][n][1]) + (v[bj][n][2] + v[bj][n][3]);
                        s += __shfl_xor(s, 16); s += __shfl_xor(s, 32);
                        const float mean = s * (1.0f / 64.0f); float q = 0.f;
#pragma unroll
                        for (int bj = 0; bj < 2; ++bj)
#pragma unroll
                            for (int n = 0; n < 2; ++n) { v[bj][n] = v[bj][n] - mean; const f32x4 d = v[bj][n]; q += (d[0] * d[0] + d[1] * d[1]) + (d[2] * d[2] + d[3] * d[3]); }
                        q += __shfl_xor(q, 16); q += __shfl_xor(q, 32);
                        const float rstd = 1.0f / sqrtf(q * (1.0f / 64.0f) + LN_EPS);
#pragma unroll
                        for (int bj = 0; bj < 2; ++bj)
#pragma unroll
                            for (int n = 0; n < 2; ++n) v[bj][n] = v[bj][n] * rstd * *(const f32x4*)(gn_g + 32 * bj + 8 * fq + 4 * n) + *(const f32x4*)(gn_b + 32 * bj + 8 * fq + 4 * n);
                    }
                }
                bf16_t* rowp = base + (size_t)row * ldc + head * 64 + 8 * fq;
#pragma unroll
                for (int bj = 0; bj < 2; ++bj) { u32x4 w; w.x = cvtpk(v[bj][0][0], v[bj][0][1]); w.y = cvtpk(v[bj][0][2], v[bj][0][3]); w.z = cvtpk(v[bj][1][0], v[bj][1][1]); w.w = cvtpk(v[bj][1][2], v[bj][1][3]);
                    *(u32x4*)(rowp + 32 * bj) = w; }
            }
    }
};
struct EpiOut {
    static constexpr bool PERM = false, PREFETCH = true;
    DI void prefetch(const __amdgpu_buffer_rsrc_t rs, LAS unsigned char* lds, const pg8::Unit& u, int ui, int wid, int lane) const {
        LAS unsigned char* eb = lds + EPIBUF_OFF + (ui & 1) * EPIBUF_SZ;
        EPI_DMA(1, 0, WS_OUTC + (size_t)u.pn * 1024); EPI_DMA(2, 1024, WS_OUTC + 4096 + (size_t)u.pn * 1024);
        EPI_DMA(3, 2048, WS_STATS0 + (size_t)u.pm * 2048); EPI_DMA(4, 3072, WS_STATS0 + (size_t)u.pm * 2048 + 1024);
    }
    DI void operator()(f32x4 (&acc)[2][2][4][2], const pg8::Unit& u, int wr, int wc, int fr, int fq, LAS unsigned char* lds, int ui) const {
        const int col0 = u.pn * 256 + wc * 32 + 4 * fq;
        float* y1 = outp();
        const float* x = inp<I_X>();
        const LAS float* cbuf = (const LAS float*)(lds + EPIBUF_OFF + (ui & 1) * EPIBUF_SZ); const LAS f32x2* sbuf = (const LAS f32x2*)(cbuf + 512);
        f32x4 ca[2][2];
#pragma unroll
        for (int bj = 0; bj < 2; ++bj)
#pragma unroll
            for (int n = 0; n < 2; ++n) { const int tc = wc * 32 + 4 * fq + bj * 128 + n * 16; ca[bj][n] = *(const LAS f32x4*)(cbuf + tc); const f32x4 cb = *(const LAS f32x4*)(cbuf + 256 + tc);
#pragma unroll
                for (int ai = 0; ai < 2; ++ai)
#pragma unroll
                    for (int m = 0; m < 4; ++m) acc[ai][bj][m][n] += cb; }
        const int row0 = u.pm * 256 + wr * 64 + fr;
#pragma unroll
        for (int ai = 0; ai < 2; ++ai) {
            f32x4 xv[4][2][2];
#pragma unroll
            for (int m = 0; m < 4; ++m) { const size_t off = (size_t)(row0 + ai * 128 + m * 16) * D + col0;
#pragma unroll
                for (int bj = 0; bj < 2; ++bj)
#pragma unroll
                    for (int n = 0; n < 2; ++n) xv[m][bj][n] = *(const f32x4*)(x + off + bj * 128 + n * 16); }
#pragma unroll
            for (int m = 0; m < 4; ++m) {
                const int rt = wr * 64 + fr + ai * 128 + m * 16;
                const f32x2 st = sbuf[rt];
                const size_t off = (size_t)(row0 + ai * 128 + m * 16) * D + col0;
#pragma unroll
                for (int bj = 0; bj < 2; ++bj)
#pragma unroll
                    for (int n = 0; n < 2; ++n) { const f32x4 o = acc[ai][bj][m][n] + (xv[m][bj][n] - st.x) * st.y * ca[bj][n];
                        *(f32x4*)(y1 + off + bj * 128 + n * 16) = o; }
            }
            asm volatile("" ::: "memory");
        }
    }
};
struct EpiGateUp {
    static constexpr bool PERM = true, PREFETCH = true;
    DI void prefetch(const __amdgpu_buffer_rsrc_t rs, LAS unsigned char* lds, const pg8::Unit& u, int ui, int wid, int lane) const {
        LAS unsigned char* eb = lds + EPIBUF_OFF + (ui & 1) * EPIBUF_SZ;
        EPI_DMA(1, 0, WS_BGU + ((size_t)u.e * 8 + u.pn) * 1024);
    }
    DI void operator()(f32x4 (&acc)[2][2][4][2], const pg8::Unit& u, int wr, int wc, int fr, int fq, LAS unsigned char* lds, int ui) const {
        const int hcol0 = 128 * u.pn + 32 * wc + 8 * fq;
        unsigned char* hmid = wsp() + WS_HMID;
        const LAS float* bbuf = (const LAS float*)(lds + EPIBUF_OFF + (ui & 1) * EPIBUF_SZ);
        f32x4 bg[2], bu[2];
#pragma unroll
        for (int n = 0; n < 2; ++n) { bg[n] = *(const LAS f32x4*)(bbuf + 32 * wc + 8 * fq + 4 * n); bu[n] = *(const LAS f32x4*)(bbuf + 128 + 32 * wc + 8 * fq + 4 * n); }
        const size_t row0 = (size_t)u.pm * 256 + wr * 64 + fr;
#pragma unroll
        for (int ai = 0; ai < 2; ++ai)
#pragma unroll
            for (int m = 0; m < 4; ++m) {
                float h[2][4];
#pragma unroll
                for (int n = 0; n < 2; ++n) {
                    const f32x4 gt = acc[ai][0][m][n] + bg[n], up = acc[ai][1][m][n] + bu[n];
#pragma unroll
                    for (int j = 0; j < 4; ++j) {
                        const float gc = fminf(gt[j], 7.0f), uc = fminf(fmaxf(up[j], -7.0f), 7.0f);
                        const float sg = __builtin_amdgcn_rcpf(1.0f + __builtin_amdgcn_exp2f(gc * (-1.702f * LOG2E)));
                        h[n][j] = (uc + 1.0f) * (gc * sg);
                    }
                }
                u32x2 w; w.x = cvt4_fp8(h[0][0], h[0][1], h[0][2], h[0][3]); w.y = cvt4_fp8(h[1][0], h[1][1], h[1][2], h[1][3]);
                *(u32x2*)(hmid + (row0 + ai * 128 + m * 16) * 1024 + hcol0) = w;
            }
    }
};
struct EpiDown {
    static constexpr bool PERM = true, PREFETCH = true;
    DI void prefetch(const __amdgpu_buffer_rsrc_t rs, LAS unsigned char* lds, const pg8::Unit& u, int ui, int wid, int lane) const {
        LAS unsigned char* eb = lds + EPIBUF_OFF + (ui & 1) * EPIBUF_SZ;
        EPI_DMA(1, 0, WS_SLOTDEST + (size_t)u.pm * 1024); EPI_DMA(2, 1024, WS_SLOTGATE + (size_t)u.pm * 1024); EPI_DMA(3, 2048, WS_BD + (size_t)u.e * 4096 + (size_t)u.pn * 1024);
    }
    DI void operator()(f32x4 (&acc)[2][2][4][2], const pg8::Unit& u, int wr, int wc, int fr, int fq, LAS unsigned char* lds, int ui) const {
        const int col0 = 256 * u.pn + 32 * wc + 8 * fq;
        bf16_t* yslot = (bf16_t*)(wsp() + WS_YSLOT);
        const LAS int* dbuf = (const LAS int*)(lds + EPIBUF_OFF + (ui & 1) * EPIBUF_SZ); const LAS float* gbuf = (const LAS float*)(dbuf + 256); const LAS float* bbuf = gbuf + 256;
        f32x4 bd[2][2];
#pragma unroll
        for (int bj = 0; bj < 2; ++bj)
#pragma unroll
            for (int n = 0; n < 2; ++n) bd[bj][n] = *(const LAS f32x4*)(bbuf + 128 * bj + 32 * wc + 8 * fq + 4 * n);
        int dest[2][4]; float gt[2][4];
#pragma unroll
        for (int ai = 0; ai < 2; ++ai)
#pragma unroll
            for (int m = 0; m < 4; ++m) { const int r = wr * 64 + fr + ai * 128 + m * 16; dest[ai][m] = dbuf[r]; gt[ai][m] = gbuf[r]; }
#pragma unroll
        for (int ai = 0; ai < 2; ++ai)
#pragma unroll
            for (int m = 0; m < 4; ++m) {
                if (dest[ai][m] >= 0) {
                    bf16_t* rowp = yslot + (size_t)dest[ai][m] * 1024 + col0;
#pragma unroll
                    for (int bj = 0; bj < 2; ++bj) { const f32x4 v0 = (acc[ai][bj][m][0] + bd[bj][0]) * gt[ai][m], v1 = (acc[ai][bj][m][1] + bd[bj][1]) * gt[ai][m];
                        u32x4 w; w.x = cvtpk(v0[0], v0[1]); w.y = cvtpk(v0[2], v0[3]); w.z = cvtpk(v1[0], v1[1]); w.w = cvtpk(v1[2], v1[3]);
                        *(u32x4*)(rowp + 128 * bj) = w; }
                }
            }
    }
};
#undef EPI_DMA

DI int rowmap(int kind, int n) {
    if (kind == 0) { const int pn = n >> 8, ch = n & 255, wc = ch >> 6, bj = (ch >> 5) & 1, w = ch & 31; return (pn << 8) + (bj << 7) + (wc << 5) + w; }
    if (kind == 2) { return n < 1024 ? ((n >> 7) << 8) + (n & 127) : (((n - 1024) >> 7) << 8) + 128 + ((n - 1024) & 127); }
    return n;
}
DI void p0_transpose_item(const float* W, int N, bf16_t* WT, int kind, LAS unsigned char* scr, int item, int lane) {
    const int nblk = N / 64, kb = item / nblk, nb = item % nblk, k0 = 64 * kb, n0 = 64 * nb;
    const int nq = lane >> 2, kr = lane & 3;
    f32x4 a[8], b[8];
#pragma unroll
    for (int i = 0; i < 8; ++i) { const float* p = W + (size_t)(k0 + 8 * i + 2 * kr) * N + n0 + 4 * nq; a[i] = *(const GAS f32x4*)p; b[i] = *(const GAS f32x4*)(p + N); }
#pragma unroll
    for (int i = 0; i < 8; ++i)
#pragma unroll
        for (int c = 0; c < 4; ++c) *(LAS unsigned*)(scr + (4 * nq + c) * 132 + (8 * i + 2 * kr) * 2) = cvtpk(a[i][c], b[i][c]);
    LDS_WAIT(); asm volatile("" ::: "memory");
    const int c8 = lane & 7;
#pragma unroll
    for (int j = 0; j < 8; ++j) { const int n = (lane >> 3) + 8 * j; const LAS unsigned* s = (const LAS unsigned*)(scr + n * 132 + 16 * c8);
        u32x4 o; o.x = s[0]; o.y = s[1]; o.z = s[2]; o.w = s[3];
        *(GAS u32x4*)(WT + (size_t)rowmap(kind, n0 + n) * 1024 + k0 + 8 * c8) = o; }
    LDS_WAIT(); asm volatile("" ::: "memory");
}
struct QItem { const float* W; unsigned char* WT; int N, kind, k0, n0; };
DI QItem p0_qitem(int r, const float* wgu, const float* wd, unsigned char* ws) {
    constexpr int I_GU = (D / 128) * (2048 / 32), I_D = (D / 128) * (D / 32);
    QItem q;
    if (r < NE * I_GU) { const int e = r / I_GU, it = r % I_GU; q.W = wgu + (size_t)e * D * 2048; q.WT = ws + WS_WGU + (size_t)e * 2048 * D; q.N = 2048; q.kind = 2; q.k0 = 128 * (it / 64); q.n0 = 32 * (it % 64); }
    else { r -= NE * I_GU; const int e = r / I_D, it = r % I_D; q.W = wd + (size_t)e * D * D; q.WT = ws + WS_WD + (size_t)e * D * D; q.N = D; q.kind = 1; q.k0 = 128 * (it / 32); q.n0 = 32 * (it % 32); }
    return q;
}
DI void p0_qload(const QItem& q, f32x4 (&a)[4][4], int lane) {
    const int nq = lane >> 3, kr = lane & 7;
#pragma unroll
    for (int i = 0; i < 4; ++i) { const float* p = q.W + (size_t)(q.k0 + 32 * i + 4 * kr) * q.N + q.n0 + 4 * nq;
#pragma unroll
        for (int u = 0; u < 4; ++u) a[i][u] = *(const GAS f32x4*)(p + (size_t)u * q.N); }
}
DI void p0_qfinish(const QItem& q, const f32x4 (&a)[4][4], LAS unsigned char* scr, int lane) {
    const int nq = lane >> 3, kr = lane & 7;
#pragma unroll
    for (int i = 0; i < 4; ++i)
#pragma unroll
        for (int c = 0; c < 4; ++c) *(LAS unsigned*)(scr + (4 * nq + c) * 136 + 32 * i + 4 * kr) = cvt4_fp8(a[i][0][c] * WQ_SCALE, a[i][1][c] * WQ_SCALE, a[i][2][c] * WQ_SCALE, a[i][3][c] * WQ_SCALE);
    LDS_WAIT(); asm volatile("" ::: "memory");
    const int c8 = lane & 7;
#pragma unroll
    for (int j = 0; j < 4; ++j) { const int n = (lane >> 3) + 8 * j; const LAS u32x2* s = (const LAS u32x2*)(scr + n * 136 + 16 * c8);
        const u32x2 x = s[0], y = s[1]; u32x4 o; o.x = x.x; o.y = x.y; o.z = y.x; o.w = y.y;
        *(GAS u32x4*)(q.WT + (size_t)rowmap(q.kind, q.n0 + n) * 1024 + q.k0 + 16 * c8) = o; }
    LDS_WAIT(); asm volatile("" ::: "memory");
}
DI void p0_prologue(const Frame& F0, LAS unsigned char* lds) {
    const Frame F = opaque(F0);
    unsigned char* ws = wsp();
    LAS unsigned char* scr = lds + F.wave * 16384;
    const int gw = F.bid * NWAVES + F.wave, NGW = G * NWAVES;
    const int gt = F.bid * NTHREADS + F.tid, NGT = G * NTHREADS;
    constexpr int I_IN = (D / 64) * (INW / 64), I_OUT = (D / 64) * (D / 64), I_GU = (D / 128) * (2048 / 32), I_D = (D / 128) * (D / 32);
    for (int it = gw; it < I_IN + I_OUT; it += NGW) {
        if (it < I_IN) p0_transpose_item(inp<I_WIN>(), INW, (bf16_t*)(ws + WS_WIN), 0, scr, it, F.lane);
        else p0_transpose_item(inp<I_WOUT>(), D, (bf16_t*)(ws + WS_WOUT), 1, scr, it - I_IN, F.lane);
    }
    {
        constexpr int NQ = NE * (I_GU + I_D);
        const float* wgu = inp<I_WGU>(); const float* wd = inp<I_WD>();
        f32x4 ra[4][4], rb[4][4];
        QItem qa = p0_qitem(gw < NQ ? gw : 0, wgu, wd, ws), qb = qa;
        if (gw < NQ) p0_qload(qa, ra, F.lane);
#pragma unroll 1
        for (int it = gw; it < NQ; it += 2 * NGW) {
            const bool hb = it + NGW < NQ;
            if (hb) { qb = p0_qitem(it + NGW, wgu, wd, ws); p0_qload(qb, rb, F.lane); }
            p0_qfinish(qa, ra, scr, F.lane);
            if (it + 2 * NGW < NQ) { qa = p0_qitem(it + 2 * NGW, wgu, wd, ws); p0_qload(qa, ra, F.lane); }
            if (hb) p0_qfinish(qb, rb, scr, F.lane);
        }
    }
    bf16_t* h0b = (bf16_t*)(ws + WS_H0B); float* stats0 = (float*)(ws + WS_STATS0);
    const float* xin = inp<I_X>(); const float* lg = inp<I_LNING>(); const float* lb = inp<I_LNINB>();
    {
        f32x4 pf[4][4];
#pragma unroll
        for (int u = 0; u < 4; ++u)
#pragma unroll
            for (int j = 0; j < 4; ++j) pf[u][j] = ((const GAS f32x4*)(xin + (size_t)(gw + u * NGW) * D))[F.lane + 64 * j];
        f32x4 gg[4], bb[4];
#pragma unroll
        for (int j = 0; j < 4; ++j) { gg[j] = ((const f32x4*)lg)[F.lane + 64 * j]; bb[j] = ((const f32x4*)lb)[F.lane + 64 * j]; }
#pragma unroll 1
        for (int m0 = gw; m0 < T; m0 += 4 * NGW) {
#pragma unroll
            for (int u = 0; u < 4; ++u) {
                const int m = m0 + u * NGW;
                f32x4 v[4]; float s = 0.f;
#pragma unroll
                for (int j = 0; j < 4; ++j) { v[j] = pf[u][j]; s += (v[j].x + v[j].y) + (v[j].z + v[j].w); }
                { const int mn = (m + 4 * NGW < T) ? m + 4 * NGW : m;
#pragma unroll
                  for (int j = 0; j < 4; ++j) pf[u][j] = ((const GAS f32x4*)(xin + (size_t)mn * D))[F.lane + 64 * j]; }
                const float mean = wave_sum(s) * (1.f / D); float s2 = 0.f;
#pragma unroll
                for (int j = 0; j < 4; ++j) { v[j] = v[j] - mean; s2 += (v[j].x * v[j].x + v[j].y * v[j].y) + (v[j].z * v[j].z + v[j].w * v[j].w); }
                const float rstd = 1.f / sqrtf(wave_sum(s2) * (1.f / D) + LN_EPS);
                GAS u32x2* o8 = (GAS u32x2*)(h0b + (size_t)m * D) + F.lane;
#pragma unroll
                for (int j = 0; j < 4; ++j) { const f32x4 r = v[j] * rstd * gg[j] + bb[j]; u32x2 w; w.x = cvtpk(r.x, r.y); w.y = cvtpk(r.z, r.w); o8[64 * j] = w; }
                if (F.lane == 0) { stats0[2 * m] = mean; stats0[2 * m + 1] = rstd; }
            }
        }
    }
    {
        const int* positions = (const int*)inp<I_POS>(); float* posf = (float*)(ws + WS_POSF);
        for (int i = gt; i < T; i += NGT) posf[i] = (float)positions[i];
        const float* b_in = inp<I_BIN>(); float* binp = (float*)(ws + WS_BINP);
        for (int i = gt; i < INW; i += NGT) { const int pn = i >> 8, t = i & 255, bj = t >> 7, wc = (t >> 5) & 3, w = t & 31; binp[i] = b_in[256 * pn + 64 * wc + 32 * bj + w]; }
        const float* bgu = inp<I_BGU>(); float* bgup = (float*)(ws + WS_BGU);
        for (int i = gt; i < NE * 2048; i += NGT) { const int e = i >> 11, r = i & 2047, pn = r >> 8, t = r & 255; bgup[i] = bgu[e * 2048 + (t < 128 ? 128 * pn + t : 1024 + 128 * pn + (t - 128))]; }
        const float* bd = inp<I_BD>(); float* bdp = (float*)(ws + WS_BD);
        for (int i = gt; i < NE * 1024; i += NGT) bdp[i] = bd[i];
    }
    int* slot_tok = (int*)(ws + WS_SLOTTOK); int* slot_dest = (int*)(ws + WS_SLOTDEST);
    for (int i = gt; i < NSLOT; i += NGT) { slot_tok[i] = -1; slot_dest[i] = -1; }
    float* outc = (float*)(ws + WS_OUTC); const float* bo = inp<I_BOUT>();
    for (int i = gt; i < D; i += NGT) { outc[i] = ALPHA * lg[i]; outc[1024 + i] = bo[i] + ALPHA * lb[i]; }
    bf16_t* wsp = (bf16_t*)(ws + WS_WSP); const float* w_s = inp<I_WS>();
    for (int i = gt; i < 8 * 128 * 128; i += NGT) {
        const int j = i & 7, hi = (i >> 3) & 1, ks = (i >> 4) & 7, t = (i >> 7) & 127, h = i >> 14;
        const int s = 16 * ks + 8 * (j >> 2) + 4 * hi + (j & 3);
        const float w = (s <= t) ? w_s[((size_t)h * 128 + t) * 128 + s] : 0.f;
        wsp[i] = (bf16_t)(cvtpk(w, 0.f) & 0xffffu);
    }
}

#define MFMA32(a, b, c) __builtin_amdgcn_mfma_f32_32x32x16_bf16((a), (b), (c), 0, 0, 0)
DI int crow(int r, int hi) { return (r & 3) + 8 * (r >> 2) + 4 * hi; }
DI bf16x8 cat4(s16x4 lo, s16x4 hi) { return __builtin_shufflevector(lo, hi, 0, 1, 2, 3, 4, 5, 6, 7); }
#define ATT_ISSUE_Q(uu, sb) do { const int b_ = (uu) >> 6, n_ = ((uu) >> 1) & 31, kvh_ = (uu) & 1, tok0_ = b_ * SEQ + n_ * 128, hq_ = kvh_ * 4 + g; \
    const bf16_t* qp = Qb + (size_t)(tok0_ + rh * 64 + (sb) * 32 + q) * 512 + hq_ * 64 + hi * 8; \
    _Pragma("unroll") for (int ds = 0; ds < 4; ++ds) qf[sb][ds] = *(const bf16x8*)(qp + ds * 16); } while (0)
#define ATT_ISSUE_KV(uu) do { const int b_ = (uu) >> 6, n_ = ((uu) >> 1) & 31, kvh_ = (uu) & 1, tok0_ = b_ * SEQ + n_ * 128; \
    _Pragma("unroll") for (int rep = 0; rep < 4; ++rep) { const int c = F.tid + 512 * rep, kw = c >> 3, ch = c & 7; \
        int tokk = tok0_ - 128 + kw; if (n_ == 0 && kw < 128) tokk = tok0_ + kw;       \
        kreg[rep] = *(const u32x4*)(Kb + (size_t)tokk * 128 + kvh_ * 64 + ch * 8); vreg[rep] = *(const u32x4*)(Vb + (size_t)tokk * 128 + kvh_ * 64 + ch * 8); } } while (0)
DI void attn_phase(const Frame& F0, LAS unsigned char* lds) {
    const Frame F = opaque(F0);
    unsigned char* ws = wsp();
    const bf16_t* Qb = (const bf16_t*)(ws + WS_QB); const bf16_t* Kb = (const bf16_t*)(ws + WS_KB); const bf16_t* Vb = (const bf16_t*)(ws + WS_VB);
    bf16_t* Ob = (bf16_t*)(ws + WS_H0B);
    LAS unsigned char* Kl = lds;
    LAS unsigned char* Vt = lds + 36864;
    const int g = F.wave >> 1, rh = F.wave & 1;
    const float* sinks = inp<I_SINKS>();
    u32x4 kreg[4], vreg[4]; bf16x8 qf[2][4];
    constexpr int NU = NBATCH * 32 * 2;
    if (F.bid < NU) { const int q = F.lane & 31, hi = F.lane >> 5; ATT_ISSUE_KV(F.bid); ATT_ISSUE_Q(F.bid, 0); ATT_ISSUE_Q(F.bid, 1); }
#pragma unroll 1
    for (int u = F.bid; u < NU; u += G) {
        const int b = u >> 6, n = (u >> 1) & 31, kvh = u & 1, tok0 = b * SEQ + n * 128, hq = kvh * 4 + g;
        int tid2 = F.tid; asm volatile("" : "+v"(tid2));
        const int q = tid2 & 31, hi = (tid2 >> 5) & 1;
#pragma unroll
        for (int rep = 0; rep < 4; ++rep) {
            const int c = tid2 + 512 * rep, kw = c >> 3, ch = c & 7;
            *(LAS u32x4*)(Kl + kw * 144 + ch * 16) = kreg[rep];
            const unsigned wv[4] = {vreg[rep].x, vreg[rep].y, vreg[rep].z, vreg[rep].w};
#pragma unroll
            for (int e = 0; e < 8; ++e) { const int d = ch * 8 + e; const unsigned short val = (unsigned short)((e & 1) ? (wv[e >> 1] >> 16) : (wv[e >> 1] & 0xffffu));
                *(LAS unsigned short*)(Vt + d * 512 + ((((kw >> 2) ^ (d & 31))) << 3) + (kw & 3) * 2) = val; }
        }
        __syncthreads();
        if (u + G < NU) ATT_ISSUE_KV(u + G);
        const float sink2 = sinks[hq] * LOG2E;
#pragma unroll
        for (int sb = 0; sb < 2; ++sb) {
            const int r0 = rh * 64 + sb * 32, kb0 = r0 >> 5;
            f32x16 p[5];
#pragma unroll
            for (int kbi = 0; kbi < 5; ++kbi) {
                f32x16 a = {};
#pragma unroll
                for (int ds = 0; ds < 4; ++ds) { const bf16x8 kf = *(const LAS bf16x8*)(Kl + ((kb0 + kbi) * 32 + q) * 144 + (ds * 16 + hi * 8) * 2); a = MFMA32(kf, qf[sb][ds], a); }
                p[kbi] = a;
            }
            if (u + G < NU) ATT_ISSUE_Q(u + G, sb);
            float mx = sink2;
#pragma unroll
            for (int kbi = 0; kbi < 5; ++kbi) {
                const bool blk_ok = (n > 0) || (kb0 + kbi >= 4);
#pragma unroll
                for (int r = 0; r < 16; ++r) { const int c = crow(r, hi); const bool ok = blk_ok && (kbi == 0 ? c > q : kbi == 4 ? c <= q : true);
                    const float s = ok ? p[kbi][r] : -1e30f; p[kbi][r] = s; mx = fmaxf(mx, s); }
            }
            mx = fmaxf(mx, partnerf<5>(mx, F.lane));
            float l = 0.f;
#pragma unroll
            for (int kbi = 0; kbi < 5; ++kbi)
#pragma unroll
                for (int r = 0; r < 16; ++r) { const float e = __builtin_amdgcn_exp2f(p[kbi][r] - mx); p[kbi][r] = e; l += e; }
            l += partnerf<5>(l, F.lane); l += __builtin_amdgcn_exp2f(sink2 - mx);
            f32x16 o0 = {}, o1 = {};
#pragma unroll
            for (int kbi = 0; kbi < 5; ++kbi)
#pragma unroll
                for (int s2 = 0; s2 < 2; ++s2) {
                    u32x4 pw; pw.x = cvtpk(p[kbi][8 * s2 + 0], p[kbi][8 * s2 + 1]); pw.y = cvtpk(p[kbi][8 * s2 + 2], p[kbi][8 * s2 + 3]);
                    pw.z = cvtpk(p[kbi][8 * s2 + 4], p[kbi][8 * s2 + 5]); pw.w = cvtpk(p[kbi][8 * s2 + 6], p[kbi][8 * s2 + 7]);
                    const bf16x8 pa = __builtin_bit_cast(bf16x8, pw);
                    const int kc = ((kb0 + kbi) * 32 + 16 * s2 + 4 * hi) >> 2;
                    { const int d = q; const s16x4 lo = *(const LAS s16x4*)(Vt + d * 512 + ((kc ^ (d & 31)) << 3)), hh = *(const LAS s16x4*)(Vt + d * 512 + (((kc + 2) ^ (d & 31)) << 3)); o0 = MFMA32(cat4(lo, hh), pa, o0); }
                    { const int d = 32 + q; const s16x4 lo = *(const LAS s16x4*)(Vt + d * 512 + ((kc ^ (d & 31)) << 3)), hh = *(const LAS s16x4*)(Vt + d * 512 + (((kc + 2) ^ (d & 31)) << 3)); o1 = MFMA32(cat4(lo, hh), pa, o1); }
                }
            const float rl = __builtin_amdgcn_rcpf(l);
            bf16_t* op = Ob + (size_t)(tok0 + r0 + q) * D + hq * 64 + 4 * hi;
#pragma unroll
            for (int g4 = 0; g4 < 4; ++g4) {
                u32x2 w0, w1; w0.x = cvtpk(o0[4 * g4] * rl, o0[4 * g4 + 1] * rl); w0.y = cvtpk(o0[4 * g4 + 2] * rl, o0[4 * g4 + 3] * rl);
                w1.x = cvtpk(o1[4 * g4] * rl, o1[4 * g4 + 1] * rl); w1.y = cvtpk(o1[4 * g4 + 2] * rl, o1[4 * g4 + 3] * rl);
                *(u32x2*)(op + 8 * g4) = w0; *(u32x2*)(op + 32 + 8 * g4) = w1;
            }
        }
        __syncthreads();
    }
}
#undef ATT_ISSUE_Q
#undef ATT_ISSUE_KV
template <int TB> DI void gmlp_tb(const bf16_t* GUb, const bf16_t* wsp, bf16_t* Ob, const float* b_s, LAS unsigned char* Vt, int h, int tok0, int q, int hi) {
    constexpr int NKS = 2 * TB + 2;
    const int t = TB * 32 + q;
    const bf16_t* gp = GUb + (size_t)(tok0 + t) * 512 + h * 64 + 4 * hi;
    const bf16_t* wp = wsp + ((size_t)(h * 128 + t) * 8) * 16 + hi * 8;
    bf16x8 wa[NKS];
#pragma unroll
    for (int ks = 0; ks < NKS; ++ks) wa[ks] = *(const bf16x8*)(wp + ks * 16);
    u32x2 gu0[4], gu1[4];
#pragma unroll
    for (int g4 = 0; g4 < 4; ++g4) { gu0[g4] = *(const u32x2*)(gp + 8 * g4); gu1[g4] = *(const u32x2*)(gp + 32 + 8 * g4); }
    const float bias = b_s[h * 128 + t];
    f32x16 a0 = {}, a1 = {};
#pragma unroll
    for (int ks = 0; ks < NKS; ++ks) {
        const int kc = (16 * ks + 4 * hi) >> 2;
        { const int d = q; const s16x4 lo = *(const LAS s16x4*)(Vt + d * 256 + ((kc ^ (d & 31)) << 3)), hh = *(const LAS s16x4*)(Vt + d * 256 + (((kc + 2) ^ (d & 31)) << 3)); a0 = MFMA32(cat4(lo, hh), wa[ks], a0); }
        { const int d = 32 + q; const s16x4 lo = *(const LAS s16x4*)(Vt + d * 256 + ((kc ^ (d & 31)) << 3)), hh = *(const LAS s16x4*)(Vt + d * 256 + (((kc + 2) ^ (d & 31)) << 3)); a1 = MFMA32(cat4(lo, hh), wa[ks], a1); }
    }
    bf16_t* op = Ob + (size_t)(tok0 + t) * D + 512 + h * 64 + 4 * hi;
#pragma unroll
    for (int g4 = 0; g4 < 4; ++g4) {
        u32x2 w0, w1;
        w0.x = cvtpk(bflo(gu0[g4].x) * (a0[4 * g4] + bias), bfhi(gu0[g4].x) * (a0[4 * g4 + 1] + bias)); w0.y = cvtpk(bflo(gu0[g4].y) * (a0[4 * g4 + 2] + bias), bfhi(gu0[g4].y) * (a0[4 * g4 + 3] + bias));
        w1.x = cvtpk(bflo(gu1[g4].x) * (a1[4 * g4] + bias), bfhi(gu1[g4].x) * (a1[4 * g4 + 1] + bias)); w1.y = cvtpk(bflo(gu1[g4].y) * (a1[4 * g4 + 2] + bias), bfhi(gu1[g4].y) * (a1[4 * g4 + 3] + bias));
        *(u32x2*)(op + 8 * g4) = w0; *(u32x2*)(op + 32 + 8 * g4) = w1;
    }
}
DI void gmlp_phase(const Frame& F0, LAS unsigned char* lds) {
    const Frame F = opaque(F0);
    unsigned char* ws = wsp();
    const int h = F.wave;
    const bf16_t* GUb = (const bf16_t*)(ws + WS_GUB); const bf16_t* GVb = (const bf16_t*)(ws + WS_GVB); const bf16_t* wsp = (const bf16_t*)(ws + WS_WSP);
    bf16_t* Ob = (bf16_t*)(ws + WS_H0B);
    const float* b_s = inp<I_BS>();
    LAS unsigned char* Vt = lds + F.wave * 16384;
    const int q = F.lane & 31, hi = F.lane >> 5;
    u32x4 gv[16];
#pragma unroll
    for (int rep = 0; rep < 16; ++rep) { const int c = F.lane + 64 * rep, s = c >> 3, ch = c & 7; gv[rep] = *(const u32x4*)(GVb + (size_t)(F.bid * 128 + s) * 512 + h * 64 + ch * 8); }
#pragma unroll 1
    for (int chunk = F.bid; chunk < T / 128; chunk += G) {
        const int tok0 = chunk * 128;
        int ln = F.lane; asm volatile("" : "+v"(ln));
#pragma unroll
        for (int rep = 0; rep < 16; ++rep) {
            const int c = ln + 64 * rep, s = c >> 3, ch = c & 7;
            const unsigned wv[4] = {gv[rep].x, gv[rep].y, gv[rep].z, gv[rep].w};
#pragma unroll
            for (int e = 0; e < 8; ++e) { const int d = ch * 8 + e; const unsigned short val = (unsigned short)((e & 1) ? (wv[e >> 1] >> 16) : (wv[e >> 1] & 0xffffu));
                *(LAS unsigned short*)(Vt + d * 256 + (((s >> 2) ^ (d & 31)) << 3) + (s & 3) * 2) = val; }
        }
        if (chunk + G < T / 128) {
#pragma unroll
            for (int rep = 0; rep < 16; ++rep) { const int c = F.lane + 64 * rep, s = c >> 3, ch = c & 7; gv[rep] = *(const u32x4*)(GVb + (size_t)((chunk + G) * 128 + s) * 512 + h * 64 + ch * 8); }
        }
        LDS_WAIT();
        gmlp_tb<0>(GUb, wsp, Ob, b_s, Vt, h, tok0, q, hi);
        gmlp_tb<1>(GUb, wsp, Ob, b_s, Vt, h, tok0, q, hi);
        gmlp_tb<2>(GUb, wsp, Ob, b_s, Vt, h, tok0, q, hi);
        gmlp_tb<3>(GUb, wsp, Ob, b_s, Vt, h, tok0, q, hi);
        LDS_WAIT();
    }
}

DI void p4_router(const Frame& F0, LAS unsigned char* lds) {
    const Frame F = opaque(F0);
    unsigned char* ws = wsp(); float* out = outp();
    LAS unsigned char* Whi = lds;
    LAS unsigned char* Wlo = lds + 65536;
    LAS int* cnt = (LAS int*)(lds + MISC_OFF + 256);
    { const float* w_router = inp<I_WR>();
      for (int i = F.tid; i < D * NE; i += NTHREADS) { const int c = i >> 5, e = i & 31; const float w = w_router[i];
          const unsigned h = cvtpk(w, 0.f) & 0xffffu; const unsigned l = cvtpk(w - __uint_as_float(h << 16), 0.f) & 0xffffu;
          const int off = e * 2048 + (((c >> 3) ^ (e & 15)) << 4) + (c & 7) * 2;
          *(LAS unsigned short*)(Whi + off) = (unsigned short)h; *(LAS unsigned short*)(Wlo + off) = (unsigned short)l; } }
    if (F.tid < 32) cnt[F.tid] = 0;
    __syncthreads();
    constexpr int R = T / G, rpw = R / NWAVES;
    static_assert(rpw == 32, "one 32-token MFMA block per wave");
    int* tok_e = (int*)(ws + WS_TOKE); float* tok_g = (float*)(ws + WS_TOKG); int* tok_l = (int*)(ws + WS_TOKL);
    const int lane = F.lane;
    const int tokb = F.bid * R + F.wave * rpw;
    {
        f32x4 g1[4], b1[4];
#pragma unroll
        for (int j = 0; j < 4; ++j) { g1[j] = ((const f32x4*)inp<I_LN1G>())[lane + 64 * j]; b1[j] = ((const f32x4*)inp<I_LN1B>())[lane + 64 * j]; }
        f32x4 pf[4][4];
#pragma unroll
        for (int u = 0; u < 4; ++u)
#pragma unroll
            for (int j = 0; j < 4; ++j) pf[u][j] = ((const GAS f32x4*)(out + (size_t)(tokb + u) * D))[lane + 64 * j];
#pragma unroll 1
        for (int i = 0; i < rpw; i += 4) {
#pragma unroll
            for (int u = 0; u < 4; ++u) {
                const int tok = tokb + i + u;
                f32x4 v[4];
#pragma unroll
                for (int j = 0; j < 4; ++j) v[j] = pf[u][j];
                { const int tn = (i + u + 4 < rpw) ? tok + 4 : tok;
#pragma unroll
                  for (int j = 0; j < 4; ++j) pf[u][j] = ((const GAS f32x4*)(out + (size_t)tn * D))[lane + 64 * j]; }
                float s = 0.f;
#pragma unroll
                for (int j = 0; j < 4; ++j) s += (v[j].x + v[j].y) + (v[j].z + v[j].w);
                const float mean = wave_sum(s) * (1.f / D); float s2 = 0.f;
#pragma unroll
                for (int j = 0; j < 4; ++j) { v[j] = v[j] - mean; s2 += (v[j].x * v[j].x + v[j].y * v[j].y) + (v[j].z * v[j].z + v[j].w * v[j].w); }
                const float rstd = 1.f / sqrtf(wave_sum(s2) * (1.f / D) + LN_EPS);
                float* rowp = out + (size_t)tok * D;
                GAS u32x2* hp = (GAS u32x2*)rowp + lane; GAS u32x2* lp = (GAS u32x2*)(rowp + 512) + lane;
#pragma unroll
                for (int j = 0; j < 4; ++j) {
                    v[j] = v[j] * rstd * g1[j] + b1[j];
                    u32x2 wh; wh.x = cvtpk(v[j].x, v[j].y); wh.y = cvtpk(v[j].z, v[j].w);
                    u32x2 wl; wl.x = cvtpk(v[j].x - bflo(wh.x), v[j].y - bfhi(wh.x)); wl.y = cvtpk(v[j].z - bflo(wh.y), v[j].w - bfhi(wh.y));
                    hp[64 * j] = wh; lp[64 * j] = wl;
                    ((GAS unsigned*)(ws + WS_H1Q + (size_t)tok * 1024))[lane + 64 * j] = cvt4_fp8(v[j].x, v[j].y, v[j].z, v[j].w);
                }
            }
        }
    }
    VM_WAIT();
    __builtin_amdgcn_fence(__ATOMIC_ACQUIRE, "agent");
    VM_WAIT();
    const int q = lane & 31, hi = lane >> 5;
    f32x16 acc = {};
    {
        const unsigned char* hrow = (const unsigned char*)(out + (size_t)(tokb + q) * D) + hi * 16;
        const int wbase = q * 2048;
#pragma unroll 4
        for (int s = 0; s < 64; ++s) {
            const bf16x8 bh = *(const GAS bf16x8*)(hrow + 32 * s), bl = *(const GAS bf16x8*)(hrow + 2048 + 32 * s);
            const int off = wbase + (((2 * s + hi) ^ (q & 15)) << 4);
            const bf16x8 wh = *(const LAS bf16x8*)(Whi + off), wl = *(const LAS bf16x8*)(Wlo + off);
            acc = MFMA32(wh, bh, acc); acc = MFMA32(wl, bh, acc); acc = MFMA32(wh, bl, acc);
        }
    }
    const float* b_router = inp<I_BR>();
    float lg[16];
#pragma unroll
    for (int r = 0; r < 16; ++r) lg[r] = acc[r] + b_router[crow(r, hi)];
    float ov[4]; int oi[4];
#pragma unroll
    for (int k = 0; k < 4; ++k) {
        float best = -INFINITY; int bi = 64;
#pragma unroll
        for (int r = 0; r < 16; ++r) { const bool gt = lg[r] > best; best = gt ? lg[r] : best; bi = gt ? crow(r, hi) : bi; }
#pragma unroll
        for (int r = 0; r < 16; ++r) lg[r] = (crow(r, hi) == bi) ? -INFINITY : lg[r];
        ov[k] = best; oi[k] = bi;
    }
    float cv[8]; int ci[8];
#pragma unroll
    for (int k = 0; k < 4; ++k) { cv[k] = ov[k]; ci[k] = oi[k]; cv[4 + k] = partnerf<5>(ov[k], lane); ci[4 + k] = partneri<5>(oi[k], lane); }
    float tv[4]; int ti[4];
#pragma unroll
    for (int k = 0; k < 4; ++k) {
        float best = -INFINITY; int bi = 64;
#pragma unroll
        for (int c = 0; c < 8; ++c) { const bool gt = cv[c] > best || (cv[c] == best && ci[c] < bi); best = gt ? cv[c] : best; bi = gt ? ci[c] : bi; }
#pragma unroll
        for (int c = 0; c < 8; ++c) cv[c] = (ci[c] == bi) ? -INFINITY : cv[c];
        tv[k] = best; ti[k] = bi;
    }
    if (hi == 0) {
        const float e1 = __expf(tv[1] - tv[0]), e2 = __expf(tv[2] - tv[0]), e3 = __expf(tv[3] - tv[0]);
        const float inv = 1.0f / (1.0f + e1 + e2 + e3);
        const int tok = tokb + q;
        int lp4[4];
#pragma unroll
        for (int k = 0; k < 4; ++k) lp4[k] = atomicAdd((int*)(cnt + ti[k]), 1);
        *(int4*)(tok_e + tok * 4) = make_int4(ti[0], ti[1], ti[2], ti[3]);
        *(float4*)(tok_g + tok * 4) = make_float4(inv, e1 * inv, e2 * inv, e3 * inv);
        *(int4*)(tok_l + tok * 4) = make_int4(lp4[0], lp4[1], lp4[2], lp4[3]);
    }
    __syncthreads();
    if (F.tid < 32) ((int*)(ws + WS_WGCOUNT))[F.bid * 32 + F.tid] = cnt[F.tid];
}
DI int p4b_lists(const Frame& F0, LAS unsigned char* lds) {
    const Frame F = opaque(F0);
    unsigned char* ws = wsp();
    LAS int* tab = (LAS int*)lds;
    LAS int* pstart = (LAS int*)(lds + MISC_OFF + 256);
    LAS int* mybase = pstart + 64;
    const int* wgc = (const int*)(ws + WS_WGCOUNT);
    for (int i = F.tid; i < G * 32; i += NTHREADS) tab[i] = (int)__hip_atomic_load((unsigned*)wgc + i, __ATOMIC_RELAXED, __HIP_MEMORY_SCOPE_AGENT);
    __syncthreads();
    if (F.tid < 32) { int tot = 0, mb = 0; for (int w = 0; w < G; ++w) { const int c = tab[w * 32 + F.tid]; if (w < F.bid) mb += c; tot += c; } mybase[F.tid] = mb; pstart[32 + 32 + 32 + F.tid] = tot; }
    __syncthreads();
    if (F.tid == 0) { int off = 0; for (int e = 0; e < 32; ++e) { pstart[e] = off; off += ((pstart[96 + e] + 255) >> 8) << 8; } pstart[32] = off; }
    __syncthreads();
    const int ngroups = pstart[32] >> 8;
    if (F.bid == 0) {
        int* grp_e = (int*)(ws + WS_GRPE);
        for (int g = F.tid; g < NGRP_MAX; g += NTHREADS) { int e = 0; for (int k = 1; k < 32; ++k) if (pstart[k] <= g * 256) e = k; grp_e[g] = (g < ngroups) ? e : 0; }
    }
    const int R = T / G;
    const int* tok_e = (const int*)(ws + WS_TOKE); const float* tok_g = (const float*)(ws + WS_TOKG); const int* tok_l = (const int*)(ws + WS_TOKL);
    int* slot_tok = (int*)(ws + WS_SLOTTOK); float* slot_gate = (float*)(ws + WS_SLOTGATE); int* slot_dest = (int*)(ws + WS_SLOTDEST);
    for (int i = F.tid; i < R * 4; i += NTHREADS) {
        const int idx = F.bid * R * 4 + i; const int e = tok_e[idx];
        const int slot = pstart[e] + mybase[e] + tok_l[idx];
        slot_tok[slot] = idx >> 2; slot_gate[slot] = tok_g[idx]; slot_dest[slot] = idx;
    }
    return ngroups;
}
DI void p7_final(const Frame& F0) {
    const Frame F = opaque(F0);
    unsigned char* ws = wsp(); float* out = outp();
    const bf16_t* yslot = (const bf16_t*)(ws + WS_YSLOT);
    const int gw = F.bid * NWAVES + F.wave, NGW = G * NWAVES, lane = F.lane;
    const float* ln2_g = inp<I_LN2G>(); const float* ln2_b = inp<I_LN2B>();
    for (int tok = gw; tok < T; tok += NGW) {
        float* rowp = out + (size_t)tok * D;
        f32x4 v[4];
#pragma unroll
        for (int j = 0; j < 4; ++j) {
            const u32x2 wh = ((const GAS u32x2*)rowp)[lane + 64 * j];
            v[j] = (f32x4){bflo(wh.x), bfhi(wh.x), bflo(wh.y), bfhi(wh.y)} * ALPHA;
        }
#pragma unroll
        for (int k = 0; k < 4; ++k) {
            const GAS u32x2* yp = (const GAS u32x2*)(yslot + ((size_t)tok * 4 + k) * 1024) + lane;
#pragma unroll
            for (int j = 0; j < 4; ++j) { const u32x2 w = yp[64 * j]; v[j] = v[j] + (f32x4){bflo(w.x), bfhi(w.x), bflo(w.y), bfhi(w.y)}; }
        }
        float s = 0.f;
#pragma unroll
        for (int j = 0; j < 4; ++j) s += (v[j].x + v[j].y) + (v[j].z + v[j].w);
        const float mean = wave_sum(s) * (1.f / D); float s2 = 0.f;
#pragma unroll
        for (int j = 0; j < 4; ++j) { v[j] = v[j] - mean; s2 += (v[j].x * v[j].x + v[j].y * v[j].y) + (v[j].z * v[j].z + v[j].w * v[j].w); }
        const float rstd = 1.f / sqrtf(wave_sum(s2) * (1.f / D) + LN_EPS);
#pragma unroll
        for (int j = 0; j < 4; ++j) { const f32x4 gg = ((const f32x4*)ln2_g)[lane + 64 * j], bb = ((const f32x4*)ln2_b)[lane + 64 * j];
            ((GAS f32x4*)rowp)[lane + 64 * j] = v[j] * rstd * gg + bb; }
    }
}

struct CfgIn   { static constexpr bool FP8 = false, GATHER = false; static constexpr size_t A_OFF = WS_H0B,  B_OFF = WS_WIN,  B_E_BYTES = 0; static constexpr unsigned A_PITCH = 0; };
struct CfgOut  { static constexpr bool FP8 = false, GATHER = false; static constexpr size_t A_OFF = WS_H0B,  B_OFF = WS_WOUT, B_E_BYTES = 0; static constexpr unsigned A_PITCH = 0; };
struct CfgGU   { static constexpr bool FP8 = true,  GATHER = true;  static constexpr size_t A_OFF = WS_H1Q,  B_OFF = WS_WGU,  B_E_BYTES = (size_t)2048 * D; static constexpr unsigned A_PITCH = 1024u; };
struct CfgDown { static constexpr bool FP8 = true,  GATHER = false; static constexpr size_t A_OFF = WS_HMID, B_OFF = WS_WD,   B_E_BYTES = (size_t)D * D; static constexpr unsigned A_PITCH = 0; };
#ifndef PHASE_MASK
#define PHASE_MASK 0xFFFF
#endif
struct Args { const void* in[23]; float* out; unsigned char* ws; };
__global__ void __launch_bounds__(NTHREADS, 2) mk_fwd(Args args) {
    __shared__ __attribute__((aligned(16))) unsigned char lds_raw[LDS_BYTES];
    LAS unsigned char* lds = (LAS unsigned char*)lds_raw;
    Frame F;
    F.tid = threadIdx.x; F.lane = F.tid & 63; F.wave = __builtin_amdgcn_readfirstlane(F.tid >> 6); F.bid = blockIdx.x;
    volatile LAS unsigned* MISC = (volatile LAS unsigned*)(lds + MISC_OFF);
    if (F.tid < 64) MISC[F.tid] = 0u;
    __syncthreads();
    xcd_barrier_post((unsigned*)(wsp() + WS_CTL) + CW_BAR);
    volatile LAS unsigned* bst = MISC + 8;
#ifdef PROBE_A
    int n_stamp = 0;
#define STAMP() do { if (F.bid == 0 && F.tid == 0) { __hip_atomic_store((unsigned long long*)(wsp() + WS_CTL + 32768) + n_stamp, (unsigned long long)__builtin_amdgcn_s_memrealtime(), __ATOMIC_RELAXED, __HIP_MEMORY_SCOPE_AGENT); } ++n_stamp; } while (0)
#else
#define STAMP() do {} while (0)
#endif
    STAMP();
    LAS unsigned char* tokbuf = lds + TOKBUF_OFF;

    if (PHASE_MASK & 1) p0_prologue(F, lds);
    xcd_barrier(bst); STAMP();
    if (PHASE_MASK & 2) { pg8::StaticOrder<T, INW> S{F.bid}; EpiInProj E; pg8::gemm_phase<CfgIn>(lds, tokbuf, 0, S, E); }
    xcd_barrier(bst); STAMP();
    if (PHASE_MASK & 4) attn_phase(F, lds);
    if (PHASE_MASK & 8) gmlp_phase(F, lds);
    xcd_barrier(bst); STAMP();
    if (PHASE_MASK & 16) { pg8::StaticOrder<T, D> S{F.bid}; EpiOut E; pg8::gemm_phase<CfgOut>(lds, tokbuf, 0, S, E); }
    xcd_barrier(bst); STAMP();
    if (PHASE_MASK & 32) p4_router(F, lds);
    xcd_barrier(bst); STAMP();
    int ngroups = 1040; if (PHASE_MASK & 64) ngroups = p4b_lists(F, lds);
    xcd_barrier(bst); STAMP();
    if (PHASE_MASK & 128) { pg8::GroupOrder<8> S{0, ngroups, F.bid}; EpiGateUp E; pg8::gemm_phase<CfgGU>(lds, tokbuf, 0, S, E); }
    xcd_barrier(bst); STAMP();
    if (PHASE_MASK & 256) { pg8::GroupOrder<4> S{0, ngroups, F.bid}; EpiDown E; pg8::gemm_phase<CfgDown>(lds, tokbuf, 0, S, E); }
    xcd_barrier(bst); STAMP();
    if (PHASE_MASK & 512) p7_final(F);
#ifdef PROBE_A
    STAMP();
    if (F.bid == 0 && F.tid == 0) {
        unsigned long long* ts = (unsigned long long*)(wsp() + WS_CTL + 32768);
        unsigned long long extra = 0ull;
        for (int k = 1; k < 12; ++k) if ((PROBE_A >> k) & 1) extra += __hip_atomic_load(ts + k, __ATOMIC_RELAXED, __HIP_MEMORY_SCOPE_AGENT) - __hip_atomic_load(ts + k - 1, __ATOMIC_RELAXED, __HIP_MEMORY_SCOPE_AGENT);
        const unsigned long long t0 = __builtin_amdgcn_s_memrealtime();
        while (__builtin_amdgcn_s_memrealtime() - t0 < extra) __builtin_amdgcn_s_sleep(8);
    }
#endif
}

extern "C" void kernel_launch(void* const* d_in, const int* in_sizes, int n_in, void* d_out, int out_size, void* d_ws, size_t ws_size, hipStream_t stream) {
    static int grid = 0;
    if (grid == 0) {
        if (n_in != 23 || in_sizes[0] != T * D || out_size != T * D || ws_size < WS_END) {
            fprintf(stderr, "kernel_launch: unexpected shapes/workspace (n_in %d, in0 %d, out %d, ws %zu, need %zu); nothing launched\n", n_in, n_in > 0 ? in_sizes[0] : -1, out_size, ws_size, (size_t)WS_END);
            grid = -1; return;
        }
        int dev = 0, cus = 0, per_cu = 0;
        if (hipGetDevice(&dev) != hipSuccess || hipDeviceGetAttribute(&cus, hipDeviceAttributeMultiprocessorCount, dev) != hipSuccess) { grid = -1; return; }
        if (hipOccupancyMaxActiveBlocksPerMultiprocessor(&per_cu, (const void*)mk_fwd, NTHREADS, 0) != hipSuccess || per_cu < 1) {
            fprintf(stderr, "kernel_launch: occupancy query says %d blocks per CU; nothing launched\n", per_cu); (void)hipGetLastError(); grid = -1; return;
        }
        grid = cus;
        if (grid != G) { fprintf(stderr, "kernel_launch: built for a 256-CU device, found %d; nothing launched\n", cus); grid = -1; return; }
    }
    if (grid < 0) return;
    if (hipMemsetAsync((char*)d_ws + WS_CTL, 0, CTL_ZERO_BYTES, stream) != hipSuccess) return;
    Args a{};
    for (int i = 0; i < 23; ++i) a.in[i] = d_in[i];
    a.out = (float*)d_out; a.ws = (unsigned char*)d_ws;
    hipLaunchKernelGGL(mk_fwd, dim3(grid), dim3(NTHREADS), 0, stream, a);
}
```

```cpp
#include <hip/hip_runtime.h>
#include <cstdio>
#include <cstdint>
#include <type_traits>

#define DI __device__ __forceinline__
#define LAS __attribute__((address_space(3)))
#define GAS __attribute__((address_space(1)))
typedef unsigned short bf16_t;
typedef short bf16x8 __attribute__((ext_vector_type(8)));
typedef short s16x4 __attribute__((ext_vector_type(4)));
typedef float f32x2 __attribute__((ext_vector_type(2)));
typedef float f32x4 __attribute__((ext_vector_type(4)));
typedef float f32x16 __attribute__((ext_vector_type(16)));
typedef unsigned u32x2 __attribute__((ext_vector_type(2)));
typedef unsigned u32x4 __attribute__((ext_vector_type(4)));
typedef __bf16 bf16x2_t __attribute__((ext_vector_type(2)));
typedef GAS unsigned gu32;
typedef int v8i __attribute__((ext_vector_type(8)));

constexpr int D = 1024, SEQ = 4096, NBATCH = 16, T = NBATCH * SEQ;
constexpr int INW = 1792, NE = 32;
constexpr int NSLOT = T * 4 + NE * 256;
constexpr int NGRP_MAX = NSLOT / 256;
constexpr float LN_EPS = 1e-5f;
constexpr float ALPHA = 1.189207115002721f;
constexpr float LOG2E = 1.4426950408889634f;
constexpr float QSCALE = 0.125f * LOG2E;
constexpr float WQ_SCALE = 64.0f;
constexpr int WQ_E8M0 = 127 - 6;
constexpr int NWAVES = 8, NTHREADS = 512;

constexpr size_t MiB = 1u << 20;
constexpr size_t WS_CTL = 0, CTL_ZERO_BYTES = 65536;
constexpr size_t WS_WGCOUNT = 1 * MiB;
constexpr size_t WS_GRPE = 1 * MiB + 65536;
constexpr size_t WS_OUTC = 1 * MiB + 131072;
constexpr size_t WS_WIN = 2 * MiB;
constexpr size_t WS_WOUT = 6 * MiB;
constexpr size_t WS_WSP = 8 * MiB;
constexpr size_t WS_STATS0 = 9 * MiB;
constexpr size_t WS_BINP = 10 * MiB;
constexpr size_t WS_POSF = 10 * MiB + 65536;
constexpr size_t WS_BGU = 11 * MiB;
constexpr size_t WS_BD = 12 * MiB;
constexpr size_t WS_WGU = 16 * MiB;
constexpr size_t WS_WD = 80 * MiB;
constexpr size_t WS_H1Q = 112 * MiB;
constexpr size_t WS_TOKE = 208 * MiB;
constexpr size_t WS_TOKG = 209 * MiB;
constexpr size_t WS_TOKL = 210 * MiB;
constexpr size_t WS_SLOTTOK = 211 * MiB;
constexpr size_t WS_SLOTGATE = 212 * MiB + 512 * 1024;
constexpr size_t WS_SLOTDEST = 214 * MiB;
constexpr size_t WS_H0B = 216 * MiB;
constexpr size_t WS_QB = 344 * MiB;
constexpr size_t WS_KB = 408 * MiB;
constexpr size_t WS_VB = 424 * MiB;
constexpr size_t WS_GUB = 440 * MiB;
constexpr size_t WS_GVB = 504 * MiB;
constexpr size_t WS_YSLOT = 216 * MiB;
constexpr size_t WS_HMID = 728 * MiB;
constexpr size_t WS_END = 1024 * MiB;
static_assert(WS_HMID + (size_t)NSLOT * 1024 <= WS_END && WS_H1Q + (size_t)T * 1024 <= 208 * MiB, "ws map");
static_assert(WS_YSLOT + (size_t)T * 4 * 1024 * 2 <= WS_HMID, "ws map");
constexpr int CW_BAR = 4096;

constexpr int RING_BYTES = 131072;
constexpr int MISC_OFF = RING_BYTES;
constexpr int TOKBUF_OFF = MISC_OFF + 1024;
constexpr int EPIBUF_OFF = MISC_OFF + 4096, EPIBUF_SZ = 4096;
constexpr int LDS_BYTES = 147456;

DI unsigned cvtpk(float lo, float hi) { f32x2 v = {lo, hi}; bf16x2_t b = __builtin_convertvector(v, bf16x2_t); return __builtin_bit_cast(unsigned, b); }
DI unsigned cvt4_fp8(float a, float b, float c, float d) { int p = __builtin_amdgcn_cvt_pk_fp8_f32(a, b, 0, false); p = __builtin_amdgcn_cvt_pk_fp8_f32(c, d, p, true); return (unsigned)p; }
DI float bf2f(unsigned short h) { return __uint_as_float((unsigned)h << 16); }
DI float bflo(unsigned w) { return __uint_as_float(w << 16); }
DI float bfhi(unsigned w) { return __uint_as_float(w & 0xffff0000u); }
template <int CTRL> DI float dppf(float v) { return __builtin_bit_cast(float, __builtin_amdgcn_update_dpp(0, __builtin_bit_cast(int, v), CTRL, 0xf, 0xf, false)); }
DI void swap32(float& a, float& b) { asm("s_nop 1\n\tv_permlane32_swap_b32 %0, %1" : "+v"(a), "+v"(b)); }
DI void swap16(float& a, float& b) { asm("s_nop 1\n\tv_permlane16_swap_b32 %0, %1" : "+v"(a), "+v"(b)); }
template <int CTRL> DI int dppi(int v) { return __builtin_amdgcn_update_dpp(0, v, CTRL, 0xf, 0xf, false); }
constexpr int DPP_XOR1 = 0xB1, DPP_XOR2 = 0x4E, DPP_HMIRROR = 0x141, DPP_MIRROR = 0x140;
template <int LV> DI float partnerf(float v, int lane) {
    if constexpr (LV == 0) return dppf<DPP_XOR1>(v);
    else if constexpr (LV == 1) return dppf<DPP_XOR2>(v);
    else if constexpr (LV == 2) return dppf<DPP_HMIRROR>(v);
    else if constexpr (LV == 3) return dppf<DPP_MIRROR>(v);
    else if constexpr (LV == 4) { float a = v, b = v; swap16(a, b); return (lane & 16) ? a : b; }
    else { float a = v, b = v; swap32(a, b); return (lane & 32) ? a : b; }
}
template <int LV> DI int partneri(int v, int lane) { return __builtin_bit_cast(int, partnerf<LV>(__builtin_bit_cast(float, v), lane)); }
DI float wave_sum(float v) {
    v += dppf<DPP_XOR1>(v); v += dppf<DPP_XOR2>(v); v += dppf<DPP_HMIRROR>(v); v += dppf<DPP_MIRROR>(v);
    { float a = v, b = v; swap16(a, b); v = a + b; }
    { float a = v, b = v; swap32(a, b); v = a + b; }
    return v;
}
#define LDS_WAIT() asm volatile("s_waitcnt lgkmcnt(0)" ::: "memory")
#define VM_WAIT() asm volatile("s_waitcnt vmcnt(0)" ::: "memory")

DI f32x2 gelu_pk(f32x2 v) {
    const f32x2 av = __builtin_elementwise_abs(v), d = av * 0.2316418882f + 1.0f;
    f32x2 t; t.x = __builtin_amdgcn_rcpf(d.x); t.y = __builtin_amdgcn_rcpf(d.y);
    f32x2 q = t * 0.5307027145f + (-0.7265760135f); q = q * t + 0.7107068705f; q = q * t + (-0.142248368f); q = q * t + 0.127414796f; q = q * t;
    const f32x2 s = (v * v) * (-0.72134752044f);
    f32x2 e; e.x = __builtin_amdgcn_exp2f(s.x); e.y = __builtin_amdgcn_exp2f(s.y);
    const f32x2 m = v * (q * e), r = v - m;
    f32x2 o; o.x = v.x < 0.f ? m.x : r.x; o.y = v.y < 0.f ? m.y : r.y; return o;
}
DI f32x4 gelu4(f32x4 v) { f32x2 a = gelu_pk((f32x2){v[0], v[1]}), b = gelu_pk((f32x2){v[2], v[3]}); return (f32x4){a.x, a.y, b.x, b.y}; }


struct Frame { int tid, lane, wave, bid; };
DI Frame opaque(const Frame& f) { Frame r; r.tid = threadIdx.x; asm volatile("" : "+v"(r.tid)); r.lane = r.tid & 63; r.wave = __builtin_amdgcn_readfirstlane(r.tid >> 6); r.bid = f.bid; return r; }
constexpr int G = 256;
template <int K> DI const float* inp() { const float* p; asm volatile("s_load_dwordx2 %0, %1, %2\n\ts_waitcnt lgkmcnt(0)" : "=s"(p) : "s"(__builtin_amdgcn_kernarg_segment_ptr()), "i"(K * 8)); return p; }
DI float* outp() { float* p; asm volatile("s_load_dwordx2 %0, %1, %2\n\ts_waitcnt lgkmcnt(0)" : "=s"(p) : "s"(__builtin_amdgcn_kernarg_segment_ptr()), "i"(23 * 8)); return p; }
DI unsigned char* wsp() { unsigned char* p; asm volatile("s_load_dwordx2 %0, %1, %2\n\ts_waitcnt lgkmcnt(0)" : "=s"(p) : "s"(__builtin_amdgcn_kernarg_segment_ptr()), "i"(24 * 8)); return p; }
enum { I_X = 0, I_POS = 1, I_LNING = 2, I_LNINB = 3, I_WIN = 4, I_BIN = 5, I_SINKS = 6, I_GNG = 7, I_GNB = 8, I_WS = 9, I_BS = 10, I_WOUT = 11, I_BOUT = 12, I_LN1G = 13, I_LN1B = 14,
       I_WR = 15, I_BR = 16, I_WGU = 17, I_BGU = 18, I_WD = 19, I_BD = 20, I_LN2G = 21, I_LN2B = 22 };

DI void dma16(const __amdgpu_buffer_rsrc_t rs, unsigned lds_addr, unsigned voff, unsigned soff) {
    asm volatile("s_mov_b32 m0, %0\n\ts_nop 0\n\tbuffer_load_dwordx4 %1, %2, %3 offen lds" :: "s"(lds_addr), "v"(voff), "s"(rs), "s"(soff) : "m0", "memory");
}
DI unsigned lds_u32(const LAS unsigned char* p) { return (unsigned)(uintptr_t)p; }
#define XB_TMO      128
#define XB_XCNT(j)  (256  + 64 * (j))
#define XB_XSUB(j)  (1280 + 64 * (j))
#define XB_XGEN(j)  (2304 + 64 * (j))
#define XB_TOP      3328
#define XB_TOPGEN   3392
#define XCD_BAR_WORDS 3456
#define XB_SPIN_CAP (1u << 18)
DI unsigned xb_ld(unsigned* p)              { return __hip_atomic_load(p, __ATOMIC_RELAXED, __HIP_MEMORY_SCOPE_AGENT); }
DI unsigned xb_add(unsigned* p, unsigned v) { return __hip_atomic_fetch_add(p, v, __ATOMIC_RELAXED, __HIP_MEMORY_SCOPE_AGENT); }
DI unsigned xb_xcc_id() { return (unsigned)__builtin_amdgcn_s_getreg((3 << 11) | 20) & 0xFu; }
#define XB_SPIN(cond, bar) do { unsigned _sp = 0; while (cond) { __builtin_amdgcn_s_sleep(1); \
    if ((++_sp & 255u) == 0u) { if (xb_ld(&(bar)[XB_TMO])) break; if (_sp > XB_SPIN_CAP) { atomicAdd(&(bar)[XB_TMO], 1u); break; } } } } while (0)
DI void xcd_barrier_post(unsigned* bar) { if (threadIdx.x == 0) (void)xb_add(&bar[XB_XCNT(xb_xcc_id())], 1u); }
DI void xcd_barrier_complete(unsigned* bar, unsigned x, unsigned& nloc, unsigned& nx) {
    unsigned sum, cnt, mine, sp = 0u;
    for (;;) {
        sum = 0u; cnt = 0u; mine = 0u;
#pragma unroll
        for (unsigned j = 0; j < 16; ++j) { const unsigned c = xb_ld(&bar[XB_XCNT(j)]); sum += c; cnt += (c > 0u) ? 1u : 0u; mine = (j == x) ? c : mine; }
        if (sum == (unsigned)G) break;
        __builtin_amdgcn_s_sleep(1);
        if ((++sp & 255u) == 0u) { if (xb_ld(&bar[XB_TMO])) break; if (sp > XB_SPIN_CAP) { atomicAdd(&bar[XB_TMO], 1u); break; } }
    }
    nloc = mine > 0u ? mine : 1u; nx = cnt > 0u ? cnt : 1u;
}
DI void xcd_barrier(volatile LAS unsigned* st) {
    asm volatile("s_waitcnt vmcnt(0)" ::: "memory");
    __syncthreads();
    if (threadIdx.x == 0) {
        unsigned* bar = (unsigned*)(wsp() + WS_CTL) + CW_BAR; const unsigned x = xb_xcc_id();
        __builtin_amdgcn_s_waitcnt(0);
        unsigned nloc = st[0], nx = st[1];
        if (nloc == 0u) { xcd_barrier_complete(bar, x, nloc, nx); st[0] = nloc; st[1] = nx; }
        const unsigned old = xb_add(&bar[XB_XSUB(x)], 1u);
        const unsigned gen = old / nloc;
        if (old + 1u == (gen + 1u) * nloc) {
            __builtin_amdgcn_fence(__ATOMIC_RELEASE, "agent");
            asm volatile("s_waitcnt vmcnt(0)" ::: "memory");
            const unsigned og = xb_add(&bar[XB_TOP], 1u);
            const unsigned tg = og / nx;
            if (og + 1u == (tg + 1u) * nx) xb_add(&bar[XB_TOPGEN], 1u);
            else XB_SPIN(xb_ld(&bar[XB_TOPGEN]) == tg, bar);
            __builtin_amdgcn_fence(__ATOMIC_ACQUIRE, "agent");
            xb_add(&bar[XB_XGEN(x)], 1u);
            asm volatile("s_waitcnt vmcnt(0)" ::: "memory");
        } else {
            XB_SPIN(xb_ld(&bar[XB_XGEN(x)]) == gen, bar);
            __builtin_amdgcn_fence(__ATOMIC_ACQUIRE, "agent");
            asm volatile("s_waitcnt vmcnt(0)" ::: "memory");
        }
    }
    __syncthreads();
}

namespace pg8 {
constexpr int BM = 256, HALF = 128, HTB = HALF * 128, NXCD = 8, WGM = 8, GK = 1024;
constexpr size_t KSTEP = 128;
DI int lds_byte(int r, int c) { const int st = (r >> 4) * 2 + (c >> 5), rr = r & 15, cc = c & 31, ob = rr * 64 + cc * 2; return st * 1024 + (ob ^ (((ob >> 9) & 1) << 5)); }
DI void stage_rc(int b, int& R, int& C) { const int st = b / 1024, sb = b % 1024, swz = sb ^ (((sb >> 9) & 1) << 5); R = (st >> 1) * 16 + swz / 64; C = (st & 1) * 32 + (swz % 64) / 2; }
DI int perm32(int rho) { const int n = rho >> 4, i = rho & 15; return 8 * (i >> 2) + 4 * n + (i & 3); }

struct Unit { int pm, pn, e; };

template <int M, int N> struct StaticOrder {
    int c;
    DI bool next(int i, Unit& u) const {
        constexpr int nM = M / BM, nN = N / BM, nwg = nM * nN;
        const int L = i * G + c; if (L >= nwg) return false;
        int wgid = L; { constexpr int q = nwg / NXCD, r = nwg % NXCD; const int xcd = wgid % NXCD, off = wgid / NXCD; wgid = (xcd < r ? xcd * (q + 1) : r * (q + 1) + (xcd - r) * q) + off; }
        constexpr int nig = WGM * nN; const int gid = wgid / nig, fm = gid * WGM, gsz = (nM - fm) < WGM ? (nM - fm) : WGM;
        u.pm = fm + ((wgid % nig) % gsz); u.pn = (wgid % nig) / gsz; u.e = 0; return true;
    }
};
template <int NPN> struct GroupOrder {
    int g0, g1, c;
    DI bool next(int i, Unit& u) const {
        constexpr int GPX = 32 / NPN;
        const int x = c & 7, j = c >> 3;
        const int g = g0 + i * (8 * GPX) + x * GPX + j / NPN;
        if (g >= g1) return false;
        u.pm = g; u.pn = j % NPN;
        { const unsigned char* p = wsp() + WS_GRPE + (size_t)g * 4; int e; asm volatile("s_load_dword %0, %1, 0x0\n\ts_waitcnt lgkmcnt(0)" : "=s"(e) : "s"(p)); u.e = e; }
        return true;
    }
};
DI void piece_rc(int i, int& R, int& C) { int t = threadIdx.x; asm volatile("" : "+v"(t)); stage_rc(t * 16 + i * 8192, R, C); }
DI unsigned tok_off(const LAS int* tb, int h, int i, unsigned pitch) { int R, C; piece_rc(i, R, C); int tok = tb[h * HALF + R]; tok = tok < 0 ? 0 : tok; return (unsigned)tok * pitch + (unsigned)C * 2u; }

struct FragBF { bf16x8 k0, k1; };
struct FragF8 { v8i v; };
DI void ldfrag(FragBF& f, const LAS unsigned char* p) { f.k0 = *(const LAS bf16x8*)p; f.k1 = *(const LAS bf16x8*)(p + 1024); }
typedef int v8i_a16 __attribute__((ext_vector_type(8), aligned(16)));
DI void ldfrag(FragF8& f, const LAS unsigned char* p) { f.v = *(const LAS v8i_a16*)p; }
DI void mma(f32x4& acc, const FragBF& w, const FragBF& a) { acc = __builtin_amdgcn_mfma_f32_16x16x32_bf16(w.k0, a.k0, acc, 0, 0, 0); acc = __builtin_amdgcn_mfma_f32_16x16x32_bf16(w.k1, a.k1, acc, 0, 0, 0); }
DI void mma(f32x4& acc, const FragF8& w, const FragF8& a) { acc = __builtin_amdgcn_mfma_scale_f32_16x16x128_f8f6f4(w.v, a.v, acc, 0, 0, 0, WQ_E8M0, 0, 127); }
template <class Cfg, class Epi, class Sched>
DI void gemm_phase(LAS unsigned char* lds, LAS unsigned char* tokbuf, const int pm_bias, const Sched& S, const Epi& E) {
    constexpr bool GATHER = Cfg::GATHER, FP8 = Cfg::FP8;
    constexpr int ROWB = FP8 ? GK : 2 * GK, NT = ROWB / 128;
    constexpr size_t HSTEP = (size_t)HALF * ROWB, TSTEP = 2 * HSTEP;
    using Frag = typename std::conditional<FP8, FragF8, FragBF>::type;
    int tid = threadIdx.x; asm volatile("" : "+v"(tid));
    const int wid = __builtin_amdgcn_readfirstlane(tid >> 6), lane = tid & 63, wr = wid >> 2, wc = wid & 3, fr = lane & 15, fq = lane >> 4;
    unsigned voffB[2], vaC[2][2];
#pragma unroll
    for (int i = 0; i < 2; ++i) { int R, C; stage_rc(tid * 16 + i * 8192, R, C); const int Rb = Epi::PERM ? ((R & ~31) + perm32(R & 31)) : R;
        voffB[i] = (unsigned)(Rb * ROWB + C * 2); vaC[0][i] = (unsigned)(R * ROWB + C * 2); vaC[1][i] = vaC[0][i]; }
    constexpr size_t AHSTEP = GATHER ? (size_t)0 : HSTEP;
    const unsigned ldsw = (unsigned)wid * 1024u, ldsb = lds_u32(lds);
    const int cfr = FP8 ? (fq >> 1) * 32 + (fq & 1) * 16 : fq * 8;
    const int aoff = lds_byte(wr * 64 + fr, cfr);
    int boff = lds_byte(wc * 32 + fr, cfr) + 4 * HTB; asm volatile("" : "+v"(boff));
#define PG8_SA(b, h) (((b) * 2 + (h)) * HTB)
#define PG8_SB(b, h) ((4 + (b) * 2 + (h)) * HTB)
    const __amdgpu_buffer_rsrc_t rs = __builtin_amdgcn_make_buffer_rsrc((void*)wsp(), 0, 0x40000000, 0x00020000);
#define PG8_STAGEB(bufoff, soff) do { _Pragma("unroll") for (int _i = 0; _i < 2; ++_i) dma16(rs, ldsb + (bufoff) + ldsw + _i * 8192, voffB[_i], (soff)); } while (0)
#define PG8_STAGEA(bufoff, soff, o0, o1) do { dma16(rs, ldsb + (bufoff) + ldsw, (o0), (soff)); dma16(rs, ldsb + (bufoff) + ldsw + 8192, (o1), (soff)); } while (0)
#define PG8_LDA(dst, b, h) do { _Pragma("unroll") for (int m = 0; m < 4; ++m) ldfrag(dst[m], lds + PG8_SA(b, h) + aoff + m * 2048); } while (0)
#define PG8_LDB(dst, b, h) do { _Pragma("unroll") for (int n = 0; n < 2; ++n) ldfrag(dst[n], lds + ((b) * 2 + (h)) * HTB + boff + n * 2048); } while (0)
#define PG8_MMA(ai, bj, At, Bt) do { __builtin_amdgcn_s_setprio(1); _Pragma("unroll") for (int m = 0; m < 4; ++m) _Pragma("unroll") for (int n = 0; n < 2; ++n) \
        mma(acc[ai][bj][m][n], Bt[n], At[m]); __builtin_amdgcn_s_setprio(0); } while (0)
#define PG8_WAIT_V(n) asm volatile("s_waitcnt vmcnt(" #n ")" ::: "memory")
#define PG8_WAIT_L(n) asm volatile("s_waitcnt lgkmcnt(" #n ")" ::: "memory")
#define PG8_BAR __builtin_amdgcn_s_barrier()
#define PG8_SCHED __builtin_amdgcn_sched_barrier(0)
#define PG8_ABASE(u) (GATHER ? (unsigned)Cfg::A_OFF : (unsigned)(Cfg::A_OFF + (size_t)((u).pm - pm_bias) * TSTEP))
#define PG8_BBASE(u) ((unsigned)(Cfg::B_OFF + (size_t)(u).e * Cfg::B_E_BYTES + (size_t)(u).pn * TSTEP))
#define PG8_TOKDMA(u, dst) dma16(rs, lds_u32(dst), (unsigned)lane * 16u, (unsigned)(WS_SLOTTOK + (size_t)(u).pm * 1024))
    Unit cur, nxt; int ui = 0;
    if (!S.next(0, cur)) return;
    if constexpr (GATHER) {
        if (wid == 0) PG8_TOKDMA(cur, tokbuf);
        PG8_WAIT_V(0); PG8_BAR;
#pragma unroll
        for (int h = 0; h < 2; ++h)
#pragma unroll
            for (int i = 0; i < 2; ++i) vaC[h][i] = tok_off((const LAS int*)tokbuf, h, i, Cfg::A_PITCH);
        PG8_WAIT_L(0); PG8_BAR;
    }
    f32x4 acc[2][2][4][2];
#pragma unroll
    for (int a = 0; a < 2; ++a)
#pragma unroll
        for (int b = 0; b < 2; ++b)
#pragma unroll
            for (int m = 0; m < 4; ++m)
#pragma unroll
                for (int n = 0; n < 2; ++n) acc[a][b][m][n] = (f32x4){0.f, 0.f, 0.f, 0.f};
    Frag At[4], B0[2], B1[2];
    unsigned cA = PG8_ABASE(cur);
    unsigned cB = PG8_BBASE(cur);
    PG8_STAGEB(PG8_SB(0, 0), cB); PG8_STAGEB(PG8_SB(0, 1), cB + (unsigned)HSTEP); PG8_STAGEA(PG8_SA(0, 0), cA, vaC[0][0], vaC[0][1]); PG8_STAGEA(PG8_SA(0, 1), cA + (unsigned)AHSTEP, vaC[1][0], vaC[1][1]);
    if (wr == 1) PG8_BAR;
    PG8_WAIT_V(2); PG8_BAR;
    PG8_STAGEB(PG8_SB(1, 0), cB + (unsigned)KSTEP); PG8_STAGEA(PG8_SA(1, 0), cA + (unsigned)KSTEP, vaC[0][0], vaC[0][1]); PG8_STAGEB(PG8_SB(1, 1), cB + (unsigned)(HSTEP + KSTEP));
    PG8_WAIT_V(6); PG8_BAR;
    for (;;) {
        const bool has_next = S.next(ui + 1, nxt);
        const LAS int* tbn = (const LAS int*)(tokbuf + ((ui + 1) & 1) * 1024);
        if constexpr (Epi::PREFETCH) E.prefetch(rs, lds, cur, ui, wid, lane);
        if constexpr (GATHER) {
            if (has_next && wid == 0) PG8_TOKDMA(nxt, tokbuf + ((ui + 1) & 1) * 1024);
        }
        asm volatile(".p2align 8" ::: "memory");
#pragma unroll 1
        for (int t = 0; t < NT; t += 2) {
            const bool last = (t == NT - 2);
            const unsigned a1 = cA + (unsigned)(t + 1) * (unsigned)KSTEP;
            unsigned a2 = cA + (unsigned)(t + 2) * (unsigned)KSTEP, b2 = cB + (unsigned)(t + 2) * (unsigned)KSTEP;
            if (last) {
                if (has_next) { a2 = PG8_ABASE(nxt); b2 = PG8_BBASE(nxt);
                    if constexpr (GATHER) { vaC[0][0] = tok_off(tbn, 0, 0, Cfg::A_PITCH); vaC[0][1] = tok_off(tbn, 0, 1, Cfg::A_PITCH); } }
                else { a2 = cA; b2 = cB; }
            }
            const unsigned a3 = a2 + (unsigned)KSTEP, b3 = b2 + (unsigned)KSTEP;
            PG8_LDB(B0, 0, 0); PG8_LDB(B1, 0, 1); PG8_SCHED; PG8_LDA(At, 0, 0); PG8_STAGEA(PG8_SA(1, 1), a1 + (unsigned)AHSTEP, vaC[1][0], vaC[1][1]);
            if constexpr (GATHER) { if (last && has_next) { vaC[1][0] = tok_off(tbn, 1, 0, Cfg::A_PITCH); vaC[1][1] = tok_off(tbn, 1, 1, Cfg::A_PITCH); } }
            PG8_WAIT_V(8); PG8_WAIT_L(0); PG8_BAR; PG8_MMA(0, 0, At, B0); PG8_MMA(0, 1, At, B1); PG8_BAR; PG8_SCHED;
            PG8_LDA(At, 0, 1); PG8_STAGEB(PG8_SB(0, 0), b2); PG8_STAGEB(PG8_SB(0, 1), b2 + (unsigned)HSTEP); PG8_STAGEA(PG8_SA(0, 0), a2, vaC[0][0], vaC[0][1]);
            PG8_WAIT_V(8); PG8_WAIT_L(0); PG8_BAR; PG8_MMA(1, 0, At, B0); PG8_MMA(1, 1, At, B1); PG8_BAR; PG8_SCHED;
            PG8_LDB(B0, 1, 0); PG8_LDB(B1, 1, 1); PG8_SCHED; PG8_LDA(At, 1, 0); PG8_STAGEA(PG8_SA(0, 1), a2 + (unsigned)AHSTEP, vaC[1][0], vaC[1][1]);
            PG8_WAIT_V(8); PG8_WAIT_L(0); PG8_BAR; PG8_MMA(0, 0, At, B0); PG8_MMA(0, 1, At, B1); PG8_BAR; PG8_SCHED;
            PG8_LDA(At, 1, 1); PG8_STAGEB(PG8_SB(1, 0), b3); PG8_STAGEB(PG8_SB(1, 1), b3 + (unsigned)HSTEP); PG8_STAGEA(PG8_SA(1, 0), a3, vaC[0][0], vaC[0][1]);
            PG8_WAIT_V(8); PG8_WAIT_L(0); PG8_BAR; PG8_MMA(1, 0, At, B0); PG8_MMA(1, 1, At, B1); PG8_BAR; PG8_SCHED;
        }
        if (wr == 0) PG8_BAR;
        E(acc, cur, wr, wc, fr, fq, lds, ui);
        if (!has_next) break;
#pragma unroll
        for (int a = 0; a < 2; ++a)
#pragma unroll
            for (int b = 0; b < 2; ++b)
#pragma unroll
                for (int m = 0; m < 4; ++m)
#pragma unroll
                    for (int n = 0; n < 2; ++n) acc[a][b][m][n] = (f32x4){0.f, 0.f, 0.f, 0.f};
        cur = nxt; cA = PG8_ABASE(cur); cB = PG8_BBASE(cur); ++ui;
        if (wr == 1) PG8_BAR;
    }
    PG8_WAIT_V(0);
    PG8_BAR;
#undef PG8_SA
#undef PG8_SB
#undef PG8_STAGEA
#undef PG8_STAGEB
#undef PG8_LDA
#undef PG8_LDB
#undef PG8_MMA
#undef PG8_WAIT_V
#undef PG8_WAIT_L
#undef PG8_BAR
#undef PG8_SCHED
#undef PG8_ABASE
#undef PG8_BBASE
#undef PG8_TOKDMA
}
}

#define EPI_DMA(w, dstoff, wsoff) do { if (wid == (w)) dma16(rs, lds_u32(eb) + (dstoff), (unsigned)lane * 16u, (unsigned)(wsoff)); } while (0)
struct EpiInProj {
    static constexpr bool PERM = true, PREFETCH = true;
    DI void prefetch(const __amdgpu_buffer_rsrc_t rs, LAS unsigned char* lds, const pg8::Unit& u, int ui, int wid, int lane) const {
        LAS unsigned char* eb = lds + EPIBUF_OFF + (ui & 1) * EPIBUF_SZ;
        EPI_DMA(1, 0, WS_BINP + (size_t)u.pn * 1024); EPI_DMA(2, 1024, WS_POSF + (size_t)u.pm * 1024);
    }
    DI void operator()(f32x4 (&acc)[2][2][4][2], const pg8::Unit& u, int wr, int wc, int fr, int fq, LAS unsigned char* lds, int ui) const {
        const int pn = u.pn;
        int kind, head, ldc; size_t boff;
        if (pn < 2) { kind = 0; head = 4 * pn + wc; boff = WS_QB; ldc = 512; }
        else if (pn == 2) { if (wc < 2) { kind = 1; head = wc; boff = WS_KB; } else { kind = 2; head = wc - 2; boff = WS_VB; } ldc = 128; }
        else if (pn < 5) { kind = 3; head = 4 * (pn - 3) + wc; boff = WS_GUB; ldc = 512; }
        else { kind = 4; head = 4 * (pn - 5) + wc; boff = WS_GVB; ldc = 512; }
        bf16_t* base = (bf16_t*)(wsp() + boff);
        const LAS float* bbuf = (const LAS float*)(lds + EPIBUF_OFF + (ui & 1) * EPIBUF_SZ); const LAS float* pbuf = bbuf + 256;
#pragma unroll
        for (int bj = 0; bj < 2; ++bj)
#pragma unroll
            for (int n = 0; n < 2; ++n) { const f32x4 bv = *(const LAS f32x4*)(bbuf + 128 * bj + 32 * wc + 8 * fq + 4 * n);
#pragma unroll
                for (int ai = 0; ai < 2; ++ai)
#pragma unroll
                    for (int m = 0; m < 4; ++m) acc[ai][bj][m][n] += bv; }
        const float* gn_g = inp<I_GNG>(); const float* gn_b = inp<I_GNB>();
        const int row0 = u.pm * 256 + wr * 64 + fr;
#pragma unroll
        for (int ai = 0; ai < 2; ++ai)
#pragma unroll
            for (int m = 0; m < 4; ++m) {
                const int row = row0 + ai * 128 + m * 16;
                f32x4 v[2][2];
#pragma unroll
                for (int bj = 0; bj < 2; ++bj)
#pragma unroll
                    for (int n = 0; n < 2; ++n) v[bj][n] = acc[ai][bj][m][n];
                if (kind <= 1) {
                    const float pos = pbuf[wr * 64 + fr + ai * 128 + m * 16];
#pragma unroll
                    for (int n = 0; n < 2; ++n) {
                        f32x4 c4, s4;
#pragma unroll
                        for (int j = 0; j < 4; ++j) { const int i = 4 * n + j;
                            const float invr = i == 0 ? 1.5915494309189535e-01f : i == 1 ? 3.086376340470123e-02f : i == 2 ? 5.985185712713705e-03f : i == 3 ? 1.160663641240061e-03f : i == 4 ? 2.2507907903927653e-04f : i == 5 ? 4.364795279280289e-05f : i == 6 ? 8.464330808241401e-06f : 1.6414262627950345e-06f;
                            float rev = pos * invr; rev -= floorf(rev); c4[j] = __builtin_amdgcn_cosf(rev); s4[j] = __builtin_amdgcn_sinf(rev); }
                        f32x4 p4;
#pragma unroll
                        for (int j = 0; j < 4; ++j) { float a_ = v[0][n][j], b_ = a_; swap16(a_, b_); p4[j] = (fq & 1) ? a_ : b_; }
                        const f32x4 sg = (fq & 1) ? s4 : -s4;
                        const f32x4 rot = v[0][n] * c4 + p4 * sg;
                        if (fq < 2) v[0][n] = rot;
                    }
                    if (kind == 0) {
#pragma unroll
                        for (int bj = 0; bj < 2; ++bj)
#pragma unroll
                            for (int n = 0; n < 2; ++n) v[bj][n] = v[bj][n] * QSCALE;
                    }
                } else if (kind >= 3) {
#pragma unroll
                    for (int bj = 0; bj < 2; ++bj)
#pragma unroll
                        for (int n = 0; n < 2; ++n) v[bj][n] = gelu4(v[bj][n]);
                    if (kind == 4) {
                        float s = 0.f;
#pragma unroll
                        for (int bj = 0; bj < 2; ++bj)
#pragma unroll
                            for (int n = 0; n < 2; ++n) s += (v[bj][n][0] + v[bj][n][1]) + (v[bj][n][2] + v[bj][n][3]);
                        s += __shfl_xor(s, 16); s += __shfl_xor(s, 32);
                        const float mean = s * (1.0f / 64.0f); float q = 0.f;
#pragma unroll
                        for (int bj = 0; bj < 2; ++bj)
#pragma unroll
                            for (int n = 0; n < 2; ++n) { v[bj][n] = v[bj][n] - mean; const f32x4 d = v[bj][n]; q += (d[0] * d[0] + d[1] * d[1]) + (d[2] * d[2] + d[3] * d[3]); }
                        q += __shfl_xor(q, 16); q += __shfl_xor(q, 32);
                        const float rstd = 1.0f / sqrtf(q * (1.0f / 64.0f) + LN_EPS);
#pragma unroll
                        for (int bj = 0; bj < 2; ++bj)
#pragma unroll
                            for (int n = 0; n < 2; ++n) v[bj][n] = v[bj][n] * rstd * *(const f32x4*)(gn_g + 32 * bj + 8 * fq + 4 * n) + *(const f32x4*)(gn_b + 32 * bj + 8 * fq + 4 * n);
                    }
                }
                bf16_t* rowp = base + (size_t)row * ldc + head * 64 + 8 * fq;
#pragma unroll
                for (int bj = 0; bj < 2; ++bj) { u32x4 w; w.x = cvtpk(v[bj][0][0], v[bj][0][1]); w.y = cvtpk(v[bj][0][2], v[bj][0][3]); w.z = cvtpk(v[bj][1][0], v[bj][1][1]); w.w = cvtpk(v[bj][1][2], v[bj][1][3]);
                    *(u32x4*)(rowp + 32 * bj) = w; }
            }
    }
};
struct EpiOut {
    static constexpr bool PERM = false, PREFETCH = true;
    DI void prefetch(const __amdgpu_buffer_rsrc_t rs, LAS unsigned char* lds, const pg8::Unit& u, int ui, int wid, int lane) const {
        LAS unsigned char* eb = lds + EPIBUF_OFF + (ui & 1) * EPIBUF_SZ;
        EPI_DMA(1, 0, WS_OUTC + (size_t)u.pn * 1024); EPI_DMA(2, 1024, WS_OUTC + 4096 + (size_t)u.pn * 1024);
        EPI_DMA(3, 2048, WS_STATS0 + (size_t)u.pm * 2048); EPI_DMA(4, 3072, WS_STATS0 + (size_t)u.pm * 2048 + 1024);
    }
    DI void operator()(f32x4 (&acc)[2][2][4][2], const pg8::Unit& u, int wr, int wc, int fr, int fq, LAS unsigned char* lds, int ui) const {
        const int col0 = u.pn * 256 + wc * 32 + 4 * fq;
        float* y1 = outp();
        const float* x = inp<I_X>();
        const LAS float* cbuf = (const LAS float*)(lds + EPIBUF_OFF + (ui & 1) * EPIBUF_SZ); const LAS f32x2* sbuf = (const LAS f32x2*)(cbuf + 512);
        f32x4 ca[2][2];
#pragma unroll
        for (int bj = 0; bj < 2; ++bj)
#pragma unroll
            for (int n = 0; n < 2; ++n) { const int tc = wc * 32 + 4 * fq + bj * 128 + n * 16; ca[bj][n] = *(const LAS f32x4*)(cbuf + tc); const f32x4 cb = *(const LAS f32x4*)(cbuf + 256 + tc);
#pragma unroll
                for (int ai = 0; ai < 2; ++ai)
#pragma unroll
                    for (int m = 0; m < 4; ++m) acc[ai][bj][m][n] += cb; }
        const int row0 = u.pm * 256 + wr * 64 + fr;
#pragma unroll
        for (int ai = 0; ai < 2; ++ai) {
            f32x4 xv[4][2][2];
#pragma unroll
            for (int m = 0; m < 4; ++m) { const size_t off = (size_t)(row0 + ai * 128 + m * 16) * D + col0;
#pragma unroll
                for (int bj = 0; bj < 2; ++bj)
#pragma unroll
                    for (int n = 0; n < 2; ++n) xv[m][bj][n] = *(const f32x4*)(x + off + bj * 128 + n * 16); }
#pragma unroll
            for (int m = 0; m < 4; ++m) {
                const int rt = wr * 64 + fr + ai * 128 + m * 16;
                const f32x2 st = sbuf[rt];
                const size_t off = (size_t)(row0 + ai * 128 + m * 16) * D + col0;
#pragma unroll
                for (int bj = 0; bj < 2; ++bj)
#pragma unroll
                    for (int n = 0; n < 2; ++n) { const f32x4 o = acc[ai][bj][m][n] + (xv[m][bj][n] - st.x) * st.y * ca[bj][n];
                        *(f32x4*)(y1 + off + bj * 128 + n * 16) = o; }
            }
            asm volatile("" ::: "memory");
        }
    }
};
struct EpiGateUp {
    static constexpr bool PERM = true, PREFETCH = true;
    DI void prefetch(const __amdgpu_buffer_rsrc_t rs, LAS unsigned char* lds, const pg8::Unit& u, int ui, int wid, int lane) const {
        LAS unsigned char* eb = lds + EPIBUF_OFF + (ui & 1) * EPIBUF_SZ;
        EPI_DMA(1, 0, WS_BGU + ((size_t)u.e * 8 + u.pn) * 1024);
    }
    DI void operator()(f32x4 (&acc)[2][2][4][2], const pg8::Unit& u, int wr, int wc, int fr, int fq, LAS unsigned char* lds, int ui) const {
        const int hcol0 = 128 * u.pn + 32 * wc + 8 * fq;
        unsigned char* hmid = wsp() + WS_HMID;
        const LAS float* bbuf = (const LAS float*)(lds + EPIBUF_OFF + (ui & 1) * EPIBUF_SZ);
        f32x4 bg[2], bu[2];
#pragma unroll
        for (int n = 0; n < 2; ++n) { bg[n] = *(const LAS f32x4*)(bbuf + 32 * wc + 8 * fq + 4 * n); bu[n] = *(const LAS f32x4*)(bbuf + 128 + 32 * wc + 8 * fq + 4 * n); }
        const size_t row0 = (size_t)u.pm * 256 + wr * 64 + fr;
#pragma unroll
        for (int ai = 0; ai < 2; ++ai)
#pragma unroll
            for (int m = 0; m < 4; ++m) {
                float h[2][4];
#pragma unroll
                for (int n = 0; n < 2; ++n) {
                    const f32x4 gt = acc[ai][0][m][n] + bg[n], up = acc[ai][1][m][n] + bu[n];
#pragma unroll
                    for (int j = 0; j < 4; ++j) {
                        const float gc = fminf(gt[j], 7.0f), uc = fminf(fmaxf(up[j], -7.0f), 7.0f);
                        const float sg = __builtin_amdgcn_rcpf(1.0f + __builtin_amdgcn_exp2f(gc * (-1.702f * LOG2E)));
                        h[n][j] = (uc + 1.0f) * (gc * sg);
                    }
                }
                u32x2 w; w.x = cvt4_fp8(h[0][0], h[0][1], h[0][2], h[0][3]); w.y = cvt4_fp8(h[1][0], h[1][1], h[1][2], h[1][3]);
                *(u32x2*)(hmid + (row0 + ai * 128 + m * 16) * 1024 + hcol0) = w;
            }
    }
};
struct EpiDown {
    static constexpr bool PERM = true, PREFETCH = true;
    DI void prefetch(const __amdgpu_buffer_rsrc_t rs, LAS unsigned char* lds, const pg8::Unit& u, int ui, int wid, int lane) const {
        LAS unsigned char* eb = lds + EPIBUF_OFF + (ui & 1) * EPIBUF_SZ;
        EPI_DMA(1, 0, WS_SLOTDEST + (size_t)u.pm * 1024); EPI_DMA(2, 1024, WS_SLOTGATE + (size_t)u.pm * 1024); EPI_DMA(3, 2048, WS_BD + (size_t)u.e * 4096 + (size_t)u.pn * 1024);
    }
    DI void operator()(f32x4 (&acc)[2][2][4][2], const pg8::Unit& u, int wr, int wc, int fr, int fq, LAS unsigned char* lds, int ui) const {
        const int col0 = 256 * u.pn + 32 * wc + 8 * fq;
        bf16_t* yslot = (bf16_t*)(wsp() + WS_YSLOT);
        const LAS int* dbuf = (const LAS int*)(lds + EPIBUF_OFF + (ui & 1) * EPIBUF_SZ); const LAS float* gbuf = (const LAS float*)(dbuf + 256); const LAS float* bbuf = gbuf + 256;
        f32x4 bd[2][2];
#pragma unroll
        for (int bj = 0; bj < 2; ++bj)
#pragma unroll
            for (int n = 0; n < 2; ++n) bd[bj][n] = *(const LAS f32x4*)(bbuf + 128 * bj + 32 * wc + 8 * fq + 4 * n);
        int dest[2][4]; float gt[2][4];
#pragma unroll
        for (int ai = 0; ai < 2; ++ai)
#pragma unroll
            for (int m = 0; m < 4; ++m) { const int r = wr * 64 + fr + ai * 128 + m * 16; dest[ai][m] = dbuf[r]; gt[ai][m] = gbuf[r]; }
#pragma unroll
        for (int ai = 0; ai < 2; ++ai)
#pragma unroll
            for (int m = 0; m < 4; ++m) {
                if (dest[ai][m] >= 0) {
                    bf16_t* rowp = yslot + (size_t)dest[ai][m] * 1024 + col0;
#pragma unroll
                    for (int bj = 0; bj < 2; ++bj) { const f32x4 v0 = (acc[ai][bj][m][0] + bd[bj][0]) * gt[ai][m], v1 = (acc[ai][bj][m][1] + bd[bj][1]) * gt[ai][m];
                        u32x4 w; w.x = cvtpk(v0[0], v0[1]); w.y = cvtpk(v0[2], v0[3]); w.z = cvtpk(v1[0], v1[1]); w.w = cvtpk(v1[2], v1[3]);
                        *(u32x4*)(rowp + 128 * bj) = w; }
                }
            }
    }
};
#undef EPI_DMA

DI int rowmap(int kind, int n) {
    if (kind == 0) { const int pn = n >> 8, ch = n & 255, wc = ch >> 6, bj = (ch >> 5) & 1, w = ch & 31; return (pn << 8) + (bj << 7) + (wc << 5) + w; }
    if (kind == 2) { return n < 1024 ? ((n >> 7) << 8) + (n & 127) : (((n - 1024) >> 7) << 8) + 128 + ((n - 1024) & 127); }
    return n;
}
DI void p0_transpose_item(const float* W, int N, bf16_t* WT, int kind, LAS unsigned char* scr, int item, int lane) {
    const int nblk = N / 64, kb = item / nblk, nb = item % nblk, k0 = 64 * kb, n0 = 64 * nb;
    const int nq = lane >> 2, kr = lane & 3;
    f32x4 a[8], b[8];
#pragma unroll
    for (int i = 0; i < 8; ++i) { const float* p = W + (size_t)(k0 + 8 * i + 2 * kr) * N + n0 + 4 * nq; a[i] = *(const GAS f32x4*)p; b[i] = *(const GAS f32x4*)(p + N); }
#pragma unroll
    for (int i = 0; i < 8; ++i)
#pragma unroll
        for (int c = 0; c < 4; ++c) *(LAS unsigned*)(scr + (4 * nq + c) * 132 + (8 * i + 2 * kr) * 2) = cvtpk(a[i][c], b[i][c]);
    LDS_WAIT(); asm volatile("" ::: "memory");
    const int c8 = lane & 7;
#pragma unroll
    for (int j = 0; j < 8; ++j) { const int n = (lane >> 3) + 8 * j; const LAS unsigned* s = (const LAS unsigned*)(scr + n * 132 + 16 * c8);
        u32x4 o; o.x = s[0]; o.y = s[1]; o.z = s[2]; o.w = s[3];
        *(GAS u32x4*)(WT + (size_t)rowmap(kind, n0 + n) * 1024 + k0 + 8 * c8) = o; }
    LDS_WAIT(); asm volatile("" ::: "memory");
}
struct QItem { const float* W; unsigned char* WT; int N, kind, k0, n0; };
DI QItem p0_qitem(int r, const float* wgu, const float* wd, unsigned char* ws) {
    constexpr int I_GU = (D / 128) * (2048 / 32), I_D = (D / 128) * (D / 32);
    QItem q;
    if (r < NE * I_GU) { const int e = r / I_GU, it = r % I_GU; q.W = wgu + (size_t)e * D * 2048; q.WT = ws + WS_WGU + (size_t)e * 2048 * D; q.N = 2048; q.kind = 2; q.k0 = 128 * (it / 64); q.n0 = 32 * (it % 64); }
    else { r -= NE * I_GU; const int e = r / I_D, it = r % I_D; q.W = wd + (size_t)e * D * D; q.WT = ws + WS_WD + (size_t)e * D * D; q.N = D; q.kind = 1; q.k0 = 128 * (it / 32); q.n0 = 32 * (it % 32); }
    return q;
}
DI void p0_qload(const QItem& q, f32x4 (&a)[4][4], int lane) {
    const int nq = lane >> 3, kr = lane & 7;
#pragma unroll
    for (int i = 0; i < 4; ++i) { const float* p = q.W + (size_t)(q.k0 + 32 * i + 4 * kr) * q.N + q.n0 + 4 * nq;
#pragma unroll
        for (int u = 0; u < 4; ++u) a[i][u] = *(const GAS f32x4*)(p + (size_t)u * q.N); }
}
DI void p0_qfinish(const QItem& q, const f32x4 (&a)[4][4], LAS unsigned char* scr, int lane) {
    const int nq = lane >> 3, kr = lane & 7;
#pragma unroll
    for (int i = 0; i < 4; ++i)
#pragma unroll
        for (int c = 0; c < 4; ++c) *(LAS unsigned*)(scr + (4 * nq + c) * 136 + 32 * i + 4 * kr) = cvt4_fp8(a[i][0][c] * WQ_SCALE, a[i][1][c] * WQ_SCALE, a[i][2][c] * WQ_SCALE, a[i][3][c] * WQ_SCALE);
    LDS_WAIT(); asm volatile("" ::: "memory");
    const int c8 = lane & 7;
#pragma unroll
    for (int j = 0; j < 4; ++j) { const int n = (lane >> 3) + 8 * j; const LAS u32x2* s = (const LAS u32x2*)(scr + n * 136 + 16 * c8);
        const u32x2 x = s[0], y = s[1]; u32x4 o; o.x = x.x; o.y = x.y; o.z = y.x; o.w = y.y;
        *(GAS u32x4*)(q.WT + (size_t)rowmap(q.kind, q.n0 + n) * 1024 + q.k0 + 16 * c8) = o; }
    LDS_WAIT(); asm volatile("" ::: "memory");
}
DI void p0_prologue(const Frame& F0, LAS unsigned char* lds) {
    const Frame F = opaque(F0);
    unsigned char* ws = wsp();
    LAS unsigned char* scr = lds + F.wave * 16384;
    const int gw = F.bid * NWAVES + F.wave, NGW = G * NWAVES;
    const int gt = F.bid * NTHREADS + F.tid, NGT = G * NTHREADS;
    constexpr int I_IN = (D / 64) * (INW / 64), I_OUT = (D / 64) * (D / 64), I_GU = (D / 128) * (2048 / 32), I_D = (D / 128) * (D / 32);
    for (int it = gw; it < I_IN + I_OUT; it += NGW) {
        if (it < I_IN) p0_transpose_item(inp<I_WIN>(), INW, (bf16_t*)(ws + WS_WIN), 0, scr, it, F.lane);
        else p0_transpose_item(inp<I_WOUT>(), D, (bf16_t*)(ws + WS_WOUT), 1, scr, it - I_IN, F.lane);
    }
    {
        constexpr int NQ = NE * (I_GU + I_D);
        const float* wgu = inp<I_WGU>(); const float* wd = inp<I_WD>();
        f32x4 ra[4][4], rb[4][4];
        QItem qa = p0_qitem(gw < NQ ? gw : 0, wgu, wd, ws), qb = qa;
        if (gw < NQ) p0_qload(qa, ra, F.lane);
#pragma unroll 1
        for (int it = gw; it < NQ; it += 2 * NGW) {
            const bool hb = it + NGW < NQ;
            if (hb) { qb = p0_qitem(it + NGW, wgu, wd, ws); p0_qload(qb, rb, F.lane); }
            p0_qfinish(qa, ra, scr, F.lane);
            if (it + 2 * NGW < NQ) { qa = p0_qitem(it + 2 * NGW, wgu, wd, ws); p0_qload(qa, ra, F.lane); }
            if (hb) p0_qfinish(qb, rb, scr, F.lane);
        }
    }
    bf16_t* h0b = (bf16_t*)(ws + WS_H0B); float* stats0 = (float*)(ws + WS_STATS0);
    const float* xin = inp<I_X>(); const float* lg = inp<I_LNING>(); const float* lb = inp<I_LNINB>();
    {
        f32x4 pf[4][4];
#pragma unroll
        for (int u = 0; u < 4; ++u)
#pragma unroll
            for (int j = 0; j < 4; ++j) pf[u][j] = ((const GAS f32x4*)(xin + (size_t)(gw + u * NGW) * D))[F.lane + 64 * j];
        f32x4 gg[4], bb[4];
#pragma unroll
        for (int j = 0; j < 4; ++j) { gg[j] = ((const f32x4*)lg)[F.lane + 64 * j]; bb[j] = ((const f32x4*)lb)[F.lane + 64 * j]; }
#pragma unroll 1
        for (int m0 = gw; m0 < T; m0 += 4 * NGW) {
#pragma unroll
            for (int u = 0; u < 4; ++u) {
                const int m = m0 + u * NGW;
                f32x4 v[4]; float s = 0.f;
#pragma unroll
                for (int j = 0; j < 4; ++j) { v[j] = pf[u][j]; s += (v[j].x + v[j].y) + (v[j].z + v[j].w); }
                { const int mn = (m + 4 * NGW < T) ? m + 4 * NGW : m;
#pragma unroll
                  for (int j = 0; j < 4; ++j) pf[u][j] = ((const GAS f32x4*)(xin + (size_t)mn * D))[F.lane + 64 * j]; }
                const float mean = wave_sum(s) * (1.f / D); float s2 = 0.f;
#pragma unroll
                for (int j = 0; j < 4; ++j) { v[j] = v[j] - mean; s2 += (v[j].x * v[j].x + v[j].y * v[j].y) + (v[j].z * v[j].z + v[j].w * v[j].w); }
                const float rstd = 1.f / sqrtf(wave_sum(s2) * (1.f / D) + LN_EPS);
                GAS u32x2* o8 = (GAS u32x2*)(h0b + (size_t)m * D) + F.lane;
#pragma unroll
                for (int j = 0; j < 4; ++j) { const f32x4 r = v[j] * rstd * gg[j] + bb[j]; u32x2 w; w.x = cvtpk(r.x, r.y); w.y = cvtpk(r.z, r.w); o8[64 * j] = w; }
                if (F.lane == 0) { stats0[2 * m] = mean; stats0[2 * m + 1] = rstd; }
            }
        }
    }
    {
        const int* positions = (const int*)inp<I_POS>(); float* posf = (float*)(ws + WS_POSF);
        for (int i = gt; i < T; i += NGT) posf[i] = (float)positions[i];
        const float* b_in = inp<I_BIN>(); float* binp = (float*)(ws + WS_BINP);
        for (int i = gt; i < INW; i += NGT) { const int pn = i >> 8, t = i & 255, bj = t >> 7, wc = (t >> 5) & 3, w = t & 31; binp[i] = b_in[256 * pn + 64 * wc + 32 * bj + w]; }
        const float* bgu = inp<I_BGU>(); float* bgup = (float*)(ws + WS_BGU);
        for (int i = gt; i < NE * 2048; i += NGT) { const int e = i >> 11, r = i & 2047, pn = r >> 8, t = r & 255; bgup[i] = bgu[e * 2048 + (t < 128 ? 128 * pn + t : 1024 + 128 * pn + (t - 128))]; }
        const float* bd = inp<I_BD>(); float* bdp = (float*)(ws + WS_BD);
        for (int i = gt; i < NE * 1024; i += NGT) bdp[i] = bd[i];
    }
    int* slot_tok = (int*)(ws + WS_SLOTTOK); int* slot_dest = (int*)(ws + WS_SLOTDEST);
    for (int i = gt; i < NSLOT; i += NGT) { slot_tok[i] = -1; slot_dest[i] = -1; }
    float* outc = (float*)(ws + WS_OUTC); const float* bo = inp<I_BOUT>();
    for (int i = gt; i < D; i += NGT) { outc[i] = ALPHA * lg[i]; outc[1024 + i] = bo[i] + ALPHA * lb[i]; }
    bf16_t* wsp = (bf16_t*)(ws + WS_WSP); const float* w_s = inp<I_WS>();
    for (int i = gt; i < 8 * 128 * 128; i += NGT) {
        const int j = i & 7, hi = (i >> 3) & 1, ks = (i >> 4) & 7, t = (i >> 7) & 127, h = i >> 14;
        const int s = 16 * ks + 8 * (j >> 2) + 4 * hi + (j & 3);
        const float w = (s <= t) ? w_s[((size_t)h * 128 + t) * 128 + s] : 0.f;
        wsp[i] = (bf16_t)(cvtpk(w, 0.f) & 0xffffu);
    }
}

#define MFMA32(a, b, c) __builtin_amdgcn_mfma_f32_32x32x16_bf16((a), (b), (c), 0, 0, 0)
DI int crow(int r, int hi) { return (r & 3) + 8 * (r >> 2) + 4 * hi; }
DI bf16x8 cat4(s16x4 lo, s16x4 hi) { return __builtin_shufflevector(lo, hi, 0, 1, 2, 3, 4, 5, 6, 7); }
#define ATT_ISSUE_Q(uu, sb) do { const int b_ = (uu) >> 6, n_ = ((uu) >> 1) & 31, kvh_ = (uu) & 1, tok0_ = b_ * SEQ + n_ * 128, hq_ = kvh_ * 4 + g; \
    const bf16_t* qp = Qb + (size_t)(tok0_ + rh * 64 + (sb) * 32 + q) * 512 + hq_ * 64 + hi * 8; \
    _Pragma("unroll") for (int ds = 0; ds < 4; ++ds) qf[sb][ds] = *(const bf16x8*)(qp + ds * 16); } while (0)
#define ATT_ISSUE_KV(uu) do { const int b_ = (uu) >> 6, n_ = ((uu) >> 1) & 31, kvh_ = (uu) & 1, tok0_ = b_ * SEQ + n_ * 128; \
    _Pragma("unroll") for (int rep = 0; rep < 4; ++rep) { const int c = F.tid + 512 * rep, kw = c >> 3, ch = c & 7; \
        int tokk = tok0_ - 128 + kw; if (n_ == 0 && kw < 128) tokk = tok0_ + kw;       \
        kreg[rep] = *(const u32x4*)(Kb + (size_t)tokk * 128 + kvh_ * 64 + ch * 8); vreg[rep] = *(const u32x4*)(Vb + (size_t)tokk * 128 + kvh_ * 64 + ch * 8); } } while (0)
DI void attn_phase(const Frame& F0, LAS unsigned char* lds) {
    const Frame F = opaque(F0);
    unsigned char* ws = wsp();
    const bf16_t* Qb = (const bf16_t*)(ws + WS_QB); const bf16_t* Kb = (const bf16_t*)(ws + WS_KB); const bf16_t* Vb = (const bf16_t*)(ws + WS_VB);
    bf16_t* Ob = (bf16_t*)(ws + WS_H0B);
    LAS unsigned char* Kl = lds;
    LAS unsigned char* Vt = lds + 36864;
    const int g = F.wave >> 1, rh = F.wave & 1;
    const float* sinks = inp<I_SINKS>();
    u32x4 kreg[4], vreg[4]; bf16x8 qf[2][4];
    constexpr int NU = NBATCH * 32 * 2;
    if (F.bid < NU) { const int q = F.lane & 31, hi = F.lane >> 5; ATT_ISSUE_KV(F.bid); ATT_ISSUE_Q(F.bid, 0); ATT_ISSUE_Q(F.bid, 1); }
#pragma unroll 1
    for (int u = F.bid; u < NU; u += G) {
        const int b = u >> 6, n = (u >> 1) & 31, kvh = u & 1, tok0 = b * SEQ + n * 128, hq = kvh * 4 + g;
        int tid2 = F.tid; asm volatile("" : "+v"(tid2));
        const int q = tid2 & 31, hi = (tid2 >> 5) & 1;
#pragma unroll
        for (int rep = 0; rep < 4; ++rep) {
            const int c = tid2 + 512 * rep, kw = c >> 3, ch = c & 7;
            *(LAS u32x4*)(Kl + kw * 144 + ch * 16) = kreg[rep];
            const unsigned wv[4] = {vreg[rep].x, vreg[rep].y, vreg[rep].z, vreg[rep].w};
#pragma unroll
            for (int e = 0; e < 8; ++e) { const int d = ch * 8 + e; const unsigned short val = (unsigned short)((e & 1) ? (wv[e >> 1] >> 16) : (wv[e >> 1] & 0xffffu));
                *(LAS unsigned short*)(Vt + d * 512 + ((((kw >> 2) ^ (d & 31))) << 3) + (kw & 3) * 2) = val; }
        }
        __syncthreads();
        if (u + G < NU) ATT_ISSUE_KV(u + G);
        const float sink2 = sinks[hq] * LOG2E;
#pragma unroll
        for (int sb = 0; sb < 2; ++sb) {
            const int r0 = rh * 64 + sb * 32, kb0 = r0 >> 5;
            f32x16 p[5];
#pragma unroll
            for (int kbi = 0; kbi < 5; ++kbi) {
                f32x16 a = {};
#pragma unroll
                for (int ds = 0; ds < 4; ++ds) { const bf16x8 kf = *(const LAS bf16x8*)(Kl + ((kb0 + kbi) * 32 + q) * 144 + (ds * 16 + hi * 8) * 2); a = MFMA32(kf, qf[sb][ds], a); }
                p[kbi] = a;
            }
            if (u + G < NU) ATT_ISSUE_Q(u + G, sb);
            float mx = sink2;
#pragma unroll
            for (int kbi = 0; kbi < 5; ++kbi) {
                const bool blk_ok = (n > 0) || (kb0 + kbi >= 4);
#pragma unroll
                for (int r = 0; r < 16; ++r) { const int c = crow(r, hi); const bool ok = blk_ok && (kbi == 0 ? c > q : kbi == 4 ? c <= q : true);
                    const float s = ok ? p[kbi][r] : -1e30f; p[kbi][r] = s; mx = fmaxf(mx, s); }
            }
            mx = fmaxf(mx, partnerf<5>(mx, F.lane));
            float l = 0.f;
#pragma unroll
            for (int kbi = 0; kbi < 5; ++kbi)
#pragma unroll
                for (int r = 0; r < 16; ++r) { const float e = __builtin_amdgcn_exp2f(p[kbi][r] - mx); p[kbi][r] = e; l += e; }
            l += partnerf<5>(l, F.lane); l += __builtin_amdgcn_exp2f(sink2 - mx);
            f32x16 o0 = {}, o1 = {};
#pragma unroll
            for (int kbi = 0; kbi < 5; ++kbi)
#pragma unroll
                for (int s2 = 0; s2 < 2; ++s2) {
                    u32x4 pw; pw.x = cvtpk(p[kbi][8 * s2 + 0], p[kbi][8 * s2 + 1]); pw.y = cvtpk(p[kbi][8 * s2 + 2], p[kbi][8 * s2 + 3]);
                    pw.z = cvtpk(p[kbi][8 * s2 + 4], p[kbi][8 * s2 + 5]); pw.w = cvtpk(p[kbi][8 * s2 + 6], p[kbi][8 * s2 + 7]);
                    const bf16x8 pa = __builtin_bit_cast(bf16x8, pw);
                    const int kc = ((kb0 + kbi) * 32 + 16 * s2 + 4 * hi) >> 2;
                    { const int d = q; const s16x4 lo = *(const LAS s16x4*)(Vt + d * 512 + ((kc ^ (d & 31)) << 3)), hh = *(const LAS s16x4*)(Vt + d * 512 + (((kc + 2) ^ (d & 31)) << 3)); o0 = MFMA32(cat4(lo, hh), pa, o0); }
                    { const int d = 32 + q; const s16x4 lo = *(const LAS s16x4*)(Vt + d * 512 + ((kc ^ (d & 31)) << 3)), hh = *(const LAS s16x4*)(Vt + d * 512 + (((kc + 2) ^ (d & 31)) << 3)); o1 = MFMA32(cat4(lo, hh), pa, o1); }
                }
            const float rl = __builtin_amdgcn_rcpf(l);
            bf16_t* op = Ob + (size_t)(tok0 + r0 + q) * D + hq * 64 + 4 * hi;
#pragma unroll
            for (int g4 = 0; g4 < 4; ++g4) {
                u32x2 w0, w1; w0.x = cvtpk(o0[4 * g4] * rl, o0[4 * g4 + 1] * rl); w0.y = cvtpk(o0[4 * g4 + 2] * rl, o0[4 * g4 + 3] * rl);
                w1.x = cvtpk(o1[4 * g4] * rl, o1[4 * g4 + 1] * rl); w1.y = cvtpk(o1[4 * g4 + 2] * rl, o1[4 * g4 + 3] * rl);
                *(u32x2*)(op + 8 * g4) = w0; *(u32x2*)(op + 32 + 8 * g4) = w1;
            }
        }
        __syncthreads();
    }
}
#undef ATT_ISSUE_Q
#undef ATT_ISSUE_KV
template <int TB> DI void gmlp_tb(const bf16_t* GUb, const bf16_t* wsp, bf16_t* Ob, const float* b_s, LAS unsigned char* Vt, int h, int tok0, int q, int hi) {
    constexpr int NKS = 2 * TB + 2;
    const int t = TB * 32 + q;
    const bf16_t* gp = GUb + (size_t)(tok0 + t) * 512 + h * 64 + 4 * hi;
    const bf16_t* wp = wsp + ((size_t)(h * 128 + t) * 8) * 16 + hi * 8;
    bf16x8 wa[NKS];
#pragma unroll
    for (int ks = 0; ks < NKS; ++ks) wa[ks] = *(const bf16x8*)(wp + ks * 16);
    u32x2 gu0[4], gu1[4];
#pragma unroll
    for (int g4 = 0; g4 < 4; ++g4) { gu0[g4] = *(const u32x2*)(gp + 8 * g4); gu1[g4] = *(const u32x2*)(gp + 32 + 8 * g4); }
    const float bias = b_s[h * 128 + t];
    f32x16 a0 = {}, a1 = {};
#pragma unroll
    for (int ks = 0; ks < NKS; ++ks) {
        const int kc = (16 * ks + 4 * hi) >> 2;
        { const int d = q; const s16x4 lo = *(const LAS s16x4*)(Vt + d * 256 + ((kc ^ (d & 31)) << 3)), hh = *(const LAS s16x4*)(Vt + d * 256 + (((kc + 2) ^ (d & 31)) << 3)); a0 = MFMA32(cat4(lo, hh), wa[ks], a0); }
        { const int d = 32 + q; const s16x4 lo = *(const LAS s16x4*)(Vt + d * 256 + ((kc ^ (d & 31)) << 3)), hh = *(const LAS s16x4*)(Vt + d * 256 + (((kc + 2) ^ (d & 31)) << 3)); a1 = MFMA32(cat4(lo, hh), wa[ks], a1); }
    }
    bf16_t* op = Ob + (size_t)(tok0 + t) * D + 512 + h * 64 + 4 * hi;
#pragma unroll
    for (int g4 = 0; g4 < 4; ++g4) {
        u32x2 w0, w1;
        w0.x = cvtpk(bflo(gu0[g4].x) * (a0[4 * g4] + bias), bfhi(gu0[g4].x) * (a0[4 * g4 + 1] + bias)); w0.y = cvtpk(bflo(gu0[g4].y) * (a0[4 * g4 + 2] + bias), bfhi(gu0[g4].y) * (a0[4 * g4 + 3] + bias));
        w1.x = cvtpk(bflo(gu1[g4].x) * (a1[4 * g4] + bias), bfhi(gu1[g4].x) * (a1[4 * g4 + 1] + bias)); w1.y = cvtpk(bflo(gu1[g4].y) * (a1[4 * g4 + 2] + bias), bfhi(gu1[g4].y) * (a1[4 * g4 + 3] + bias));
        *(u32x2*)(op + 8 * g4) = w0; *(u32x2*)(op + 32 + 8 * g4) = w1;
    }
}
DI void gmlp_phase(const Frame& F0, LAS unsigned char* lds) {
    const Frame F = opaque(F0);
    unsigned char* ws = wsp();
    const int h = F.wave;
    const bf16_t* GUb = (const bf16_t*)(ws + WS_GUB); const bf16_t* GVb = (const bf16_t*)(ws + WS_GVB); const bf16_t* wsp = (const bf16_t*)(ws + WS_WSP);
    bf16_t* Ob = (bf16_t*)(ws + WS_H0B);
    const float* b_s = inp<I_BS>();
    LAS unsigned char* Vt = lds + F.wave * 16384;
    const int q = F.lane & 31, hi = F.lane >> 5;
    u32x4 gv[16];
#pragma unroll
    for (int rep = 0; rep < 16; ++rep) { const int c = F.lane + 64 * rep, s = c >> 3, ch = c & 7; gv[rep] = *(const u32x4*)(GVb + (size_t)(F.bid * 128 + s) * 512 + h * 64 + ch * 8); }
#pragma unroll 1
    for (int chunk = F.bid; chunk < T / 128; chunk += G) {
        const int tok0 = chunk * 128;
        int ln = F.lane; asm volatile("" : "+v"(ln));
#pragma unroll
        for (int rep = 0; rep < 16; ++rep) {
            const int c = ln + 64 * rep, s = c >> 3, ch = c & 7;
            const unsigned wv[4] = {gv[rep].x, gv[rep].y, gv[rep].z, gv[rep].w};
#pragma unroll
            for (int e = 0; e < 8; ++e) { const int d = ch * 8 + e; const unsigned short val = (unsigned short)((e & 1) ? (wv[e >> 1] >> 16) : (wv[e >> 1] & 0xffffu));
                *(LAS unsigned short*)(Vt + d * 256 + (((s >> 2) ^ (d & 31)) << 3) + (s & 3) * 2) = val; }
        }
        if (chunk + G < T / 128) {
#pragma unroll
            for (int rep = 0; rep < 16; ++rep) { const int c = F.lane + 64 * rep, s = c >> 3, ch = c & 7; gv[rep] = *(const u32x4*)(GVb + (size_t)((chunk + G) * 128 + s) * 512 + h * 64 + ch * 8); }
        }
        LDS_WAIT();
        gmlp_tb<0>(GUb, wsp, Ob, b_s, Vt, h, tok0, q, hi);
        gmlp_tb<1>(GUb, wsp, Ob, b_s, Vt, h, tok0, q, hi);
        gmlp_tb<2>(GUb, wsp, Ob, b_s, Vt, h, tok0, q, hi);
        gmlp_tb<3>(GUb, wsp, Ob, b_s, Vt, h, tok0, q, hi);
        LDS_WAIT();
    }
}

DI void p4_router(const Frame& F0, LAS unsigned char* lds) {
    const Frame F = opaque(F0);
    unsigned char* ws = wsp(); float* out = outp();
    LAS unsigned char* Whi = lds;
    LAS unsigned char* Wlo = lds + 65536;
    LAS int* cnt = (LAS int*)(lds + MISC_OFF + 256);
    { const float* w_router = inp<I_WR>();
      for (int i = F.tid; i < D * NE; i += NTHREADS) { const int c = i >> 5, e = i & 31; const float w = w_router[i];
          const unsigned h = cvtpk(w, 0.f) & 0xffffu; const unsigned l = cvtpk(w - __uint_as_float(h << 16), 0.f) & 0xffffu;
          const int off = e * 2048 + (((c >> 3) ^ (e & 15)) << 4) + (c & 7) * 2;
          *(LAS unsigned short*)(Whi + off) = (unsigned short)h; *(LAS unsigned short*)(Wlo + off) = (unsigned short)l; } }
    if (F.tid < 32) cnt[F.tid] = 0;
    __syncthreads();
    constexpr int R = T / G, rpw = R / NWAVES;
    static_assert(rpw == 32, "one 32-token MFMA block per wave");
    int* tok_e = (int*)(ws + WS_TOKE); float* tok_g = (float*)(ws + WS_TOKG); int* tok_l = (int*)(ws + WS_TOKL);
    const int lane = F.lane;
    const int tokb = F.bid * R + F.wave * rpw;
    {
        f32x4 g1[4], b1[4];
#pragma unroll
        for (int j = 0; j < 4; ++j) { g1[j] = ((const f32x4*)inp<I_LN1G>())[lane + 64 * j]; b1[j] = ((const f32x4*)inp<I_LN1B>())[lane + 64 * j]; }
        f32x4 pf[4][4];
#pragma unroll
        for (int u = 0; u < 4; ++u)
#pragma unroll
            for (int j = 0; j < 4; ++j) pf[u][j] = ((const GAS f32x4*)(out + (size_t)(tokb + u) * D))[lane + 64 * j];
#pragma unroll 1
        for (int i = 0; i < rpw; i += 4) {
#pragma unroll
            for (int u = 0; u < 4; ++u) {
                const int tok = tokb + i + u;
                f32x4 v[4];
#pragma unroll
                for (int j = 0; j < 4; ++j) v[j] = pf[u][j];
                { const int tn = (i + u + 4 < rpw) ? tok + 4 : tok;
#pragma unroll
                  for (int j = 0; j < 4; ++j) pf[u][j] = ((const GAS f32x4*)(out + (size_t)tn * D))[lane + 64 * j]; }
                float s = 0.f;
#pragma unroll
                for (int j = 0; j < 4; ++j) s += (v[j].x + v[j].y) + (v[j].z + v[j].w);
                const float mean = wave_sum(s) * (1.f / D); float s2 = 0.f;
#pragma unroll
                for (int j = 0; j < 4; ++j) { v[j] = v[j] - mean; s2 += (v[j].x * v[j].x + v[j].y * v[j].y) + (v[j].z * v[j].z + v[j].w * v[j].w); }
                const float rstd = 1.f / sqrtf(wave_sum(s2) * (1.f / D) + LN_EPS);
                float* rowp = out + (size_t)tok * D;
                GAS u32x2* hp = (GAS u32x2*)rowp + lane; GAS u32x2* lp = (GAS u32x2*)(rowp + 512) + lane;
#pragma unroll
                for (int j = 0; j < 4; ++j) {
                    v[j] = v[j] * rstd * g1[j] + b1[j];
                    u32x2 wh; wh.x = cvtpk(v[j].x, v[j].y); wh.y = cvtpk(v[j].z, v[j].w);
                    u32x2 wl; wl.x = cvtpk(v[j].x - bflo(wh.x), v[j].y - bfhi(wh.x)); wl.y = cvtpk(v[j].z - bflo(wh.y), v[j].w - bfhi(wh.y));
                    hp[64 * j] = wh; lp[64 * j] = wl;
                    ((GAS unsigned*)(ws + WS_H1Q + (size_t)tok * 1024))[lane + 64 * j] = cvt4_fp8(v[j].x, v[j].y, v[j].z, v[j].w);
                }
            }
        }
    }
    VM_WAIT();
    __builtin_amdgcn_fence(__ATOMIC_ACQUIRE, "agent");
    VM_WAIT();
    const int q = lane & 31, hi = lane >> 5;
    f32x16 acc = {};
    {
        const unsigned char* hrow = (const unsigned char*)(out + (size_t)(tokb + q) * D) + hi * 16;
        const int wbase = q * 2048;
#pragma unroll 4
        for (int s = 0; s < 64; ++s) {
            const bf16x8 bh = *(const GAS bf16x8*)(hrow + 32 * s), bl = *(const GAS bf16x8*)(hrow + 2048 + 32 * s);
            const int off = wbase + (((2 * s + hi) ^ (q & 15)) << 4);
            const bf16x8 wh = *(const LAS bf16x8*)(Whi + off), wl = *(const LAS bf16x8*)(Wlo + off);
            acc = MFMA32(wh, bh, acc); acc = MFMA32(wl, bh, acc); acc = MFMA32(wh, bl, acc);
        }
    }
    const float* b_router = inp<I_BR>();
    float lg[16];
#pragma unroll
    for (int r = 0; r < 16; ++r) lg[r] = acc[r] + b_router[crow(r, hi)];
    float ov[4]; int oi[4];
#pragma unroll
    for (int k = 0; k < 4; ++k) {
        float best = -INFINITY; int bi = 64;
#pragma unroll
        for (int r = 0; r < 16; ++r) { const bool gt = lg[r] > best; best = gt ? lg[r] : best; bi = gt ? crow(r, hi) : bi; }
#pragma unroll
        for (int r = 0; r < 16; ++r) lg[r] = (crow(r, hi) == bi) ? -INFINITY : lg[r];
        ov[k] = best; oi[k] = bi;
    }
    float cv[8]; int ci[8];
#pragma unroll
    for (int k = 0; k < 4; ++k) { cv[k] = ov[k]; ci[k] = oi[k]; cv[4 + k] = partnerf<5>(ov[k], lane); ci[4 + k] = partneri<5>(oi[k], lane); }
    float tv[4]; int ti[4];
#pragma unroll
    for (int k = 0; k < 4; ++k) {
        float best = -INFINITY; int bi = 64;
#pragma unroll
        for (int c = 0; c < 8; ++c) { const bool gt = cv[c] > best || (cv[c] == best && ci[c] < bi); best = gt ? cv[c] : best; bi = gt ? ci[c] : bi; }
#pragma unroll
        for (int c = 0; c < 8; ++c) cv[c] = (ci[c] == bi) ? -INFINITY : cv[c];
        tv[k] = best; ti[k] = bi;
    }
    if (hi == 0) {
        const float e1 = __expf(tv[1] - tv[0]), e2 = __expf(tv[2] - tv[0]), e3 = __expf(tv[3] - tv[0]);
        const float inv = 1.0f / (1.0f + e1 + e2 + e3);
        const int tok = tokb + q;
        int lp4[4];
#pragma unroll
        for (int k = 0; k < 4; ++k) lp4[k] = atomicAdd((int*)(cnt + ti[k]), 1);
        *(int4*)(tok_e + tok * 4) = make_int4(ti[0], ti[1], ti[2], ti[3]);
        *(float4*)(tok_g + tok * 4) = make_float4(inv, e1 * inv, e2 * inv, e3 * inv);
        *(int4*)(tok_l + tok * 4) = make_int4(lp4[0], lp4[1], lp4[2], lp4[3]);
    }
    __syncthreads();
    if (F.tid < 32) ((int*)(ws + WS_WGCOUNT))[F.bid * 32 + F.tid] = cnt[F.tid];
}
DI int p4b_lists(const Frame& F0, LAS unsigned char* lds) {
    const Frame F = opaque(F0);
    unsigned char* ws = wsp();
    LAS int* tab = (LAS int*)lds;
    LAS int* pstart = (LAS int*)(lds + MISC_OFF + 256);
    LAS int* mybase = pstart + 64;
    const int* wgc = (const int*)(ws + WS_WGCOUNT);
    for (int i = F.tid; i < G * 32; i += NTHREADS) tab[i] = (int)__hip_atomic_load((unsigned*)wgc + i, __ATOMIC_RELAXED, __HIP_MEMORY_SCOPE_AGENT);
    __syncthreads();
    if (F.tid < 32) { int tot = 0, mb = 0; for (int w = 0; w < G; ++w) { const int c = tab[w * 32 + F.tid]; if (w < F.bid) mb += c; tot += c; } mybase[F.tid] = mb; pstart[32 + 32 + 32 + F.tid] = tot; }
    __syncthreads();
    if (F.tid == 0) { int off = 0; for (int e = 0; e < 32; ++e) { pstart[e] = off; off += ((pstart[96 + e] + 255) >> 8) << 8; } pstart[32] = off; }
    __syncthreads();
    const int ngroups = pstart[32] >> 8;
    if (F.bid == 0) {
        int* grp_e = (int*)(ws + WS_GRPE);
        for (int g = F.tid; g < NGRP_MAX; g += NTHREADS) { int e = 0; for (int k = 1; k < 32; ++k) if (pstart[k] <= g * 256) e = k; grp_e[g] = (g < ngroups) ? e : 0; }
    }
    const int R = T / G;
    const int* tok_e = (const int*)(ws + WS_TOKE); const float* tok_g = (const float*)(ws + WS_TOKG); const int* tok_l = (const int*)(ws + WS_TOKL);
    int* slot_tok = (int*)(ws + WS_SLOTTOK); float* slot_gate = (float*)(ws + WS_SLOTGATE); int* slot_dest = (int*)(ws + WS_SLOTDEST);
    for (int i = F.tid; i < R * 4; i += NTHREADS) {
        const int idx = F.bid * R * 4 + i; const int e = tok_e[idx];
        const int slot = pstart[e] + mybase[e] + tok_l[idx];
        slot_tok[slot] = idx >> 2; slot_gate[slot] = tok_g[idx]; slot_dest[slot] = idx;
    }
    return ngroups;
}
DI void p7_final(const Frame& F0) {
    const Frame F = opaque(F0);
    unsigned char* ws = wsp(); float* out = outp();
    const bf16_t* yslot = (const bf16_t*)(ws + WS_YSLOT);
    const int gw = F.bid * NWAVES + F.wave, NGW = G * NWAVES, lane = F.lane;
    const float* ln2_g = inp<I_LN2G>(); const float* ln2_b = inp<I_LN2B>();
    for (int tok = gw; tok < T; tok += NGW) {
        float* rowp = out + (size_t)tok * D;
        f32x4 v[4];
#pragma unroll
        for (int j = 0; j < 4; ++j) {
            const u32x2 wh = ((const GAS u32x2*)rowp)[lane + 64 * j];
            v[j] = (f32x4){bflo(wh.x), bfhi(wh.x), bflo(wh.y), bfhi(wh.y)} * ALPHA;
        }
#pragma unroll
        for (int k = 0; k < 4; ++k) {
            const GAS u32x2* yp = (const GAS u32x2*)(yslot + ((size_t)tok * 4 + k) * 1024) + lane;
#pragma unroll
            for (int j = 0; j < 4; ++j) { const u32x2 w = yp[64 * j]; v[j] = v[j] + (f32x4){bflo(w.x), bfhi(w.x), bflo(w.y), bfhi(w.y)}; }
        }
        float s = 0.f;
#pragma unroll
        for (int j = 0; j < 4; ++j) s += (v[j].x + v[j].y) + (v[j].z + v[j].w);
        const float mean = wave_sum(s) * (1.f / D); float s2 = 0.f;
#pragma unroll
        for (int j = 0; j < 4; ++j) { v[j] = v[j] - mean; s2 += (v[j].x * v[j].x + v[j].y * v[j].y) + (v[j].z * v[j].z + v[j].w * v[j].w); }
        const float rstd = 1.f / sqrtf(wave_sum(s2) * (1.f / D) + LN_EPS);
#pragma unroll
        for (int j = 0; j < 4; ++j) { const f32x4 gg = ((const f32x4*)ln2_g)[lane + 64 * j], bb = ((const f32x4*)ln2_b)[lane + 64 * j];
            ((GAS f32x4*)rowp)[lane + 64 * j] = v[j] * rstd * gg + bb; }
    }
}

struct CfgIn   { static constexpr bool FP8 = false, GATHER = false; static constexpr size_t A_OFF = WS_H0B,  B_OFF = WS_WIN,  B_E_BYTES = 0; static constexpr unsigned A_PITCH = 0; };
struct CfgOut  { static constexpr bool FP8 = false, GATHER = false; static constexpr size_t A_OFF = WS_H0B,  B_OFF = WS_WOUT, B_E_BYTES = 0; static constexpr unsigned A_PITCH = 0; };
struct CfgGU   { static constexpr bool FP8 = true,  GATHER = true;  static constexpr size_t A_OFF = WS_H1Q,  B_OFF = WS_WGU,  B_E_BYTES = (size_t)2048 * D; static constexpr unsigned A_PITCH = 1024u; };
struct CfgDown { static constexpr bool FP8 = true,  GATHER = false; static constexpr size_t A_OFF = WS_HMID, B_OFF = WS_WD,   B_E_BYTES = (size_t)D * D; static constexpr unsigned A_PITCH = 0; };
#ifndef PHASE_MASK
#define PHASE_MASK 0xFFFF
#endif
struct Args { const void* in[23]; float* out; unsigned char* ws; };
__global__ void __launch_bounds__(NTHREADS, 2) mk_fwd(Args args) {
    __shared__ __attribute__((aligned(16))) unsigned char lds_raw[LDS_BYTES];
    LAS unsigned char* lds = (LAS unsigned char*)lds_raw;
    Frame F;
    F.tid = threadIdx.x; F.lane = F.tid & 63; F.wave = __builtin_amdgcn_readfirstlane(F.tid >> 6); F.bid = blockIdx.x;
    volatile LAS unsigned* MISC = (volatile LAS unsigned*)(lds + MISC_OFF);
    if (F.tid < 64) MISC[F.tid] = 0u;
    __syncthreads();
    xcd_barrier_post((unsigned*)(wsp() + WS_CTL) + CW_BAR);
    volatile LAS unsigned* bst = MISC + 8;
#ifdef PROBE_A
    int n_stamp = 0;
#define STAMP() do { if (F.bid == 0 && F.tid == 0) { __hip_atomic_store((unsigned long long*)(wsp() + WS_CTL + 32768) + n_stamp, (unsigned long long)__builtin_amdgcn_s_memrealtime(), __ATOMIC_RELAXED, __HIP_MEMORY_SCOPE_AGENT); } ++n_stamp; } while (0)
#else
#define STAMP() do {} while (0)
#endif
    STAMP();
    LAS unsigned char* tokbuf = lds + TOKBUF_OFF;

    if (PHASE_MASK & 1) p0_prologue(F, lds);
    xcd_barrier(bst); STAMP();
    if (PHASE_MASK & 2) { pg8::StaticOrder<T, INW> S{F.bid}; EpiInProj E; pg8::gemm_phase<CfgIn>(lds, tokbuf, 0, S, E); }
    xcd_barrier(bst); STAMP();
    if (PHASE_MASK & 4) attn_phase(F, lds);
    if (PHASE_MASK & 8) gmlp_phase(F, lds);
    xcd_barrier(bst); STAMP();
    if (PHASE_MASK & 16) { pg8::StaticOrder<T, D> S{F.bid}; EpiOut E; pg8::gemm_phase<CfgOut>(lds, tokbuf, 0, S, E); }
    xcd_barrier(bst); STAMP();
    if (PHASE_MASK & 32) p4_router(F, lds);
    xcd_barrier(bst); STAMP();
    int ngroups = 1040; if (PHASE_MASK & 64) ngroups = p4b_lists(F, lds);
    xcd_barrier(bst); STAMP();
    if (PHASE_MASK & 128) { pg8::GroupOrder<8> S{0, ngroups, F.bid}; EpiGateUp E; pg8::gemm_phase<CfgGU>(lds, tokbuf, 0, S, E); }
    xcd_barrier(bst); STAMP();
    if (PHASE_MASK & 256) { pg8::GroupOrder<4> S{0, ngroups, F.bid}; EpiDown E; pg8::gemm_phase<CfgDown>(lds, tokbuf, 0, S, E); }
    xcd_barrier(bst); STAMP();
    if (PHASE_MASK & 512) p7_final(F);
#ifdef PROBE_A
    STAMP();
    if (F.bid == 0 && F.tid == 0) {
        unsigned long long* ts = (unsigned long long*)(wsp() + WS_CTL + 32768);
        unsigned long long extra = 0ull;
        for (int k = 1; k < 12; ++k) if ((PROBE_A >> k) & 1) extra += __hip_atomic_load(ts + k, __ATOMIC_RELAXED, __HIP_MEMORY_SCOPE_AGENT) - __hip_atomic_load(ts + k - 1, __ATOMIC_RELAXED, __HIP_MEMORY_SCOPE_AGENT);
        if (PROBE_A & 0x8000) extra = 50000ull;
        const unsigned long long t0 = __builtin_amdgcn_s_memrealtime();
        while (__builtin_amdgcn_s_memrealtime() - t0 < extra) __builtin_amdgcn_s_sleep(8);
    }
#endif
}

extern "C" void kernel_launch(void* const* d_in, const int* in_sizes, int n_in, void* d_out, int out_size, void* d_ws, size_t ws_size, hipStream_t stream) {
    static int grid = 0;
    if (grid == 0) {
        if (n_in != 23 || in_sizes[0] != T * D || out_size != T * D || ws_size < WS_END) {
            fprintf(stderr, "kernel_launch: unexpected shapes/workspace (n_in %d, in0 %d, out %d, ws %zu, need %zu); nothing launched\n", n_in, n_in > 0 ? in_sizes[0] : -1, out_size, ws_size, (size_t)WS_END);
            grid = -1; return;
        }
        int dev = 0, cus = 0, per_cu = 0;
        if (hipGetDevice(&dev) != hipSuccess || hipDeviceGetAttribute(&cus, hipDeviceAttributeMultiprocessorCount, dev) != hipSuccess) { grid = -1; return; }
        if (hipOccupancyMaxActiveBlocksPerMultiprocessor(&per_cu, (const void*)mk_fwd, NTHREADS, 0) != hipSuccess || per_cu < 1) {
            fprintf(stderr, "kernel_launch: occupancy query says %d blocks per CU; nothing launched\n", per_cu); (void)hipGetLastError(); grid = -1; return;
        }
        grid = cus;
        if (grid != G) { fprintf(stderr, "kernel_launch: built for a 256-CU device, found %d; nothing launched\n", cus); grid = -1; return; }
    }
    if (grid < 0) return;
    if (hipMemsetAsync((char*)d_ws + WS_CTL, 0, CTL_ZERO_BYTES, stream) != hipSuccess) return;
    Args a{};
    for (int i = 0; i < 23; ++i) a.in[i] = d_in[i];
    a.out = (float*)d_out; a.ws = (unsigned char*)d_ws;
    hipLaunchKernelGGL(mk_fwd, dim3(grid), dim3(NTHREADS), 0, stream, a);
}
```

```cpp
#include <hip/hip_runtime.h>
#include <cstdio>
#include <cstdint>
#include <type_traits>

#define DI __device__ __forceinline__
#define LAS __attribute__((address_space(3)))
#define GAS __attribute__((address_space(1)))
typedef unsigned short bf16_t;
typedef short bf16x8 __attribute__((ext_vector_type(8)));
typedef short s16x4 __attribute__((ext_vector_type(4)));
typedef float f32x2 __attribute__((ext_vector_type(2)));
typedef float f32x4 __attribute__((ext_vector_type(4)));
typedef float f32x16 __attribute__((ext_vector_type(16)));
typedef unsigned u32x2 __attribute__((ext_vector_type(2)));
typedef unsigned u32x4 __attribute__((ext_vector_type(4)));
typedef __bf16 bf16x2_t __attribute__((ext_vector_type(2)));
typedef GAS unsigned gu32;
typedef int v8i __attribute__((ext_vector_type(8)));

constexpr int D = 1024, SEQ = 4096, NBATCH = 16, T = NBATCH * SEQ;
constexpr int INW = 1792, NE = 32;
constexpr int NSLOT = T * 4 + NE * 256;
constexpr int NGRP_MAX = NSLOT / 256;
constexpr float LN_EPS = 1e-5f;
constexpr float ALPHA = 1.189207115002721f;
constexpr float LOG2E = 1.4426950408889634f;
constexpr float QSCALE = 0.125f * LOG2E;
constexpr float WQ_SCALE = 64.0f;
constexpr int WQ_E8M0 = 127 - 6;
constexpr int NWAVES = 8, NTHREADS = 512;

constexpr size_t MiB = 1u << 20;
constexpr size_t WS_CTL = 0, CTL_ZERO_BYTES = 65536;
constexpr size_t WS_WGCOUNT = 1 * MiB;
constexpr size_t WS_GRPE = 1 * MiB + 65536;
constexpr size_t WS_OUTC = 1 * MiB + 131072;
constexpr size_t WS_WIN = 2 * MiB;
constexpr size_t WS_WOUT = 6 * MiB;
constexpr size_t WS_WSP = 8 * MiB;
constexpr size_t WS_STATS0 = 9 * MiB;
constexpr size_t WS_BINP = 10 * MiB;
constexpr size_t WS_POSF = 10 * MiB + 65536;
constexpr size_t WS_BGU = 11 * MiB;
constexpr size_t WS_BD = 12 * MiB;
constexpr size_t WS_WGU = 16 * MiB;
constexpr size_t WS_WD = 80 * MiB;
constexpr size_t WS_H1Q = 112 * MiB;
constexpr size_t WS_TOKE = 208 * MiB;
constexpr size_t WS_TOKG = 209 * MiB;
constexpr size_t WS_TOKL = 210 * MiB;
constexpr size_t WS_SLOTTOK = 211 * MiB;
constexpr size_t WS_SLOTGATE = 212 * MiB + 512 * 1024;
constexpr size_t WS_SLOTDEST = 214 * MiB;
constexpr size_t WS_H0B = 216 * MiB;
constexpr size_t WS_QB = 344 * MiB;
constexpr size_t WS_KB = 408 * MiB;
constexpr size_t WS_VB = 424 * MiB;
constexpr size_t WS_GUB = 440 * MiB;
constexpr size_t WS_GVB = 504 * MiB;
constexpr size_t WS_YSLOT = 216 * MiB;
constexpr size_t WS_HMID = 728 * MiB;
constexpr size_t WS_END = 1024 * MiB;
static_assert(WS_HMID + (size_t)NSLOT * 1024 <= WS_END && WS_H1Q + (size_t)T * 1024 <= 208 * MiB, "ws map");
static_assert(WS_YSLOT + (size_t)T * 4 * 1024 * 2 <= WS_HMID, "ws map");
constexpr int CW_BAR = 4096;

constexpr int RING_BYTES = 131072;
constexpr int MISC_OFF = RING_BYTES;
constexpr int TOKBUF_OFF = MISC_OFF + 1024;
constexpr int EPIBUF_OFF = MISC_OFF + 4096, EPIBUF_SZ = 4096;
constexpr int LDS_BYTES = 147456;

DI unsigned cvtpk(float lo, float hi) { f32x2 v = {lo, hi}; bf16x2_t b = __builtin_convertvector(v, bf16x2_t); return __builtin_bit_cast(unsigned, b); }
DI unsigned cvt4_fp8(float a, float b, float c, float d) { int p = __builtin_amdgcn_cvt_pk_fp8_f32(a, b, 0, false); p = __builtin_amdgcn_cvt_pk_fp8_f32(c, d, p, true); return (unsigned)p; }
DI float bf2f(unsigned short h) { return __uint_as_float((unsigned)h << 16); }
DI float bflo(unsigned w) { return __uint_as_float(w << 16); }
DI float bfhi(unsigned w) { return __uint_as_float(w & 0xffff0000u); }
template <int CTRL> DI float dppf(float v) { return __builtin_bit_cast(float, __builtin_amdgcn_update_dpp(0, __builtin_bit_cast(int, v), CTRL, 0xf, 0xf, false)); }
DI void swap32(float& a, float& b) { asm("s_nop 1\n\tv_permlane32_swap_b32 %0, %1" : "+v"(a), "+v"(b)); }
DI void swap16(float& a, float& b) { asm("s_nop 1\n\tv_permlane16_swap_b32 %0, %1" : "+v"(a), "+v"(b)); }
template <int CTRL> DI int dppi(int v) { return __builtin_amdgcn_update_dpp(0, v, CTRL, 0xf, 0xf, false); }
constexpr int DPP_XOR1 = 0xB1, DPP_XOR2 = 0x4E, DPP_HMIRROR = 0x141, DPP_MIRROR = 0x140;
template <int LV> DI float partnerf(float v, int lane) {
    if constexpr (LV == 0) return dppf<DPP_XOR1>(v);
    else if constexpr (LV == 1) return dppf<DPP_XOR2>(v);
    else if constexpr (LV == 2) return dppf<DPP_HMIRROR>(v);
    else if constexpr (LV == 3) return dppf<DPP_MIRROR>(v);
    else if constexpr (LV == 4) { float a = v, b = v; swap16(a, b); return (lane & 16) ? a : b; }
    else { float a = v, b = v; swap32(a, b); return (lane & 32) ? a : b; }
}
template <int LV> DI int partneri(int v, int lane) { return __builtin_bit_cast(int, partnerf<LV>(__builtin_bit_cast(float, v), lane)); }
DI float wave_sum(float v) {
    v += dppf<DPP_XOR1>(v); v += dppf<DPP_XOR2>(v); v += dppf<DPP_HMIRROR>(v); v += dppf<DPP_MIRROR>(v);
    { float a = v, b = v; swap16(a, b); v = a + b; }
    { float a = v, b = v; swap32(a, b); v = a + b; }
    return v;
}
#define LDS_WAIT() asm volatile("s_waitcnt lgkmcnt(0)" ::: "memory")
#define VM_WAIT() asm volatile("s_waitcnt vmcnt(0)" ::: "memory")

DI f32x2 gelu_pk(f32x2 v) {
    const f32x2 av = __builtin_elementwise_abs(v), d = av * 0.2316418882f + 1.0f;
    f32x2 t; t.x = __builtin_amdgcn_rcpf(d.x); t.y = __builtin_amdgcn_rcpf(d.y);
    f32x2 q = t * 0.5307027145f + (-0.7265760135f); q = q * t + 0.7107068705f; q = q * t + (-0.142248368f); q = q * t + 0.127414796f; q = q * t;
    const f32x2 s = (v * v) * (-0.72134752044f);
    f32x2 e; e.x = __builtin_amdgcn_exp2f(s.x); e.y = __builtin_amdgcn_exp2f(s.y);
    const f32x2 m = v * (q * e), r = v - m;
    f32x2 o; o.x = v.x < 0.f ? m.x : r.x; o.y = v.y < 0.f ? m.y : r.y; return o;
}
DI f32x4 gelu4(f32x4 v) { f32x2 a = gelu_pk((f32x2){v[0], v[1]}), b = gelu_pk((f32x2){v[2], v[3]}); return (f32x4){a.x, a.y, b.x, b.y}; }


struct Frame { int tid, lane, wave, bid; };
DI Frame opaque(const Frame& f) { Frame r; r.tid = threadIdx.x; asm volatile("" : "+v"(r.tid)); r.lane = r.tid & 63; r.wave = __builtin_amdgcn_readfirstlane(r.tid >> 6); r.bid = f.bid; return r; }
constexpr int G = 256;
template <int K> DI const float* inp() { const float* p; asm volatile("s_load_dwordx2 %0, %1, %2\n\ts_waitcnt lgkmcnt(0)" : "=s"(p) : "s"(__builtin_amdgcn_kernarg_segment_ptr()), "i"(K * 8)); return p; }
DI float* outp() { float* p; asm volatile("s_load_dwordx2 %0, %1, %2\n\ts_waitcnt lgkmcnt(0)" : "=s"(p) : "s"(__builtin_amdgcn_kernarg_segment_ptr()), "i"(23 * 8)); return p; }
DI unsigned char* wsp() { unsigned char* p; asm volatile("s_load_dwordx2 %0, %1, %2\n\ts_waitcnt lgkmcnt(0)" : "=s"(p) : "s"(__builtin_amdgcn_kernarg_segment_ptr()), "i"(24 * 8)); return p; }
enum { I_X = 0, I_POS = 1, I_LNING = 2, I_LNINB = 3, I_WIN = 4, I_BIN = 5, I_SINKS = 6, I_GNG = 7, I_GNB = 8, I_WS = 9, I_BS = 10, I_WOUT = 11, I_BOUT = 12, I_LN1G = 13, I_LN1B = 14,
       I_WR = 15, I_BR = 16, I_WGU = 17, I_BGU = 18, I_WD = 19, I_BD = 20, I_LN2G = 21, I_LN2B = 22 };

DI void dma16(const __amdgpu_buffer_rsrc_t rs, unsigned lds_addr, unsigned voff, unsigned soff) {
    asm volatile("s_mov_b32 m0, %0\n\ts_nop 0\n\tbuffer_load_dwordx4 %1, %2, %3 offen lds" :: "s"(lds_addr), "v"(voff), "s"(rs), "s"(soff) : "m0", "memory");
}
DI unsigned lds_u32(const LAS unsigned char* p) { return (unsigned)(uintptr_t)p; }
#define XB_TMO      128
#define XB_XCNT(j)  (256  + 64 * (j))
#define XB_XSUB(j)  (1280 + 64 * (j))
#define XB_XGEN(j)  (2304 + 64 * (j))
#define XB_TOP      3328
#define XB_TOPGEN   3392
#define XCD_BAR_WORDS 3456
#define XB_SPIN_CAP (1u << 18)
DI unsigned xb_ld(unsigned* p)              { return __hip_atomic_load(p, __ATOMIC_RELAXED, __HIP_MEMORY_SCOPE_AGENT); }
DI unsigned xb_add(unsigned* p, unsigned v) { return __hip_atomic_fetch_add(p, v, __ATOMIC_RELAXED, __HIP_MEMORY_SCOPE_AGENT); }
DI unsigned xb_xcc_id() { return (unsigned)__builtin_amdgcn_s_getreg((3 << 11) | 20) & 0xFu; }
#define XB_SPIN(cond, bar) do { unsigned _sp = 0; while (cond) { __builtin_amdgcn_s_sleep(1); \
    if ((++_sp & 255u) == 0u) { if (xb_ld(&(bar)[XB_TMO])) break; if (_sp > XB_SPIN_CAP) { atomicAdd(&(bar)[XB_TMO], 1u); break; } } } } while (0)
DI void xcd_barrier_post(unsigned* bar) { if (threadIdx.x == 0) (void)xb_add(&bar[XB_XCNT(xb_xcc_id())], 1u); }
DI void xcd_barrier_complete(unsigned* bar, unsigned x, unsigned& nloc, unsigned& nx) {
    unsigned sum, cnt, mine, sp = 0u;
    for (;;) {
        sum = 0u; cnt = 0u; mine = 0u;
#pragma unroll
        for (unsigned j = 0; j < 16; ++j) { const unsigned c = xb_ld(&bar[XB_XCNT(j)]); sum += c; cnt += (c > 0u) ? 1u : 0u; mine = (j == x) ? c : mine; }
        if (sum == (unsigned)G) break;
        __builtin_amdgcn_s_sleep(1);
        if ((++sp & 255u) == 0u) { if (xb_ld(&bar[XB_TMO])) break; if (sp > XB_SPIN_CAP) { atomicAdd(&bar[XB_TMO], 1u); break; } }
    }
    nloc = mine > 0u ? mine : 1u; nx = cnt > 0u ? cnt : 1u;
}
DI void xcd_barrier(volatile LAS unsigned* st) {
    asm volatile("s_waitcnt vmcnt(0)" ::: "memory");
    __syncthreads();
    if (threadIdx.x == 0) {
        unsigned* bar = (unsigned*)(wsp() + WS_CTL) + CW_BAR; const unsigned x = xb_xcc_id();
        __builtin_amdgcn_s_waitcnt(0);
        unsigned nloc = st[0], nx = st[1];
        if (nloc == 0u) { xcd_barrier_complete(bar, x, nloc, nx); st[0] = nloc; st[1] = nx; }
        const unsigned old = xb_add(&bar[XB_XSUB(x)], 1u);
        const unsigned gen = old / nloc;
        if (old + 1u == (gen + 1u) * nloc) {
            __builtin_amdgcn_fence(__ATOMIC_RELEASE, "agent");
            asm volatile("s_waitcnt vmcnt(0)" ::: "memory");
            const unsigned og = xb_add(&bar[XB_TOP], 1u);
            const unsigned tg = og / nx;
            if (og + 1u == (tg + 1u) * nx) xb_add(&bar[XB_TOPGEN], 1u);
            else XB_SPIN(xb_ld(&bar[XB_TOPGEN]) == tg, bar);
            __builtin_amdgcn_fence(__ATOMIC_ACQUIRE, "agent");
            xb_add(&bar[XB_XGEN(x)], 1u);
            asm volatile("s_waitcnt vmcnt(0)" ::: "memory");
        } else {
            XB_SPIN(xb_ld(&bar[XB_XGEN(x)]) == gen, bar);
            __builtin_amdgcn_fence(__ATOMIC_ACQUIRE, "agent");
            asm volatile("s_waitcnt vmcnt(0)" ::: "memory");
        }
    }
    __syncthreads();
}

namespace pg8 {
constexpr int BM = 256, HALF = 128, HTB = HALF * 128, NXCD = 8, WGM = 8, GK = 1024;
constexpr size_t KSTEP = 128;
DI int lds_byte(int r, int c) { const int st = (r >> 4) * 2 + (c >> 5), rr = r & 15, cc = c & 31, ob = rr * 64 + cc * 2; return st * 1024 + (ob ^ (((ob >> 9) & 1) << 5)); }
DI void stage_rc(int b, int& R, int& C) { const int st = b / 1024, sb = b % 1024, swz = sb ^ (((sb >> 9) & 1) << 5); R = (st >> 1) * 16 + swz / 64; C = (st & 1) * 32 + (swz % 64) / 2; }
DI int lds_byte_f8(int r, int c) { const int st = (r >> 4) * 2 + (c >> 5), rr = r & 15, cc = c & 31, ob = rr * 64 + cc * 2; return st * 1024 + (ob ^ (((rr >> 2) & 1) * 48)); }
DI void stage_rc_f8(int b, int& R, int& C) { const int st = b / 1024, sb = b % 1024, rr = sb / 64, w = (sb % 64) ^ (((rr >> 2) & 1) * 48); R = (st >> 1) * 16 + rr; C = (st & 1) * 32 + w / 2; }
DI int perm32(int rho) { const int n = rho >> 4, i = rho & 15; return 8 * (i >> 2) + 4 * n + (i & 3); }

struct Unit { int pm, pn, e; };

template <int M, int N> struct StaticOrder {
    int c;
    DI bool next(int i, Unit& u) const {
        constexpr int nM = M / BM, nN = N / BM, nwg = nM * nN;
        const int L = i * G + c; if (L >= nwg) return false;
        int wgid = L; { constexpr int q = nwg / NXCD, r = nwg % NXCD; const int xcd = wgid % NXCD, off = wgid / NXCD; wgid = (xcd < r ? xcd * (q + 1) : r * (q + 1) + (xcd - r) * q) + off; }
        constexpr int nig = WGM * nN; const int gid = wgid / nig, fm = gid * WGM, gsz = (nM - fm) < WGM ? (nM - fm) : WGM;
        u.pm = fm + ((wgid % nig) % gsz); u.pn = (wgid % nig) / gsz; u.e = 0; return true;
    }
};
template <int NPN> struct GroupOrder {
    int g0, g1, c;
    DI bool next(int i, Unit& u) const {
        constexpr int GPX = 32 / NPN;
        const int x = c & 7, j = c >> 3;
        const int g = g0 + i * (8 * GPX) + x * GPX + j / NPN;
        if (g >= g1) return false;
        u.pm = g; u.pn = j % NPN;
        { const unsigned char* p = wsp() + WS_GRPE + (size_t)g * 4; int e; asm volatile("s_load_dword %0, %1, 0x0\n\ts_waitcnt lgkmcnt(0)" : "=s"(e) : "s"(p)); u.e = e; }
        return true;
    }
};
template <bool F8> DI void piece_rc(int i, int& R, int& C) { int t = threadIdx.x; asm volatile("" : "+v"(t)); if (F8) stage_rc_f8(t * 16 + i * 8192, R, C); else stage_rc(t * 16 + i * 8192, R, C); }
template <bool F8> DI unsigned tok_off(const LAS int* tb, int h, int i, unsigned pitch) { int R, C; piece_rc<F8>(i, R, C); int tok = tb[h * HALF + R]; tok = tok < 0 ? 0 : tok; return (unsigned)tok * pitch + (unsigned)C * 2u; }

struct FragBF { bf16x8 k0, k1; };
struct FragF8 { v8i v; };
DI void ldfrag(FragBF& f, const LAS unsigned char* p, const LAS unsigned char* p1) { f.k0 = *(const LAS bf16x8*)p; f.k1 = *(const LAS bf16x8*)p1; }
DI void ldfrag(FragF8& f, const LAS unsigned char* p, const LAS unsigned char* p1) { const u32x4 x = *(const LAS u32x4*)p, y = *(const LAS u32x4*)p1;
    f.v = (v8i){(int)x.x, (int)x.y, (int)x.z, (int)x.w, (int)y.x, (int)y.y, (int)y.z, (int)y.w}; }
DI void mma(f32x4& acc, const FragBF& w, const FragBF& a) { acc = __builtin_amdgcn_mfma_f32_16x16x32_bf16(w.k0, a.k0, acc, 0, 0, 0); acc = __builtin_amdgcn_mfma_f32_16x16x32_bf16(w.k1, a.k1, acc, 0, 0, 0); }
DI void mma(f32x4& acc, const FragF8& w, const FragF8& a) { acc = __builtin_amdgcn_mfma_scale_f32_16x16x128_f8f6f4(w.v, a.v, acc, 0, 0, 0, WQ_E8M0, 0, 127); }
template <class Cfg, class Epi, class Sched>
DI void gemm_phase(LAS unsigned char* lds, LAS unsigned char* tokbuf, const int pm_bias, const Sched& S, const Epi& E) {
    constexpr bool GATHER = Cfg::GATHER, FP8 = Cfg::FP8;
    constexpr int ROWB = FP8 ? GK : 2 * GK, NT = ROWB / 128;
    constexpr size_t HSTEP = (size_t)HALF * ROWB, TSTEP = 2 * HSTEP;
    using Frag = typename std::conditional<FP8, FragF8, FragBF>::type;
    int tid = threadIdx.x; asm volatile("" : "+v"(tid));
    const int wid = __builtin_amdgcn_readfirstlane(tid >> 6), lane = tid & 63, wr = wid >> 2, wc = wid & 3, fr = lane & 15, fq = lane >> 4;
    unsigned voffB[2], vaC[2][2];
#pragma unroll
    for (int i = 0; i < 2; ++i) { int R, C; if (FP8) stage_rc_f8(tid * 16 + i * 8192, R, C); else stage_rc(tid * 16 + i * 8192, R, C); const int Rb = Epi::PERM ? ((R & ~31) + perm32(R & 31)) : R;
        voffB[i] = (unsigned)(Rb * ROWB + C * 2); vaC[0][i] = (unsigned)(R * ROWB + C * 2); vaC[1][i] = vaC[0][i]; }
    constexpr size_t AHSTEP = GATHER ? (size_t)0 : HSTEP;
    const unsigned ldsw = (unsigned)wid * 1024u, ldsb = lds_u32(lds);
    const int cfr = FP8 ? (fq >> 1) * 32 + (fq & 1) * 16 : fq * 8;
    const int aoff = FP8 ? lds_byte_f8(wr * 64 + fr, cfr) : lds_byte(wr * 64 + fr, cfr);
    const int aoff1 = FP8 ? (aoff ^ 16) : aoff + 1024;
    int boff = (FP8 ? lds_byte_f8(wc * 32 + fr, cfr) : lds_byte(wc * 32 + fr, cfr)) + 4 * HTB; asm volatile("" : "+v"(boff));
    int boff1 = FP8 ? (boff ^ 16) : boff + 1024; asm volatile("" : "+v"(boff1));
#define PG8_SA(b, h) (((b) * 2 + (h)) * HTB)
#define PG8_SB(b, h) ((4 + (b) * 2 + (h)) * HTB)
    const __amdgpu_buffer_rsrc_t rs = __builtin_amdgcn_make_buffer_rsrc((void*)wsp(), 0, 0x40000000, 0x00020000);
#define PG8_STAGEB(bufoff, soff) do { _Pragma("unroll") for (int _i = 0; _i < 2; ++_i) dma16(rs, ldsb + (bufoff) + ldsw + _i * 8192, voffB[_i], (soff)); } while (0)
#define PG8_STAGEA(bufoff, soff, o0, o1) do { dma16(rs, ldsb + (bufoff) + ldsw, (o0), (soff)); dma16(rs, ldsb + (bufoff) + ldsw + 8192, (o1), (soff)); } while (0)
#define PG8_LDA(dst, b, h) do { _Pragma("unroll") for (int m = 0; m < 4; ++m) ldfrag(dst[m], lds + PG8_SA(b, h) + aoff + m * 2048, lds + PG8_SA(b, h) + aoff1 + m * 2048); } while (0)
#define PG8_LDB(dst, b, h) do { _Pragma("unroll") for (int n = 0; n < 2; ++n) ldfrag(dst[n], lds + ((b) * 2 + (h)) * HTB + boff + n * 2048, lds + ((b) * 2 + (h)) * HTB + boff1 + n * 2048); } while (0)
#define PG8_MMA(ai, bj, At, Bt) do { __builtin_amdgcn_s_setprio(1); _Pragma("unroll") for (int m = 0; m < 4; ++m) _Pragma("unroll") for (int n = 0; n < 2; ++n) \
        mma(acc[ai][bj][m][n], Bt[n], At[m]); __builtin_amdgcn_s_setprio(0); } while (0)
#define PG8_WAIT_V(n) asm volatile("s_waitcnt vmcnt(" #n ")" ::: "memory")
#define PG8_WAIT_L(n) asm volatile("s_waitcnt lgkmcnt(" #n ")" ::: "memory")
#define PG8_BAR __builtin_amdgcn_s_barrier()
#define PG8_SCHED __builtin_amdgcn_sched_barrier(0)
#define PG8_ABASE(u) (GATHER ? (unsigned)Cfg::A_OFF : (unsigned)(Cfg::A_OFF + (size_t)((u).pm - pm_bias) * TSTEP))
#define PG8_BBASE(u) ((unsigned)(Cfg::B_OFF + (size_t)(u).e * Cfg::B_E_BYTES + (size_t)(u).pn * TSTEP))
#define PG8_TOKDMA(u, dst) dma16(rs, lds_u32(dst), (unsigned)lane * 16u, (unsigned)(WS_SLOTTOK + (size_t)(u).pm * 1024))
    Unit cur, nxt; int ui = 0;
    if (!S.next(0, cur)) return;
    if constexpr (GATHER) {
        if (wid == 0) PG8_TOKDMA(cur, tokbuf);
        PG8_WAIT_V(0); PG8_BAR;
#pragma unroll
        for (int h = 0; h < 2; ++h)
#pragma unroll
            for (int i = 0; i < 2; ++i) vaC[h][i] = tok_off<FP8>((const LAS int*)tokbuf, h, i, Cfg::A_PITCH);
        PG8_WAIT_L(0); PG8_BAR;
    }
    f32x4 acc[2][2][4][2];
#pragma unroll
    for (int a = 0; a < 2; ++a)
#pragma unroll
        for (int b = 0; b < 2; ++b)
#pragma unroll
            for (int m = 0; m < 4; ++m)
#pragma unroll
                for (int n = 0; n < 2; ++n) acc[a][b][m][n] = (f32x4){0.f, 0.f, 0.f, 0.f};
    Frag At[4], B0[2], B1[2];
    unsigned cA = PG8_ABASE(cur);
    unsigned cB = PG8_BBASE(cur);
    PG8_STAGEB(PG8_SB(0, 0), cB); PG8_STAGEB(PG8_SB(0, 1), cB + (unsigned)HSTEP); PG8_STAGEA(PG8_SA(0, 0), cA, vaC[0][0], vaC[0][1]); PG8_STAGEA(PG8_SA(0, 1), cA + (unsigned)AHSTEP, vaC[1][0], vaC[1][1]);
    if (wr == 1) PG8_BAR;
    PG8_WAIT_V(2); PG8_BAR;
    PG8_STAGEB(PG8_SB(1, 0), cB + (unsigned)KSTEP); PG8_STAGEA(PG8_SA(1, 0), cA + (unsigned)KSTEP, vaC[0][0], vaC[0][1]); PG8_STAGEB(PG8_SB(1, 1), cB + (unsigned)(HSTEP + KSTEP));
    PG8_WAIT_V(6); PG8_BAR;
    for (;;) {
        const bool has_next = S.next(ui + 1, nxt);
        const LAS int* tbn = (const LAS int*)(tokbuf + ((ui + 1) & 1) * 1024);
        if constexpr (Epi::PREFETCH) E.prefetch(rs, lds, cur, ui, wid, lane);
        if constexpr (GATHER) {
            if (has_next && wid == 0) PG8_TOKDMA(nxt, tokbuf + ((ui + 1) & 1) * 1024);
        }
        asm volatile(".p2align 8" ::: "memory");
#pragma unroll 1
        for (int t = 0; t < NT; t += 2) {
            const bool last = (t == NT - 2);
            const unsigned a1 = cA + (unsigned)(t + 1) * (unsigned)KSTEP;
            unsigned a2 = cA + (unsigned)(t + 2) * (unsigned)KSTEP, b2 = cB + (unsigned)(t + 2) * (unsigned)KSTEP;
            if (last) {
                if (has_next) { a2 = PG8_ABASE(nxt); b2 = PG8_BBASE(nxt);
                    if constexpr (GATHER) { vaC[0][0] = tok_off<FP8>(tbn, 0, 0, Cfg::A_PITCH); vaC[0][1] = tok_off<FP8>(tbn, 0, 1, Cfg::A_PITCH); } }
                else { a2 = cA; b2 = cB; }
            }
            const unsigned a3 = a2 + (unsigned)KSTEP, b3 = b2 + (unsigned)KSTEP;
            PG8_LDB(B0, 0, 0); PG8_LDB(B1, 0, 1); PG8_SCHED; PG8_LDA(At, 0, 0); PG8_STAGEA(PG8_SA(1, 1), a1 + (unsigned)AHSTEP, vaC[1][0], vaC[1][1]);
            if constexpr (GATHER) { if (last && has_next) { vaC[1][0] = tok_off<FP8>(tbn, 1, 0, Cfg::A_PITCH); vaC[1][1] = tok_off<FP8>(tbn, 1, 1, Cfg::A_PITCH); } }
            PG8_WAIT_V(8); PG8_WAIT_L(0); PG8_BAR; PG8_MMA(0, 0, At, B0); PG8_MMA(0, 1, At, B1); PG8_BAR; PG8_SCHED;
            PG8_LDA(At, 0, 1); PG8_STAGEB(PG8_SB(0, 0), b2); PG8_STAGEB(PG8_SB(0, 1), b2 + (unsigned)HSTEP); PG8_STAGEA(PG8_SA(0, 0), a2, vaC[0][0], vaC[0][1]);
            PG8_WAIT_V(8); PG8_WAIT_L(0); PG8_BAR; PG8_MMA(1, 0, At, B0); PG8_MMA(1, 1, At, B1); PG8_BAR; PG8_SCHED;
            PG8_LDB(B0, 1, 0); PG8_LDB(B1, 1, 1); PG8_SCHED; PG8_LDA(At, 1, 0); PG8_STAGEA(PG8_SA(0, 1), a2 + (unsigned)AHSTEP, vaC[1][0], vaC[1][1]);
            PG8_WAIT_V(8); PG8_WAIT_L(0); PG8_BAR; PG8_MMA(0, 0, At, B0); PG8_MMA(0, 1, At, B1); PG8_BAR; PG8_SCHED;
            PG8_LDA(At, 1, 1); PG8_STAGEB(PG8_SB(1, 0), b3); PG8_STAGEB(PG8_SB(1, 1), b3 + (unsigned)HSTEP); PG8_STAGEA(PG8_SA(1, 0), a3, vaC[0][0], vaC[0][1]);
            PG8_WAIT_V(8); PG8_WAIT_L(0); PG8_BAR; PG8_MMA(1, 0, At, B0); PG8_MMA(1, 1, At, B1); PG8_BAR; PG8_SCHED;
        }
        if (wr == 0) PG8_BAR;
        { int t2 = threadIdx.x; asm volatile("" : "+v"(t2));
          E(acc, cur, wr, wc, t2 & 15, (t2 >> 4) & 3, lds, ui, rs); }
        if (!has_next) break;
#pragma unroll
        for (int a = 0; a < 2; ++a)
#pragma unroll
            for (int b = 0; b < 2; ++b)
#pragma unroll
                for (int m = 0; m < 4; ++m)
#pragma unroll
                    for (int n = 0; n < 2; ++n) acc[a][b][m][n] = (f32x4){0.f, 0.f, 0.f, 0.f};
        cur = nxt; cA = PG8_ABASE(cur); cB = PG8_BBASE(cur); ++ui;
        if (wr == 1) PG8_BAR;
    }
    PG8_WAIT_V(0);
    PG8_BAR;
#undef PG8_SA
#undef PG8_SB
#undef PG8_STAGEA
#undef PG8_STAGEB
#undef PG8_LDA
#undef PG8_LDB
#undef PG8_MMA
#undef PG8_WAIT_V
#undef PG8_WAIT_L
#undef PG8_BAR
#undef PG8_SCHED
#undef PG8_ABASE
#undef PG8_BBASE
#undef PG8_TOKDMA
}
}

#define EPI_DMA(w, dstoff, wsoff) do { if (wid == (w)) dma16(rs, lds_u32(eb) + (dstoff), (unsigned)lane * 16u, (unsigned)(wsoff)); } while (0)
struct EpiInProj {
    static constexpr bool PERM = true, PREFETCH = true;
    DI void prefetch(const __amdgpu_buffer_rsrc_t rs, LAS unsigned char* lds, const pg8::Unit& u, int ui, int wid, int lane) const {
        LAS unsigned char* eb = lds + EPIBUF_OFF + (ui & 1) * EPIBUF_SZ;
        EPI_DMA(1, 0, WS_BINP + (size_t)u.pn * 1024); EPI_DMA(2, 1024, WS_POSF + (size_t)u.pm * 1024);
    }
    DI void operator()(f32x4 (&acc)[2][2][4][2], const pg8::Unit& u, int wr, int wc, int fr, int fq, LAS unsigned char* lds, int ui, const __amdgpu_buffer_rsrc_t rs) const {
        const int pn = u.pn;
        int kind, head, ldc; size_t boff;
        if (pn < 2) { kind = 0; head = 4 * pn + wc; boff = WS_QB; ldc = 512; }
        else if (pn == 2) { if (wc < 2) { kind = 1; head = wc; boff = WS_KB; } else { kind = 2; head = wc - 2; boff = WS_VB; } ldc = 128; }
        else if (pn < 5) { kind = 3; head = 4 * (pn - 3) + wc; boff = WS_GUB; ldc = 512; }
        else { kind = 4; head = 4 * (pn - 5) + wc; boff = WS_GVB; ldc = 512; }
        bf16_t* base = (bf16_t*)(wsp() + boff);
        const LAS float* bbuf = (const LAS float*)(lds + EPIBUF_OFF + (ui & 1) * EPIBUF_SZ); const LAS float* pbuf = bbuf + 256;
#pragma unroll
        for (int bj = 0; bj < 2; ++bj)
#pragma unroll
            for (int n = 0; n < 2; ++n) { const f32x4 bv = *(const LAS f32x4*)(bbuf + 128 * bj + 32 * wc + 8 * fq + 4 * n);
#pragma unroll
                for (int ai = 0; ai < 2; ++ai)
#pragma unroll
                    for (int m = 0; m < 4; ++m) acc[ai][bj][m][n] += bv; }
        const float* gn_g = inp<I_GNG>(); const float* gn_b = inp<I_GNB>();
        const int row0 = u.pm * 256 + wr * 64 + fr;
#pragma unroll
        for (int ai = 0; ai < 2; ++ai)
#pragma unroll
            for (int m = 0; m < 4; ++m) {
                const int row = row0 + ai * 128 + m * 16;
                f32x4 v[2][2];
#pragma unroll
                for (int bj = 0; bj < 2; ++bj)
#pragma unroll
                    for (int n = 0; n < 2; ++n) v[bj][n] = acc[ai][bj][m][n];
                if (kind <= 1) {
                    const float pos = pbuf[wr * 64 + fr + ai * 128 + m * 16];
#pragma unroll
                    for (int n = 0; n < 2; ++n) {
                        f32x4 c4, s4;
#pragma unroll
                        for (int j = 0; j < 4; ++j) { const int i = 4 * n + j;
                            const float invr = i == 0 ? 1.5915494309189535e-01f : i == 1 ? 3.086376340470123e-02f : i == 2 ? 5.985185712713705e-03f : i == 3 ? 1.160663641240061e-03f : i == 4 ? 2.2507907903927653e-04f : i == 5 ? 4.364795279280289e-05f : i == 6 ? 8.464330808241401e-06f : 1.6414262627950345e-06f;
                            float rev = pos * invr; rev -= floorf(rev); c4[j] = __builtin_amdgcn_cosf(rev); s4[j] = __builtin_amdgcn_sinf(rev); }
                        f32x4 p4;
#pragma unroll
                        for (int j = 0; j < 4; ++j) { float a_ = v[0][n][j], b_ = a_; swap16(a_, b_); p4[j] = (fq & 1) ? a_ : b_; }
                        const f32x4 sg = (fq & 1) ? s4 : -s4;
                        const f32x4 rot = v[0][n] * c4 + p4 * sg;
                        if (fq < 2) v[0][n] = rot;
                    }
                    if (kind == 0) {
#pragma unroll
                        for (int bj = 0; bj < 2; ++bj)
#pragma unroll
                            for (int n = 0; n < 2; ++n) v[bj][n] = v[bj][n] * QSCALE;
                    }
                } else if (kind >= 3) {
#pragma unroll
                    for (int bj = 0; bj < 2; ++bj)
#pragma unroll
                        for (int n = 0; n < 2; ++n) v[bj][n] = gelu4(v[bj][n]);
                    if (kind == 4) {
                        float s = 0.f;
#pragma unroll
                        for (int bj = 0; bj < 2; ++bj)
#pragma unroll
                            for (int n = 0; n < 2; ++n) s += (v[bj][n][0] + v[bj][n][1]) + (v[bj][n][2] + v[bj][n][3]);
                        s += __shfl_xor(s, 16); s += __shfl_xor(s, 32);
                        const float mean = s * (1.0f / 64.0f); float q = 0.f;
#pragma unroll
                        for (int bj = 0; bj < 2; ++bj)
#pragma unroll
                            for (int n = 0; n < 2; ++n) { v[bj][n] = v[bj][n] - mean; const f32x4 d = v[bj][n]; q += (d[0] * d[0] + d[1] * d[1]) + (d[2] * d[2] + d[3] * d[3]); }
                        q += __shfl_xor(q, 16); q += __shfl_xor(q, 32);
                        const float rstd = 1.0f / sqrtf(q * (1.0f / 64.0f) + LN_EPS);
#pragma unroll
                        for (int bj = 0; bj < 2; ++bj)
#pragma unroll
                            for (int n = 0; n < 2; ++n) v[bj][n] = v[bj][n] * rstd * *(const f32x4*)(gn_g + 32 * bj + 8 * fq + 4 * n) + *(const f32x4*)(gn_b + 32 * bj + 8 * fq + 4 * n);
                    }
                }
                bf16_t* rowp = base + (size_t)row * ldc + head * 64 + 8 * fq;
#pragma unroll
                for (int bj = 0; bj < 2; ++bj) { u32x4 w; w.x = cvtpk(v[bj][0][0], v[bj][0][1]); w.y = cvtpk(v[bj][0][2], v[bj][0][3]); w.z = cvtpk(v[bj][1][0], v[bj][1][1]); w.w = cvtpk(v[bj][1][2], v[bj][1][3]);
                    *(u32x4*)(rowp + 32 * bj) = w; }
            }
    }
};
struct EpiOut {
    static constexpr bool PERM = false, PREFETCH = true;
    DI void prefetch(const __amdgpu_buffer_rsrc_t rs, LAS unsigned char* lds, const pg8::Unit& u, int ui, int wid, int lane) const {
        LAS unsigned char* eb = lds + EPIBUF_OFF + (ui & 1) * EPIBUF_SZ;
        EPI_DMA(1, 0, WS_OUTC + (size_t)u.pn * 1024); EPI_DMA(2, 1024, WS_OUTC + 4096 + (size_t)u.pn * 1024);
        EPI_DMA(3, 2048, WS_STATS0 + (size_t)u.pm * 2048); EPI_DMA(4, 3072, WS_STATS0 + (size_t)u.pm * 2048 + 1024);
    }
    DI void operator()(f32x4 (&acc)[2][2][4][2], const pg8::Unit& u, int wr, int wc, int fr, int fq, LAS unsigned char* lds, int ui, const __amdgpu_buffer_rsrc_t rs) const {
        const int col0 = u.pn * 256 + wc * 32 + 4 * fq;
        float* y1 = outp();
        const float* x = inp<I_X>();
        const LAS float* cbuf = (const LAS float*)(lds + EPIBUF_OFF + (ui & 1) * EPIBUF_SZ); const LAS f32x2* sbuf = (const LAS f32x2*)(cbuf + 512);
        f32x4 ca[2][2];
#pragma unroll
        for (int bj = 0; bj < 2; ++bj)
#pragma unroll
            for (int n = 0; n < 2; ++n) { const int tc = wc * 32 + 4 * fq + bj * 128 + n * 16; ca[bj][n] = *(const LAS f32x4*)(cbuf + tc); const f32x4 cb = *(const LAS f32x4*)(cbuf + 256 + tc);
#pragma unroll
                for (int ai = 0; ai < 2; ++ai)
#pragma unroll
                    for (int m = 0; m < 4; ++m) acc[ai][bj][m][n] += cb; }
        const int row0 = u.pm * 256 + wr * 64 + fr;
#pragma unroll
        for (int ai = 0; ai < 2; ++ai) {
            f32x4 xv[4][2][2];
#pragma unroll
            for (int m = 0; m < 4; ++m) { const size_t off = (size_t)(row0 + ai * 128 + m * 16) * D + col0;
#pragma unroll
                for (int bj = 0; bj < 2; ++bj)
#pragma unroll
                    for (int n = 0; n < 2; ++n) xv[m][bj][n] = *(const f32x4*)(x + off + bj * 128 + n * 16); }
#pragma unroll
            for (int m = 0; m < 4; ++m) {
                const int rt = wr * 64 + fr + ai * 128 + m * 16;
                const f32x2 st = sbuf[rt];
                const size_t off = (size_t)(row0 + ai * 128 + m * 16) * D + col0;
#pragma unroll
                for (int bj = 0; bj < 2; ++bj)
#pragma unroll
                    for (int n = 0; n < 2; ++n) { const f32x4 o = acc[ai][bj][m][n] + (xv[m][bj][n] - st.x) * st.y * ca[bj][n];
                        *(f32x4*)(y1 + off + bj * 128 + n * 16) = o; }
            }
            asm volatile("" ::: "memory");
        }
    }
};
struct EpiGateUp {
    static constexpr bool PERM = true, PREFETCH = true;
    DI void prefetch(const __amdgpu_buffer_rsrc_t rs, LAS unsigned char* lds, const pg8::Unit& u, int ui, int wid, int lane) const {
        LAS unsigned char* eb = lds + EPIBUF_OFF + (ui & 1) * EPIBUF_SZ;
        EPI_DMA(1, 0, WS_BGU + ((size_t)u.e * 8 + u.pn) * 1024);
    }
    DI void operator()(f32x4 (&acc)[2][2][4][2], const pg8::Unit& u, int wr, int wc, int fr, int fq, LAS unsigned char* lds, int ui, const __amdgpu_buffer_rsrc_t rs) const {
        const int hcol0 = 128 * u.pn + 32 * wc + 8 * fq;
        unsigned char* hmid = wsp() + WS_HMID;
        const LAS float* bbuf = (const LAS float*)(lds + EPIBUF_OFF + (ui & 1) * EPIBUF_SZ);
        f32x4 bg[2], bu[2];
#pragma unroll
        for (int n = 0; n < 2; ++n) { bg[n] = *(const LAS f32x4*)(bbuf + 32 * wc + 8 * fq + 4 * n); bu[n] = *(const LAS f32x4*)(bbuf + 128 + 32 * wc + 8 * fq + 4 * n); }
        const size_t row0 = (size_t)u.pm * 256 + wr * 64 + fr;
#pragma unroll
        for (int ai = 0; ai < 2; ++ai)
#pragma unroll
            for (int m = 0; m < 4; ++m) {
                float h[2][4];
#pragma unroll
                for (int n = 0; n < 2; ++n) {
                    const f32x4 gt = acc[ai][0][m][n] + bg[n], up = acc[ai][1][m][n] + bu[n];
#pragma unroll
                    for (int j = 0; j < 4; ++j) {
                        const float gc = fminf(gt[j], 7.0f), uc = fminf(fmaxf(up[j], -7.0f), 7.0f);
                        const float sg = __builtin_amdgcn_rcpf(1.0f + __builtin_amdgcn_exp2f(gc * (-1.702f * LOG2E)));
                        h[n][j] = (uc + 1.0f) * (gc * sg);
                    }
                }
                u32x2 w; w.x = cvt4_fp8(h[0][0], h[0][1], h[0][2], h[0][3]); w.y = cvt4_fp8(h[1][0], h[1][1], h[1][2], h[1][3]);
                *(u32x2*)(hmid + (row0 + ai * 128 + m * 16) * 1024 + hcol0) = w;
            }
    }
};
struct EpiDown {
    static constexpr bool PERM = true, PREFETCH = true;
    DI void prefetch(const __amdgpu_buffer_rsrc_t rs, LAS unsigned char* lds, const pg8::Unit& u, int ui, int wid, int lane) const {
        LAS unsigned char* eb = lds + EPIBUF_OFF + (ui & 1) * EPIBUF_SZ;
        EPI_DMA(1, 0, WS_SLOTDEST + (size_t)u.pm * 1024); EPI_DMA(2, 1024, WS_SLOTGATE + (size_t)u.pm * 1024); EPI_DMA(3, 2048, WS_BD + (size_t)u.e * 4096 + (size_t)u.pn * 1024);
    }
    DI void operator()(f32x4 (&acc)[2][2][4][2], const pg8::Unit& u, int wr, int wc, int fr, int fq, LAS unsigned char* lds, int ui, const __amdgpu_buffer_rsrc_t rs) const {
        const int col0 = 256 * u.pn + 32 * wc + 8 * fq;
        const LAS int* dbuf = (const LAS int*)(lds + EPIBUF_OFF + (ui & 1) * EPIBUF_SZ); const LAS float* gbuf = (const LAS float*)(dbuf + 256); const LAS float* bbuf = gbuf + 256;
        f32x4 bd[2][2];
#pragma unroll
        for (int bj = 0; bj < 2; ++bj)
#pragma unroll
            for (int n = 0; n < 2; ++n) bd[bj][n] = *(const LAS f32x4*)(bbuf + 128 * bj + 32 * wc + 8 * fq + 4 * n);
#pragma unroll
        for (int ai = 0; ai < 2; ++ai) {
            int dest[4]; float gt[4];
#pragma unroll
            for (int m = 0; m < 4; ++m) { const int r = wr * 64 + fr + ai * 128 + m * 16; dest[m] = dbuf[r]; gt[m] = gbuf[r]; }
#pragma unroll
            for (int m = 0; m < 4; ++m) {
                if (dest[m] >= 0) {
                    const unsigned voff = (unsigned)dest[m] * 2048u + (unsigned)col0 * 2u;
#pragma unroll
                    for (int bj = 0; bj < 2; ++bj) { const f32x4 v0 = (acc[ai][bj][m][0] + bd[bj][0]) * gt[m], v1 = (acc[ai][bj][m][1] + bd[bj][1]) * gt[m];
                        u32x4 w; w.x = cvtpk(v0[0], v0[1]); w.y = cvtpk(v0[2], v0[3]); w.z = cvtpk(v1[0], v1[1]); w.w = cvtpk(v1[2], v1[3]);
                        __builtin_amdgcn_raw_buffer_store_b128(w, rs, voff + 256u * bj, (int)WS_YSLOT, 0); }
                }
            }
        }
    }
};
#undef EPI_DMA

DI int rowmap(int kind, int n) {
    if (kind == 0) { const int pn = n >> 8, ch = n & 255, wc = ch >> 6, bj = (ch >> 5) & 1, w = ch & 31; return (pn << 8) + (bj << 7) + (wc << 5) + w; }
    if (kind == 2) { return n < 1024 ? ((n >> 7) << 8) + (n & 127) : (((n - 1024) >> 7) << 8) + 128 + ((n - 1024) & 127); }
    return n;
}
DI void p0_transpose_item(const float* W, int N, bf16_t* WT, int kind, LAS unsigned char* scr, int item, int lane) {
    const int nblk = N / 64, kb = item / nblk, nb = item % nblk, k0 = 64 * kb, n0 = 64 * nb;
    const int nq = lane >> 2, kr = lane & 3;
    f32x4 a[8], b[8];
#pragma unroll
    for (int i = 0; i < 8; ++i) { const float* p = W + (size_t)(k0 + 8 * i + 2 * kr) * N + n0 + 4 * nq; a[i] = *(const GAS f32x4*)p; b[i] = *(const GAS f32x4*)(p + N); }
#pragma unroll
    for (int i = 0; i < 8; ++i)
#pragma unroll
        for (int c = 0; c < 4; ++c) *(LAS unsigned*)(scr + (4 * nq + c) * 132 + (8 * i + 2 * kr) * 2) = cvtpk(a[i][c], b[i][c]);
    LDS_WAIT(); asm volatile("" ::: "memory");
    const int c8 = lane & 7;
#pragma unroll
    for (int j = 0; j < 8; ++j) { const int n = (lane >> 3) + 8 * j; const LAS unsigned* s = (const LAS unsigned*)(scr + n * 132 + 16 * c8);
        u32x4 o; o.x = s[0]; o.y = s[1]; o.z = s[2]; o.w = s[3];
        *(GAS u32x4*)(WT + (size_t)rowmap(kind, n0 + n) * 1024 + k0 + 8 * c8) = o; }
    LDS_WAIT(); asm volatile("" ::: "memory");
}
struct QItem { const float* W; unsigned char* WT; int N, kind, k0, n0; };
DI QItem p0_qitem(int r, const float* wgu, const float* wd, unsigned char* ws) {
    constexpr int I_GU = (D / 128) * (2048 / 32), I_D = (D / 128) * (D / 32);
    QItem q;
    if (r < NE * I_GU) { const int e = r / I_GU, it = r % I_GU; q.W = wgu + (size_t)e * D * 2048; q.WT = ws + WS_WGU + (size_t)e * 2048 * D; q.N = 2048; q.kind = 2; q.k0 = 128 * (it / 64); q.n0 = 32 * (it % 64); }
    else { r -= NE * I_GU; const int e = r / I_D, it = r % I_D; q.W = wd + (size_t)e * D * D; q.WT = ws + WS_WD + (size_t)e * D * D; q.N = D; q.kind = 1; q.k0 = 128 * (it / 32); q.n0 = 32 * (it % 32); }
    return q;
}
DI void p0_qload(const QItem& q, f32x4 (&a)[4][4], int lane) {
    const int nq = lane >> 3, kr = lane & 7;
#pragma unroll
    for (int i = 0; i < 4; ++i) { const float* p = q.W + (size_t)(q.k0 + 32 * i + 4 * kr) * q.N + q.n0 + 4 * nq;
#pragma unroll
        for (int u = 0; u < 4; ++u) a[i][u] = *(const GAS f32x4*)(p + (size_t)u * q.N); }
}
DI void p0_qfinish(const QItem& q, const f32x4 (&a)[4][4], LAS unsigned char* scr, int lane) {
    const int nq = lane >> 3, kr = lane & 7;
#pragma unroll
    for (int i = 0; i < 4; ++i)
#pragma unroll
        for (int c = 0; c < 4; ++c) *(LAS unsigned*)(scr + (4 * nq + c) * 136 + 32 * i + 4 * kr) = cvt4_fp8(a[i][0][c] * WQ_SCALE, a[i][1][c] * WQ_SCALE, a[i][2][c] * WQ_SCALE, a[i][3][c] * WQ_SCALE);
    LDS_WAIT(); asm volatile("" ::: "memory");
    const int c8 = lane & 7;
#pragma unroll
    for (int j = 0; j < 4; ++j) { const int n = (lane >> 3) + 8 * j; const LAS u32x2* s = (const LAS u32x2*)(scr + n * 136 + 16 * c8);
        const u32x2 x = s[0], y = s[1]; u32x4 o; o.x = x.x; o.y = x.y; o.z = y.x; o.w = y.y;
        *(GAS u32x4*)(q.WT + (size_t)rowmap(q.kind, q.n0 + n) * 1024 + q.k0 + 16 * c8) = o; }
    LDS_WAIT(); asm volatile("" ::: "memory");
}
DI void p0_prologue(const Frame& F0, LAS unsigned char* lds) {
    const Frame F = opaque(F0);
    unsigned char* ws = wsp();
    LAS unsigned char* scr = lds + F.wave * 16384;
    const int gw = F.bid * NWAVES + F.wave, NGW = G * NWAVES;
    const int gt = F.bid * NTHREADS + F.tid, NGT = G * NTHREADS;
    constexpr int I_IN = (D / 64) * (INW / 64), I_OUT = (D / 64) * (D / 64), I_GU = (D / 128) * (2048 / 32), I_D = (D / 128) * (D / 32);
    for (int it = gw; it < I_IN + I_OUT; it += NGW) {
        if (it < I_IN) p0_transpose_item(inp<I_WIN>(), INW, (bf16_t*)(ws + WS_WIN), 0, scr, it, F.lane);
        else p0_transpose_item(inp<I_WOUT>(), D, (bf16_t*)(ws + WS_WOUT), 1, scr, it - I_IN, F.lane);
    }
    {
        constexpr int NQ = NE * (I_GU + I_D);
        const float* wgu = inp<I_WGU>(); const float* wd = inp<I_WD>();
        f32x4 ra[4][4], rb[4][4];
        QItem qa = p0_qitem(gw < NQ ? gw : 0, wgu, wd, ws), qb = qa;
        if (gw < NQ) p0_qload(qa, ra, F.lane);
#pragma unroll 1
        for (int it = gw; it < NQ; it += 2 * NGW) {
            const bool hb = it + NGW < NQ;
            if (hb) { qb = p0_qitem(it + NGW, wgu, wd, ws); p0_qload(qb, rb, F.lane); }
            p0_qfinish(qa, ra, scr, F.lane);
            if (it + 2 * NGW < NQ) { qa = p0_qitem(it + 2 * NGW, wgu, wd, ws); p0_qload(qa, ra, F.lane); }
            if (hb) p0_qfinish(qb, rb, scr, F.lane);
        }
    }
    bf16_t* h0b = (bf16_t*)(ws + WS_H0B); float* stats0 = (float*)(ws + WS_STATS0);
    const float* xin = inp<I_X>(); const float* lg = inp<I_LNING>(); const float* lb = inp<I_LNINB>();
    {
        f32x4 pf[4][4];
#pragma unroll
        for (int u = 0; u < 4; ++u)
#pragma unroll
            for (int j = 0; j < 4; ++j) pf[u][j] = ((const GAS f32x4*)(xin + (size_t)(gw + u * NGW) * D))[F.lane + 64 * j];
        f32x4 gg[4], bb[4];
#pragma unroll
        for (int j = 0; j < 4; ++j) { gg[j] = ((const f32x4*)lg)[F.lane + 64 * j]; bb[j] = ((const f32x4*)lb)[F.lane + 64 * j]; }
#pragma unroll 1
        for (int m0 = gw; m0 < T; m0 += 4 * NGW) {
#pragma unroll
            for (int u = 0; u < 4; ++u) {
                const int m = m0 + u * NGW;
                f32x4 v[4]; float s = 0.f;
#pragma unroll
                for (int j = 0; j < 4; ++j) { v[j] = pf[u][j]; s += (v[j].x + v[j].y) + (v[j].z + v[j].w); }
                { const int mn = (m + 4 * NGW < T) ? m + 4 * NGW : m;
#pragma unroll
                  for (int j = 0; j < 4; ++j) pf[u][j] = ((const GAS f32x4*)(xin + (size_t)mn * D))[F.lane + 64 * j]; }
                const float mean = wave_sum(s) * (1.f / D); float s2 = 0.f;
#pragma unroll
                for (int j = 0; j < 4; ++j) { v[j] = v[j] - mean; s2 += (v[j].x * v[j].x + v[j].y * v[j].y) + (v[j].z * v[j].z + v[j].w * v[j].w); }
                const float rstd = 1.f / sqrtf(wave_sum(s2) * (1.f / D) + LN_EPS);
                GAS u32x2* o8 = (GAS u32x2*)(h0b + (size_t)m * D) + F.lane;
#pragma unroll
                for (int j = 0; j < 4; ++j) { const f32x4 r = v[j] * rstd * gg[j] + bb[j]; u32x2 w; w.x = cvtpk(r.x, r.y); w.y = cvtpk(r.z, r.w); o8[64 * j] = w; }
                if (F.lane == 0) { stats0[2 * m] = mean; stats0[2 * m + 1] = rstd; }
            }
        }
    }
    {
        const int* positions = (const int*)inp<I_POS>(); float* posf = (float*)(ws + WS_POSF);
        for (int i = gt; i < T; i += NGT) posf[i] = (float)positions[i];
        const float* b_in = inp<I_BIN>(); float* binp = (float*)(ws + WS_BINP);
        for (int i = gt; i < INW; i += NGT) { const int pn = i >> 8, t = i & 255, bj = t >> 7, wc = (t >> 5) & 3, w = t & 31; binp[i] = b_in[256 * pn + 64 * wc + 32 * bj + w]; }
        const float* bgu = inp<I_BGU>(); float* bgup = (float*)(ws + WS_BGU);
        for (int i = gt; i < NE * 2048; i += NGT) { const int e = i >> 11, r = i & 2047, pn = r >> 8, t = r & 255; bgup[i] = bgu[e * 2048 + (t < 128 ? 128 * pn + t : 1024 + 128 * pn + (t - 128))]; }
        const float* bd = inp<I_BD>(); float* bdp = (float*)(ws + WS_BD);
        for (int i = gt; i < NE * 1024; i += NGT) bdp[i] = bd[i];
    }
    int* slot_tok = (int*)(ws + WS_SLOTTOK); int* slot_dest = (int*)(ws + WS_SLOTDEST);
    for (int i = gt; i < NSLOT; i += NGT) { slot_tok[i] = -1; slot_dest[i] = -1; }
    float* outc = (float*)(ws + WS_OUTC); const float* bo = inp<I_BOUT>();
    for (int i = gt; i < D; i += NGT) { outc[i] = ALPHA * lg[i]; outc[1024 + i] = bo[i] + ALPHA * lb[i]; }
    bf16_t* wsp = (bf16_t*)(ws + WS_WSP); const float* w_s = inp<I_WS>();
    for (int i = gt; i < 8 * 128 * 128; i += NGT) {
        const int j = i & 7, hi = (i >> 3) & 1, ks = (i >> 4) & 7, t = (i >> 7) & 127, h = i >> 14;
        const int s = 16 * ks + 8 * (j >> 2) + 4 * hi + (j & 3);
        const float w = (s <= t) ? w_s[((size_t)h * 128 + t) * 128 + s] : 0.f;
        wsp[i] = (bf16_t)(cvtpk(w, 0.f) & 0xffffu);
    }
}

#define MFMA32(a, b, c) __builtin_amdgcn_mfma_f32_32x32x16_bf16((a), (b), (c), 0, 0, 0)
DI int crow(int r, int hi) { return (r & 3) + 8 * (r >> 2) + 4 * hi; }
DI bf16x8 cat4(s16x4 lo, s16x4 hi) { return __builtin_shufflevector(lo, hi, 0, 1, 2, 3, 4, 5, 6, 7); }
#define ATT_ISSUE_Q(uu, sb) do { const int b_ = (uu) >> 6, n_ = ((uu) >> 1) & 31, kvh_ = (uu) & 1, tok0_ = b_ * SEQ + n_ * 128, hq_ = kvh_ * 4 + g; \
    const bf16_t* qp = Qb + (size_t)(tok0_ + rh * 64 + (sb) * 32 + q) * 512 + hq_ * 64 + hi * 8; \
    _Pragma("unroll") for (int ds = 0; ds < 4; ++ds) qf[sb][ds] = *(const bf16x8*)(qp + ds * 16); } while (0)
#define ATT_ISSUE_KV(uu) do { const int b_ = (uu) >> 6, n_ = ((uu) >> 1) & 31, kvh_ = (uu) & 1, tok0_ = b_ * SEQ + n_ * 128; \
    _Pragma("unroll") for (int rep = 0; rep < 4; ++rep) { const int c = F.tid + 512 * rep, kw = c >> 3, ch = c & 7; \
        int tokk = tok0_ - 128 + kw; if (n_ == 0 && kw < 128) tokk = tok0_ + kw;       \
        kreg[rep] = *(const u32x4*)(Kb + (size_t)tokk * 128 + kvh_ * 64 + ch * 8); vreg[rep] = *(const u32x4*)(Vb + (size_t)tokk * 128 + kvh_ * 64 + ch * 8); } } while (0)
DI void attn_phase(const Frame& F0, LAS unsigned char* lds) {
    const Frame F = opaque(F0);
    unsigned char* ws = wsp();
    const bf16_t* Qb = (const bf16_t*)(ws + WS_QB); const bf16_t* Kb = (const bf16_t*)(ws + WS_KB); const bf16_t* Vb = (const bf16_t*)(ws + WS_VB);
    bf16_t* Ob = (bf16_t*)(ws + WS_H0B);
    LAS unsigned char* Kl = lds;
    LAS unsigned char* Vt = lds + 36864;
    const int g = F.wave >> 1, rh = F.wave & 1;
    const float* sinks = inp<I_SINKS>();
    u32x4 kreg[4], vreg[4]; bf16x8 qf[2][4];
    constexpr int NU = NBATCH * 32 * 2;
    if (F.bid < NU) { const int q = F.lane & 31, hi = F.lane >> 5; ATT_ISSUE_KV(F.bid); ATT_ISSUE_Q(F.bid, 0); ATT_ISSUE_Q(F.bid, 1); }
#pragma unroll 1
    for (int u = F.bid; u < NU; u += G) {
        const int b = u >> 6, n = (u >> 1) & 31, kvh = u & 1, tok0 = b * SEQ + n * 128, hq = kvh * 4 + g;
        int tid2 = F.tid; asm volatile("" : "+v"(tid2));
        const int q = tid2 & 31, hi = (tid2 >> 5) & 1;
#pragma unroll
        for (int rep = 0; rep < 4; ++rep) {
            const int c = tid2 + 512 * rep, kw = c >> 3, ch = c & 7;
            *(LAS u32x4*)(Kl + kw * 144 + ch * 16) = kreg[rep];
            const unsigned wv[4] = {vreg[rep].x, vreg[rep].y, vreg[rep].z, vreg[rep].w};
#pragma unroll
            for (int e = 0; e < 8; ++e) { const int d = ch * 8 + e; const unsigned short val = (unsigned short)((e & 1) ? (wv[e >> 1] >> 16) : (wv[e >> 1] & 0xffffu));
                *(LAS unsigned short*)(Vt + d * 512 + ((((kw >> 2) ^ (d & 31))) << 3) + (kw & 3) * 2) = val; }
        }
        __syncthreads();
        if (u + G < NU) ATT_ISSUE_KV(u + G);
        const float sink2 = sinks[hq] * LOG2E;
#pragma unroll
        for (int sb = 0; sb < 2; ++sb) {
            const int r0 = rh * 64 + sb * 32, kb0 = r0 >> 5;
            f32x16 p[5];
#pragma unroll
            for (int kbi = 0; kbi < 5; ++kbi) {
                f32x16 a = {};
#pragma unroll
                for (int ds = 0; ds < 4; ++ds) { const bf16x8 kf = *(const LAS bf16x8*)(Kl + ((kb0 + kbi) * 32 + q) * 144 + (ds * 16 + hi * 8) * 2); a = MFMA32(kf, qf[sb][ds], a); }
                p[kbi] = a;
            }
            if (u + G < NU) ATT_ISSUE_Q(u + G, sb);
            float mx = sink2;
#pragma unroll
            for (int kbi = 0; kbi < 5; ++kbi) {
                const bool blk_ok = (n > 0) || (kb0 + kbi >= 4);
#pragma unroll
                for (int r = 0; r < 16; ++r) { const int c = crow(r, hi); const bool ok = blk_ok && (kbi == 0 ? c > q : kbi == 4 ? c <= q : true);
                    const float s = ok ? p[kbi][r] : -1e30f; p[kbi][r] = s; mx = fmaxf(mx, s); }
            }
            mx = fmaxf(mx, partnerf<5>(mx, F.lane));
            float l = 0.f;
#pragma unroll
            for (int kbi = 0; kbi < 5; ++kbi)
#pragma unroll
                for (int r = 0; r < 16; ++r) { const float e = __builtin_amdgcn_exp2f(p[kbi][r] - mx); p[kbi][r] = e; l += e; }
            l += partnerf<5>(l, F.lane); l += __builtin_amdgcn_exp2f(sink2 - mx);
            f32x16 o0 = {}, o1 = {};
#pragma unroll
            for (int kbi = 0; kbi < 5; ++kbi)
#pragma unroll
                for (int s2 = 0; s2 < 2; ++s2) {
                    u32x4 pw; pw.x = cvtpk(p[kbi][8 * s2 + 0], p[kbi][8 * s2 + 1]); pw.y = cvtpk(p[kbi][8 * s2 + 2], p[kbi][8 * s2 + 3]);
                    pw.z = cvtpk(p[kbi][8 * s2 + 4], p[kbi][8 * s2 + 5]); pw.w = cvtpk(p[kbi][8 * s2 + 6], p[kbi][8 * s2 + 7]);
                    const bf16x8 pa = __builtin_bit_cast(bf16x8, pw);
                    const int kc = ((kb0 + kbi) * 32 + 16 * s2 + 4 * hi) >> 2;
                    { const int d = q; const s16x4 lo = *(const LAS s16x4*)(Vt + d * 512 + ((kc ^ (d & 31)) << 3)), hh = *(const LAS s16x4*)(Vt + d * 512 + (((kc + 2) ^ (d & 31)) << 3)); o0 = MFMA32(cat4(lo, hh), pa, o0); }
                    { const int d = 32 + q; const s16x4 lo = *(const LAS s16x4*)(Vt + d * 512 + ((kc ^ (d & 31)) << 3)), hh = *(const LAS s16x4*)(Vt + d * 512 + (((kc + 2) ^ (d & 31)) << 3)); o1 = MFMA32(cat4(lo, hh), pa, o1); }
                }
            const float rl = __builtin_amdgcn_rcpf(l);
            bf16_t* op = Ob + (size_t)(tok0 + r0 + q) * D + hq * 64 + 4 * hi;
#pragma unroll
            for (int g4 = 0; g4 < 4; ++g4) {
                u32x2 w0, w1; w0.x = cvtpk(o0[4 * g4] * rl, o0[4 * g4 + 1] * rl); w0.y = cvtpk(o0[4 * g4 + 2] * rl, o0[4 * g4 + 3] * rl);
                w1.x = cvtpk(o1[4 * g4] * rl, o1[4 * g4 + 1] * rl); w1.y = cvtpk(o1[4 * g4 + 2] * rl, o1[4 * g4 + 3] * rl);
                *(u32x2*)(op + 8 * g4) = w0; *(u32x2*)(op + 32 + 8 * g4) = w1;
            }
        }
        __syncthreads();
    }
}
#undef ATT_ISSUE_Q
#undef ATT_ISSUE_KV
template <int TB> DI void gmlp_tb(const bf16_t* GUb, const bf16_t* wsp, bf16_t* Ob, const float* b_s, LAS unsigned char* Vt, int h, int tok0, int q, int hi) {
    constexpr int NKS = 2 * TB + 2;
    const int t = TB * 32 + q;
    const bf16_t* gp = GUb + (size_t)(tok0 + t) * 512 + h * 64 + 4 * hi;
    const bf16_t* wp = wsp + ((size_t)(h * 128 + t) * 8) * 16 + hi * 8;
    bf16x8 wa[NKS];
#pragma unroll
    for (int ks = 0; ks < NKS; ++ks) wa[ks] = *(const bf16x8*)(wp + ks * 16);
    u32x2 gu0[4], gu1[4];
#pragma unroll
    for (int g4 = 0; g4 < 4; ++g4) { gu0[g4] = *(const u32x2*)(gp + 8 * g4); gu1[g4] = *(const u32x2*)(gp + 32 + 8 * g4); }
    const float bias = b_s[h * 128 + t];
    f32x16 a0 = {}, a1 = {};
#pragma unroll
    for (int ks = 0; ks < NKS; ++ks) {
        const int kc = (16 * ks + 4 * hi) >> 2;
        { const int d = q; const s16x4 lo = *(const LAS s16x4*)(Vt + d * 256 + ((kc ^ (d & 31)) << 3)), hh = *(const LAS s16x4*)(Vt + d * 256 + (((kc + 2) ^ (d & 31)) << 3)); a0 = MFMA32(cat4(lo, hh), wa[ks], a0); }
        { const int d = 32 + q; const s16x4 lo = *(const LAS s16x4*)(Vt + d * 256 + ((kc ^ (d & 31)) << 3)), hh = *(const LAS s16x4*)(Vt + d * 256 + (((kc + 2) ^ (d & 31)) << 3)); a1 = MFMA32(cat4(lo, hh), wa[ks], a1); }
    }
    bf16_t* op = Ob + (size_t)(tok0 + t) * D + 512 + h * 64 + 4 * hi;
#pragma unroll
    for (int g4 = 0; g4 < 4; ++g4) {
        u32x2 w0, w1;
        w0.x = cvtpk(bflo(gu0[g4].x) * (a0[4 * g4] + bias), bfhi(gu0[g4].x) * (a0[4 * g4 + 1] + bias)); w0.y = cvtpk(bflo(gu0[g4].y) * (a0[4 * g4 + 2] + bias), bfhi(gu0[g4].y) * (a0[4 * g4 + 3] + bias));
        w1.x = cvtpk(bflo(gu1[g4].x) * (a1[4 * g4] + bias), bfhi(gu1[g4].x) * (a1[4 * g4 + 1] + bias)); w1.y = cvtpk(bflo(gu1[g4].y) * (a1[4 * g4 + 2] + bias), bfhi(gu1[g4].y) * (a1[4 * g4 + 3] + bias));
        *(u32x2*)(op + 8 * g4) = w0; *(u32x2*)(op + 32 + 8 * g4) = w1;
    }
}
DI void gmlp_phase(const Frame& F0, LAS unsigned char* lds) {
    const Frame F = opaque(F0);
    unsigned char* ws = wsp();
    const int h = F.wave;
    const bf16_t* GUb = (const bf16_t*)(ws + WS_GUB); const bf16_t* GVb = (const bf16_t*)(ws + WS_GVB); const bf16_t* wsp = (const bf16_t*)(ws + WS_WSP);
    bf16_t* Ob = (bf16_t*)(ws + WS_H0B);
    const float* b_s = inp<I_BS>();
    LAS unsigned char* Vt = lds + F.wave * 16384;
    const int q = F.lane & 31, hi = F.lane >> 5;
    u32x4 gv[16];
#pragma unroll
    for (int rep = 0; rep < 16; ++rep) { const int c = F.lane + 64 * rep, s = c >> 3, ch = c & 7; gv[rep] = *(const u32x4*)(GVb + (size_t)(F.bid * 128 + s) * 512 + h * 64 + ch * 8); }
#pragma unroll 1
    for (int chunk = F.bid; chunk < T / 128; chunk += G) {
        const int tok0 = chunk * 128;
        int ln = F.lane; asm volatile("" : "+v"(ln));
#pragma unroll
        for (int rep = 0; rep < 16; ++rep) {
            const int c = ln + 64 * rep, s = c >> 3, ch = c & 7;
            const unsigned wv[4] = {gv[rep].x, gv[rep].y, gv[rep].z, gv[rep].w};
#pragma unroll
            for (int e = 0; e < 8; ++e) { const int d = ch * 8 + e; const unsigned short val = (unsigned short)((e & 1) ? (wv[e >> 1] >> 16) : (wv[e >> 1] & 0xffffu));
                *(LAS unsigned short*)(Vt + d * 256 + (((s >> 2) ^ (d & 31)) << 3) + (s & 3) * 2) = val; }
        }
        if (chunk + G < T / 128) {
#pragma unroll
            for (int rep = 0; rep < 16; ++rep) { const int c = F.lane + 64 * rep, s = c >> 3, ch = c & 7; gv[rep] = *(const u32x4*)(GVb + (size_t)((chunk + G) * 128 + s) * 512 + h * 64 + ch * 8); }
        }
        LDS_WAIT();
        gmlp_tb<0>(GUb, wsp, Ob, b_s, Vt, h, tok0, q, hi);
        gmlp_tb<1>(GUb, wsp, Ob, b_s, Vt, h, tok0, q, hi);
        gmlp_tb<2>(GUb, wsp, Ob, b_s, Vt, h, tok0, q, hi);
        gmlp_tb<3>(GUb, wsp, Ob, b_s, Vt, h, tok0, q, hi);
        LDS_WAIT();
    }
}

DI void p4_router(const Frame& F0, LAS unsigned char* lds) {
    const Frame F = opaque(F0);
    unsigned char* ws = wsp(); float* out = outp();
    LAS unsigned char* Whi = lds;
    LAS unsigned char* Wlo = lds + 65536;
    LAS int* cnt = (LAS int*)(lds + MISC_OFF + 256);
    { const float* w_router = inp<I_WR>();
      for (int i = F.tid; i < D * NE; i += NTHREADS) { const int c = i >> 5, e = i & 31; const float w = w_router[i];
          const unsigned h = cvtpk(w, 0.f) & 0xffffu; const unsigned l = cvtpk(w - __uint_as_float(h << 16), 0.f) & 0xffffu;
          const int off = e * 2048 + (((c >> 3) ^ (e & 15)) << 4) + (c & 7) * 2;
          *(LAS unsigned short*)(Whi + off) = (unsigned short)h; *(LAS unsigned short*)(Wlo + off) = (unsigned short)l; } }
    if (F.tid < 32) cnt[F.tid] = 0;
    __syncthreads();
    constexpr int R = T / G, rpw = R / NWAVES;
    static_assert(rpw == 32, "one 32-token MFMA block per wave");
    int* tok_e = (int*)(ws + WS_TOKE); float* tok_g = (float*)(ws + WS_TOKG); int* tok_l = (int*)(ws + WS_TOKL);
    const int lane = F.lane;
    const int tokb = F.bid * R + F.wave * rpw;
    {
        f32x4 g1[4], b1[4];
#pragma unroll
        for (int j = 0; j < 4; ++j) { g1[j] = ((const f32x4*)inp<I_LN1G>())[lane + 64 * j]; b1[j] = ((const f32x4*)inp<I_LN1B>())[lane + 64 * j]; }
        f32x4 pf[4][4];
#pragma unroll
        for (int u = 0; u < 4; ++u)
#pragma unroll
            for (int j = 0; j < 4; ++j) pf[u][j] = ((const GAS f32x4*)(out + (size_t)(tokb + u) * D))[lane + 64 * j];
#pragma unroll 1
        for (int i = 0; i < rpw; i += 4) {
#pragma unroll
            for (int u = 0; u < 4; ++u) {
                const int tok = tokb + i + u;
                f32x4 v[4];
#pragma unroll
                for (int j = 0; j < 4; ++j) v[j] = pf[u][j];
                { const int tn = (i + u + 4 < rpw) ? tok + 4 : tok;
#pragma unroll
                  for (int j = 0; j < 4; ++j) pf[u][j] = ((const GAS f32x4*)(out + (size_t)tn * D))[lane + 64 * j]; }
                float s = 0.f;
#pragma unroll
                for (int j = 0; j < 4; ++j) s += (v[j].x + v[j].y) + (v[j].z + v[j].w);
                const float mean = wave_sum(s) * (1.f / D); float s2 = 0.f;
#pragma unroll
                for (int j = 0; j < 4; ++j) { v[j] = v[j] - mean; s2 += (v[j].x * v[j].x + v[j].y * v[j].y) + (v[j].z * v[j].z + v[j].w * v[j].w); }
                const float rstd = 1.f / sqrtf(wave_sum(s2) * (1.f / D) + LN_EPS);
                float* rowp = out + (size_t)tok * D;
                GAS u32x2* hp = (GAS u32x2*)rowp + lane; GAS u32x2* lp = (GAS u32x2*)(rowp + 512) + lane;
#pragma unroll
                for (int j = 0; j < 4; ++j) {
                    v[j] = v[j] * rstd * g1[j] + b1[j];
                    u32x2 wh; wh.x = cvtpk(v[j].x, v[j].y); wh.y = cvtpk(v[j].z, v[j].w);
                    u32x2 wl; wl.x = cvtpk(v[j].x - bflo(wh.x), v[j].y - bfhi(wh.x)); wl.y = cvtpk(v[j].z - bflo(wh.y), v[j].w - bfhi(wh.y));
                    hp[64 * j] = wh; lp[64 * j] = wl;
                    ((GAS unsigned*)(ws + WS_H1Q + (size_t)tok * 1024))[lane + 64 * j] = cvt4_fp8(v[j].x, v[j].y, v[j].z, v[j].w);
                }
            }
        }
    }
    VM_WAIT();
    __builtin_amdgcn_fence(__ATOMIC_ACQUIRE, "agent");
    VM_WAIT();
    const int q = lane & 31, hi = lane >> 5;
    f32x16 acc = {};
    {
        const unsigned char* hrow = (const unsigned char*)(out + (size_t)(tokb + q) * D) + hi * 16;
        const int wbase = q * 2048;
#pragma unroll 4
        for (int s = 0; s < 64; ++s) {
            const bf16x8 bh = *(const GAS bf16x8*)(hrow + 32 * s), bl = *(const GAS bf16x8*)(hrow + 2048 + 32 * s);
            const int off = wbase + (((2 * s + hi) ^ (q & 15)) << 4);
            const bf16x8 wh = *(const LAS bf16x8*)(Whi + off), wl = *(const LAS bf16x8*)(Wlo + off);
            acc = MFMA32(wh, bh, acc); acc = MFMA32(wl, bh, acc); acc = MFMA32(wh, bl, acc);
        }
    }
    const float* b_router = inp<I_BR>();
    float lg[16];
#pragma unroll
    for (int r = 0; r < 16; ++r) lg[r] = acc[r] + b_router[crow(r, hi)];
    float ov[4]; int oi[4];
#pragma unroll
    for (int k = 0; k < 4; ++k) {
        float best = -INFINITY; int bi = 64;
#pragma unroll
        for (int r = 0; r < 16; ++r) { const bool gt = lg[r] > best; best = gt ? lg[r] : best; bi = gt ? crow(r, hi) : bi; }
#pragma unroll
        for (int r = 0; r < 16; ++r) lg[r] = (crow(r, hi) == bi) ? -INFINITY : lg[r];
        ov[k] = best; oi[k] = bi;
    }
    float cv[8]; int ci[8];
#pragma unroll
    for (int k = 0; k < 4; ++k) { cv[k] = ov[k]; ci[k] = oi[k]; cv[4 + k] = partnerf<5>(ov[k], lane); ci[4 + k] = partneri<5>(oi[k], lane); }
    float tv[4]; int ti[4];
#pragma unroll
    for (int k = 0; k < 4; ++k) {
        float best = -INFINITY; int bi = 64;
#pragma unroll
        for (int c = 0; c < 8; ++c) { const bool gt = cv[c] > best || (cv[c] == best && ci[c] < bi); best = gt ? cv[c] : best; bi = gt ? ci[c] : bi; }
#pragma unroll
        for (int c = 0; c < 8; ++c) cv[c] = (ci[c] == bi) ? -INFINITY : cv[c];
        tv[k] = best; ti[k] = bi;
    }
    if (hi == 0) {
        const float e1 = __expf(tv[1] - tv[0]), e2 = __expf(tv[2] - tv[0]), e3 = __expf(tv[3] - tv[0]);
        const float inv = 1.0f / (1.0f + e1 + e2 + e3);
        const int tok = tokb + q;
        int lp4[4];
#pragma unroll
        for (int k = 0; k < 4; ++k) lp4[k] = atomicAdd((int*)(cnt + ti[k]), 1);
        *(int4*)(tok_e + tok * 4) = make_int4(ti[0], ti[1], ti[2], ti[3]);
        *(float4*)(tok_g + tok * 4) = make_float4(inv, e1 * inv, e2 * inv, e3 * inv);
        *(int4*)(tok_l + tok * 4) = make_int4(lp4[0], lp4[1], lp4[2], lp4[3]);
    }
    __syncthreads();
    if (F.tid < 32) ((int*)(ws + WS_WGCOUNT))[F.bid * 32 + F.tid] = cnt[F.tid];
}
DI int p4b_lists(const Frame& F0, LAS unsigned char* lds) {
    const Frame F = opaque(F0);
    unsigned char* ws = wsp();
    LAS int* tab = (LAS int*)lds;
    LAS int* pstart = (LAS int*)(lds + MISC_OFF + 256);
    LAS int* mybase = pstart + 64;
    const int* wgc = (const int*)(ws + WS_WGCOUNT);
    for (int i = F.tid; i < G * 32; i += NTHREADS) tab[i] = (int)__hip_atomic_load((unsigned*)wgc + i, __ATOMIC_RELAXED, __HIP_MEMORY_SCOPE_AGENT);
    __syncthreads();
    if (F.tid < 32) { int tot = 0, mb = 0; for (int w = 0; w < G; ++w) { const int c = tab[w * 32 + F.tid]; if (w < F.bid) mb += c; tot += c; } mybase[F.tid] = mb; pstart[32 + 32 + 32 + F.tid] = tot; }
    __syncthreads();
    if (F.tid == 0) { int off = 0; for (int e = 0; e < 32; ++e) { pstart[e] = off; off += ((pstart[96 + e] + 255) >> 8) << 8; } pstart[32] = off; }
    __syncthreads();
    const int ngroups = pstart[32] >> 8;
    if (F.bid == 0) {
        int* grp_e = (int*)(ws + WS_GRPE);
        for (int g = F.tid; g < NGRP_MAX; g += NTHREADS) { int e = 0; for (int k = 1; k < 32; ++k) if (pstart[k] <= g * 256) e = k; grp_e[g] = (g < ngroups) ? e : 0; }
    }
    const int R = T / G;
    const int* tok_e = (const int*)(ws + WS_TOKE); const float* tok_g = (const float*)(ws + WS_TOKG); const int* tok_l = (const int*)(ws + WS_TOKL);
    int* slot_tok = (int*)(ws + WS_SLOTTOK); float* slot_gate = (float*)(ws + WS_SLOTGATE); int* slot_dest = (int*)(ws + WS_SLOTDEST);
    for (int i = F.tid; i < R * 4; i += NTHREADS) {
        const int idx = F.bid * R * 4 + i; const int e = tok_e[idx];
        const int slot = pstart[e] + mybase[e] + tok_l[idx];
        slot_tok[slot] = idx >> 2; slot_gate[slot] = tok_g[idx]; slot_dest[slot] = idx;
    }
    return ngroups;
}
DI void p7_final(const Frame& F0) {
    const Frame F = opaque(F0);
    unsigned char* ws = wsp(); float* out = outp();
    const bf16_t* yslot = (const bf16_t*)(ws + WS_YSLOT);
    const int gw = F.bid * NWAVES + F.wave, NGW = G * NWAVES, lane = F.lane;
    const float* ln2_g = inp<I_LN2G>(); const float* ln2_b = inp<I_LN2B>();
    for (int tok = gw; tok < T; tok += NGW) {
        float* rowp = out + (size_t)tok * D;
        f32x4 v[4];
#pragma unroll
        for (int j = 0; j < 4; ++j) {
            const u32x2 wh = ((const GAS u32x2*)rowp)[lane + 64 * j];
            v[j] = (f32x4){bflo(wh.x), bfhi(wh.x), bflo(wh.y), bfhi(wh.y)} * ALPHA;
        }
#pragma unroll
        for (int k = 0; k < 4; ++k) {
            const GAS u32x2* yp = (const GAS u32x2*)(yslot + ((size_t)tok * 4 + k) * 1024) + lane;
#pragma unroll
            for (int j = 0; j < 4; ++j) { const u32x2 w = yp[64 * j]; v[j] = v[j] + (f32x4){bflo(w.x), bfhi(w.x), bflo(w.y), bfhi(w.y)}; }
        }
        float s = 0.f;
#pragma unroll
        for (int j = 0; j < 4; ++j) s += (v[j].x + v[j].y) + (v[j].z + v[j].w);
        const float mean = wave_sum(s) * (1.f / D); float s2 = 0.f;
#pragma unroll
        for (int j = 0; j < 4; ++j) { v[j] = v[j] - mean; s2 += (v[j].x * v[j].x + v[j].y * v[j].y) + (v[j].z * v[j].z + v[j].w * v[j].w); }
        const float rstd = 1.f / sqrtf(wave_sum(s2) * (1.f / D) + LN_EPS);
#pragma unroll
        for (int j = 0; j < 4; ++j) { const f32x4 gg = ((const f32x4*)ln2_g)[lane + 64 * j], bb = ((const f32x4*)ln2_b)[lane + 64 * j];
            ((GAS f32x4*)rowp)[lane + 64 * j] = v[j] * rstd * gg + bb; }
    }
}

struct CfgIn   { static constexpr bool FP8 = false, GATHER = false; static constexpr size_t A_OFF = WS_H0B,  B_OFF = WS_WIN,  B_E_BYTES = 0; static constexpr unsigned A_PITCH = 0; };
struct CfgOut  { static constexpr bool FP8 = false, GATHER = false; static constexpr size_t A_OFF = WS_H0B,  B_OFF = WS_WOUT, B_E_BYTES = 0; static constexpr unsigned A_PITCH = 0; };
struct CfgGU   { static constexpr bool FP8 = true,  GATHER = true;  static constexpr size_t A_OFF = WS_H1Q,  B_OFF = WS_WGU,  B_E_BYTES = (size_t)2048 * D; static constexpr unsigned A_PITCH = 1024u; };
struct CfgDown { static constexpr bool FP8 = true,  GATHER = false; static constexpr size_t A_OFF = WS_HMID, B_OFF = WS_WD,   B_E_BYTES = (size_t)D * D; static constexpr unsigned A_PITCH = 0; };
#ifndef PHASE_MASK
#define PHASE_MASK 0xFFFF
#endif
struct Args { const void* in[23]; float* out; unsigned char* ws; };
__global__ void __launch_bounds__(NTHREADS, 2) mk_fwd(Args args) {
    __shared__ __attribute__((aligned(16))) unsigned char lds_raw[LDS_BYTES];
    LAS unsigned char* lds = (LAS unsigned char*)lds_raw;
    Frame F;
    F.tid = threadIdx.x; F.lane = F.tid & 63; F.wave = __builtin_amdgcn_readfirstlane(F.tid >> 6); F.bid = blockIdx.x;
    volatile LAS unsigned* MISC = (volatile LAS unsigned*)(lds + MISC_OFF);
    if (F.tid < 64) MISC[F.tid] = 0u;
    __syncthreads();
    xcd_barrier_post((unsigned*)(wsp() + WS_CTL) + CW_BAR);
    volatile LAS unsigned* bst = MISC + 8;
#ifdef PROBE_A
    int n_stamp = 0;
#define STAMP() do { if (F.bid == 0 && F.tid == 0) { __hip_atomic_store((unsigned long long*)(wsp() + WS_CTL + 32768) + n_stamp, (unsigned long long)__builtin_amdgcn_s_memrealtime(), __ATOMIC_RELAXED, __HIP_MEMORY_SCOPE_AGENT); } ++n_stamp; } while (0)
#else
#define STAMP() do {} while (0)
#endif
    STAMP();
    LAS unsigned char* tokbuf = lds + TOKBUF_OFF;

    if (PHASE_MASK & 1) p0_prologue(F, lds);
    xcd_barrier(bst); STAMP();
    if (PHASE_MASK & 2) { pg8::StaticOrder<T, INW> S{F.bid}; EpiInProj E; pg8::gemm_phase<CfgIn>(lds, tokbuf, 0, S, E); }
    xcd_barrier(bst); STAMP();
    if (PHASE_MASK & 4) attn_phase(F, lds);
    if (PHASE_MASK & 8) gmlp_phase(F, lds);
    xcd_barrier(bst); STAMP();
    if (PHASE_MASK & 16) { pg8::StaticOrder<T, D> S{F.bid}; EpiOut E; pg8::gemm_phase<CfgOut>(lds, tokbuf, 0, S, E); }
    xcd_barrier(bst); STAMP();
    if (PHASE_MASK & 32) p4_router(F, lds);
    xcd_barrier(bst); STAMP();
    int ngroups = 1040; if (PHASE_MASK & 64) ngroups = p4b_lists(F, lds);
    xcd_barrier(bst); STAMP();
    if (PHASE_MASK & 128) { pg8::GroupOrder<8> S{0, ngroups, F.bid}; EpiGateUp E; pg8::gemm_phase<CfgGU>(lds, tokbuf, 0, S, E); }
    xcd_barrier(bst); STAMP();
    if (PHASE_MASK & 256) { pg8::GroupOrder<4> S{0, ngroups, F.bid}; EpiDown E; pg8::gemm_phase<CfgDown>(lds, tokbuf, 0, S, E); }
    xcd_barrier(bst); STAMP();
    if (PHASE_MASK & 512) p7_final(F);
#ifdef PROBE_A
    STAMP();
    if (F.bid == 0 && F.tid == 0) {
        unsigned long long* ts = (unsigned long long*)(wsp() + WS_CTL + 32768);
        unsigned long long extra = 0ull;
        for (int k = 1; k < 12; ++k) if ((PROBE_A >> k) & 1) extra += __hip_atomic_load(ts + k, __ATOMIC_RELAXED, __HIP_MEMORY_SCOPE_AGENT) - __hip_atomic_load(ts + k - 1, __ATOMIC_RELAXED, __HIP_MEMORY_SCOPE_AGENT);
        if (PROBE_A & 0x8000) extra = 50000ull;
        const unsigned long long t0 = __builtin_amdgcn_s_memrealtime();
        while (__builtin_amdgcn_s_memrealtime() - t0 < extra) __builtin_amdgcn_s_sleep(8);
    }
#endif
}

extern "C" void kernel_launch(void* const* d_in, const int* in_sizes, int n_in, void* d_out, int out_size, void* d_ws, size_t ws_size, hipStream_t stream) {
    static int grid = 0;
    if (grid == 0) {
        if (n_in != 23 || in_sizes[0] != T * D || out_size != T * D || ws_size < WS_END) {
            fprintf(stderr, "kernel_launch: unexpected shapes/workspace (n_in %d, in0 %d, out %d, ws %zu, need %zu); nothing launched\n", n_in, n_in > 0 ? in_sizes[0] : -1, out_size, ws_size, (size_t)WS_END);
            grid = -1; return;
        }
        int dev = 0, cus = 0, per_cu = 0;
        if (hipGetDevice(&dev) != hipSuccess || hipDeviceGetAttribute(&cus, hipDeviceAttributeMultiprocessorCount, dev) != hipSuccess) { grid = -1; return; }
        if (hipOccupancyMaxActiveBlocksPerMultiprocessor(&per_cu, (const void*)mk_fwd, NTHREADS, 0) != hipSuccess || per_cu < 1) {
            fprintf(stderr, "kernel_launch: occupancy query says %d blocks per CU; nothing launched\n", per_cu); (void)hipGetLastError(); grid = -1; return;
        }
        grid = cus;
        if (grid != G) { fprintf(stderr, "kernel_launch: built for a 256-CU device, found %d; nothing launched\n", cus); grid = -1; return; }
    }
    if (grid < 0) return;
    if (hipMemsetAsync((char*)d_ws + WS_CTL, 0, CTL_ZERO_BYTES, stream) != hipSuccess) return;
    Args a{};
    for (int i = 0; i < 23; ++i) a.in[i] = d_in[i];
    a.out = (float*)d_out; a.ws = (unsigned char*)d_ws;
    hipLaunchKernelGGL(mk_fwd, dim3(grid), dim3(NTHREADS), 0, stream, a);
}
```
